# Optimizing an MI355X kernel written in HIP

```python
import jax, jax.numpy as jnp
from jax import lax
import numpy as np

D_MODEL = 2048
BATCH = 8
SEQ = 4096
DEPTH = 1

N_HEADS = 16
N_KV_HEADS = 4
HEAD_DIM = 64
GROUP = N_HEADS // N_KV_HEADS
ROT_DIM = HEAD_DIM // 4
ROPE_THETA = 500000.0
WINDOW = 128
BLOCK = 128
ATTN_WIDTH = N_HEADS * HEAD_DIM
KV_WIDTH = N_KV_HEADS * HEAD_DIM
POOL_WINDOWS = (2, 4, 8, 16)
N_POOL_GROUPS = len(POOL_WINDOWS)
POOL_WIDTH = D_MODEL // 2
POOL_GROUP_DIM = POOL_WIDTH // N_POOL_GROUPS
MIX_WIDTH = ATTN_WIDTH + POOL_WIDTH
IN_WIDTH = ATTN_WIDTH + 2 * KV_WIDTH + POOL_WIDTH
N_EXPERT_GROUPS = 4
EXPERTS_PER_GROUP = 8
N_EXPERTS = N_EXPERT_GROUPS * EXPERTS_PER_GROUP
TOP_K = 2
D_EXPERT = 512
ROW_BLOCK = 256
EPS = 1e-6

kernel_name = "hymba_swa_sink_pool_hmoe_block"


def rms_norm(t, gain):
    tf = t.astype(jnp.float32)
    tf = tf * lax.rsqrt(jnp.mean(tf * tf, axis=-1, keepdims=True) + EPS)
    return (tf * gain.astype(jnp.float32)).astype(t.dtype)


def partial_rope(t, cos, sin):
    half = ROT_DIM // 2
    x1 = t[..., :half]
    x2 = t[..., half:ROT_DIM]
    c = cos[None, :, None, :].astype(t.dtype)
    s = sin[None, :, None, :].astype(t.dtype)
    return jnp.concatenate([x1 * c - x2 * s, x2 * c + x1 * s, t[..., ROT_DIM:]], axis=-1)


def sliding_window_attention(q, k, v, sinks):
    B, S, _, _ = q.shape
    nb = S // BLOCK
    qb = q.reshape(B, nb, BLOCK, N_KV_HEADS, GROUP, HEAD_DIM)

    def band(t):
        tb = t.reshape(B, nb, BLOCK, N_KV_HEADS, HEAD_DIM)
        prev = jnp.pad(tb, ((0, 0), (1, 0), (0, 0), (0, 0), (0, 0)))[:, :nb]
        return jnp.concatenate([prev, tb], axis=2)

    kb, vb = band(k), band(v)
    scale = HEAD_DIM ** -0.5
    s = jnp.einsum('bnqkgd,bnskd->bnkgqs', qb, kb).astype(jnp.float32) * scale
    qi = jnp.arange(BLOCK)[:, None] + BLOCK
    si = jnp.arange(2 * BLOCK)[None, :]
    diff = qi - si
    local = (diff >= 0) & (diff < WINDOW)
    blk = jnp.arange(nb)[:, None, None]
    valid = local[None] & ((si[None] >= BLOCK) | (blk > 0))
    s = jnp.where(valid[None, :, None, None], s, -1e30)
    sink = sinks.astype(jnp.float32).reshape(N_KV_HEADS, GROUP)[:, :, None]
    m = jnp.maximum(jnp.max(s, axis=-1), sink)
    p = jnp.exp(s - m[..., None])
    denom = jnp.sum(p, axis=-1) + jnp.exp(sink - m)
    probs = (p / denom[..., None]).astype(v.dtype)
    o = jnp.einsum('bnkgqs,bnskd->bnqkgd', probs, vb)
    return o.reshape(B, S, ATTN_WIDTH)


def multiscale_pool(u, w_pool, pool_scale):
    B, S, _ = u.shape
    uf = u.astype(jnp.float32)
    cs = jnp.cumsum(uf, axis=1)
    pos = jnp.arange(S)
    outs = []
    for g, w in enumerate(POOL_WINDOWS):
        sl = slice(g * POOL_GROUP_DIM, (g + 1) * POOL_GROUP_DIM)
        cg = cs[..., sl]
        lag = jnp.pad(cg, ((0, 0), (w, 0), (0, 0)))[:, :S]
        cnt = jnp.minimum(pos + 1, w).astype(jnp.float32)[None, :, None]
        outs.append((cg - lag) / cnt - uf[..., sl])
    d = jnp.stack(outs, axis=2).astype(u.dtype)
    y = jnp.einsum('bsgc,gcd->bsgd', d, w_pool).reshape(B, S, POOL_WIDTH)
    return y * pool_scale


def hierarchical_moe(h, w_coarse, b_coarse, w_fine, b_fine, w_gate, w_up, w_down):
    B, S, D = h.shape
    N = B * S
    hf = h.reshape(N, D)
    coarse = (hf @ w_coarse).astype(jnp.float32) + b_coarse.astype(jnp.float32)
    p_coarse = jax.nn.softmax(coarse, axis=-1)
    grp = jnp.argmax(coarse, axis=-1)
    p_grp = jnp.take_along_axis(p_coarse, grp[:, None], axis=1)[:, 0]
    fine = ((hf @ w_fine).astype(jnp.float32) + b_fine.astype(jnp.float32)).reshape(
        N, N_EXPERT_GROUPS, EXPERTS_PER_GROUP)
    fine_sel = jnp.take_along_axis(fine, grp[:, None, None], axis=1)[:, 0]
    p_fine = jax.nn.softmax(fine_sel, axis=-1)
    top_p, top_i = lax.top_k(p_fine, TOP_K)
    gates = p_grp[:, None] * top_p / jnp.sum(top_p, axis=-1, keepdims=True)

    A = N * TOP_K
    eid = (grp[:, None] * EXPERTS_PER_GROUP + top_i).reshape(A)
    tok = jnp.repeat(jnp.arange(N), TOP_K)
    gate = gates.reshape(A)
    order = jnp.argsort(eid)
    s_eid, s_tok, s_gate = eid[order], tok[order], gate[order]
    counts = jnp.bincount(eid, length=N_EXPERTS)
    padded = ((counts + ROW_BLOCK - 1) // ROW_BLOCK) * ROW_BLOCK
    start = jnp.cumsum(counts) - counts
    pad_end = jnp.cumsum(padded)
    pad_start = pad_end - padded
    dest = pad_start[s_eid] + jnp.arange(A) - start[s_eid]
    n_blocks = -(-A // ROW_BLOCK) + N_EXPERTS
    n_rows = n_blocks * ROW_BLOCK
    row_tok = jnp.full((n_rows,), N, dtype=jnp.int32).at[dest].set(s_tok.astype(jnp.int32))
    row_gate = jnp.zeros((n_rows,), jnp.float32).at[dest].set(s_gate)
    blk_eid = jnp.clip(jnp.searchsorted(pad_end, jnp.arange(n_blocks) * ROW_BLOCK, side='right'),
                       0, N_EXPERTS - 1)
    h_ext = jnp.concatenate([hf, jnp.zeros((1, D), hf.dtype)], axis=0)
    xs = h_ext[row_tok].reshape(n_blocks, ROW_BLOCK, D)

    def expert_block(args):
        xb, e = args
        a = xb @ w_gate[e]
        b = xb @ w_up[e]
        return (jax.nn.silu(a) * b) @ w_down[e]

    ys = lax.map(expert_block, (xs, blk_eid)).reshape(n_rows, D)
    ys = ys * row_gate[:, None].astype(ys.dtype)
    out = jnp.zeros((N, D), ys.dtype).at[row_tok].add(ys, mode='drop')
    return out.reshape(B, S, D)


def setup_inputs(seed: int = 0) -> dict:
    key = jax.random.key(seed)
    ks = jax.random.split(key, 18)
    f32 = jnp.float32
    nrm = lambda k, shape, scale: jax.random.normal(k, shape, f32) * scale
    L = DEPTH
    return {
        "x": jax.random.normal(ks[0], (BATCH, SEQ, D_MODEL), f32),
        "norm_mix": 1.0 + nrm(ks[1], (L, D_MODEL), 0.02),
        "w_in": nrm(ks[2], (L, D_MODEL, IN_WIDTH), D_MODEL ** -0.5),
        "q_norm": 1.0 + nrm(ks[3], (L, HEAD_DIM), 0.02),
        "k_norm": 1.0 + nrm(ks[4], (L, HEAD_DIM), 0.02),
        "sinks": nrm(ks[5], (L, N_HEADS), 1.0),
        "w_pool": nrm(ks[6], (L, N_POOL_GROUPS, POOL_GROUP_DIM, POOL_GROUP_DIM), POOL_GROUP_DIM ** -0.5),
        "pool_scale": 1.0 + nrm(ks[7], (L, POOL_WIDTH), 0.1),
        "w_out": nrm(ks[8], (L, MIX_WIDTH, D_MODEL), MIX_WIDTH ** -0.5),
        "norm_ffn": 1.0 + nrm(ks[9], (L, D_MODEL), 0.02),
        "w_coarse": nrm(ks[10], (L, D_MODEL, N_EXPERT_GROUPS), D_MODEL ** -0.5),
        "b_coarse": nrm(ks[11], (L, N_EXPERT_GROUPS), 0.01),
        "w_fine": nrm(ks[12], (L, D_MODEL, N_EXPERTS), D_MODEL ** -0.5),
        "b_fine": nrm(ks[13], (L, N_EXPERTS), 0.01),
        "w_gate": nrm(ks[14], (L, N_EXPERTS, D_MODEL, D_EXPERT), D_MODEL ** -0.5),
        "w_up": nrm(ks[15], (L, N_EXPERTS, D_MODEL, D_EXPERT), D_MODEL ** -0.5),
        "w_down": nrm(ks[16], (L, N_EXPERTS, D_EXPERT, D_MODEL), D_EXPERT ** -0.5),
    }


def reference(x, norm_mix, w_in, q_norm, k_norm, sinks, w_pool, pool_scale, w_out,
              norm_ffn, w_coarse, b_coarse, w_fine, b_fine, w_gate, w_up, w_down):
    B, S, _ = x.shape
    pos = jnp.arange(S, dtype=jnp.float32)
    inv_freq = ROPE_THETA ** (-jnp.arange(0, ROT_DIM, 2, dtype=jnp.float32) / ROT_DIM)
    ang = pos[:, None] * inv_freq[None, :]
    cos, sin = jnp.cos(ang), jnp.sin(ang)
    h = x
    for l in range(DEPTH):
        hn = rms_norm(h, norm_mix[l])
        proj = hn @ w_in[l]
        q = proj[..., :ATTN_WIDTH].reshape(B, S, N_HEADS, HEAD_DIM)
        k = proj[..., ATTN_WIDTH:ATTN_WIDTH + KV_WIDTH].reshape(B, S, N_KV_HEADS, HEAD_DIM)
        v = proj[..., ATTN_WIDTH + KV_WIDTH:ATTN_WIDTH + 2 * KV_WIDTH].reshape(B, S, N_KV_HEADS, HEAD_DIM)
        u = proj[..., ATTN_WIDTH + 2 * KV_WIDTH:]
        q = partial_rope(rms_norm(q, q_norm[l]), cos, sin)
        k = partial_rope(rms_norm(k, k_norm[l]), cos, sin)
        attn = sliding_window_attention(q, k, v, sinks[l])
        pool = multiscale_pool(u, w_pool[l], pool_scale[l])
        mixed = jnp.concatenate([attn, pool.astype(attn.dtype)], axis=-1)
        h = h + mixed @ w_out[l]
        hn = rms_norm(h, norm_ffn[l])
        h = h + hierarchical_moe(hn, w_coarse[l], b_coarse[l], w_fine[l], b_fine[l],
                                 w_gate[l], w_up[l], w_down[l])
    return h
```

```cpp
#include <hip/hip_runtime.h>
#include <cstdio>
#include <cstdint>

#ifndef MK_N_LAUNCHES
#define MK_N_LAUNCHES 9
#endif

#define GAS __attribute__((address_space(1)))
#define LAS __attribute__((address_space(3)))
typedef unsigned short bf16_t;
typedef short bf16x8 __attribute__((ext_vector_type(8)));
typedef short s16x4 __attribute__((ext_vector_type(4)));
typedef float f32x4 __attribute__((ext_vector_type(4)));
typedef float f32x2 __attribute__((ext_vector_type(2)));
typedef float f32x16 __attribute__((ext_vector_type(16)));
typedef unsigned u32x4 __attribute__((ext_vector_type(4)));
typedef unsigned u32x2 __attribute__((ext_vector_type(2)));
typedef GAS unsigned gu32;

constexpr int BATCH = 8, SEQ = 4096, NTOK = BATCH * SEQ, DM = 2048;
constexpr int NH = 16, NKV = 4, HD = 64, INW = 2560, QOFF = 0, KOFF = 1024, VOFF = 1280, UOFF = 1536, PW = 1024;
constexpr int NEXP = 32, DEXP = 512, NASG = NTOK * 2, RCAP = NASG;
constexpr float EPS = 1e-6f;
constexpr int NPHASE = 9;

constexpr size_t MiB = 1u << 20;
constexpr size_t WS_CTL = 0, CTL_ZERO_BYTES = 64 * 1024;
constexpr size_t WS_ROPE = 1 * MiB;
constexpr size_t WS_RINV = WS_ROPE + 256 * 1024;
constexpr size_t WS_RTOK = WS_RINV + 128 * 1024;
constexpr size_t WS_GATE = WS_RTOK + 128 * 1024;
constexpr size_t WS_WR = 2 * MiB;
constexpr size_t WS_WPOOL = WS_WR + 512 * 1024;
constexpr size_t WS_WIN = 3 * MiB;
constexpr size_t WS_WOUT = 13 * MiB;
constexpr size_t WS_ROWL = 21 * MiB;
constexpr size_t WS_WGU = 29 * MiB;
constexpr size_t WS_WD = 157 * MiB;
constexpr size_t WS_XB = 221 * MiB;
constexpr size_t WS_PROJ = 349 * MiB;
constexpr size_t WS_MIXED = 509 * MiB;
constexpr size_t WS_DPOOL = 637 * MiB;
constexpr size_t WS_ACT = WS_DPOOL;
constexpr size_t WS_Y = WS_PROJ;
constexpr size_t WS_END = 701 * MiB;
static_assert(WS_Y + (size_t)NASG * DM * 2 <= WS_DPOOL, "Y overlay");
constexpr int CW_TMO = 0, CW_BAR = 1024, CW_CNT = 8192;

constexpr int RING_BYTES = 131072;
constexpr int TAB_OFF = RING_BYTES;
constexpr int TAB_UNITS = 14;
constexpr int EXPT_OFF = TAB_OFF + TAB_UNITS * 1024;
constexpr int MISC_OFF = EXPT_OFF + 512;
constexpr int LDS_BYTES = 147456;
static_assert(MISC_OFF + 16 <= LDS_BYTES, "LDS map");

#define RLX_AGENT __ATOMIC_RELAXED, __HIP_MEMORY_SCOPE_AGENT
#define LDS_WAIT() asm volatile("s_waitcnt lgkmcnt(0)" ::: "memory")
#define VM_WAIT() asm volatile("s_waitcnt vmcnt(0)" ::: "memory")

__device__ __forceinline__ unsigned f2bf(float f) { unsigned u = __builtin_bit_cast(unsigned, f); return (u + 0x7fffu + ((u >> 16) & 1u)) >> 16; }
__device__ __forceinline__ unsigned pk2(float lo, float hi) { return f2bf(lo) | (f2bf(hi) << 16); }
__device__ __forceinline__ float bflo(unsigned w) { return __builtin_bit_cast(float, w << 16); }
__device__ __forceinline__ float bfhi(unsigned w) { return __builtin_bit_cast(float, w & 0xffff0000u); }
__device__ __forceinline__ unsigned cvt_pk_bf16(float lo, float hi) { unsigned r; asm volatile("v_cvt_pk_bf16_f32 %0, %1, %2" : "=v"(r) : "v"(lo), "v"(hi)); return r; }
__device__ __forceinline__ float wave_sum(float v) {
#pragma unroll
    for (int o = 1; o < 64; o <<= 1) v += __shfl_xor(v, o);
    return v;
}

#define XB_TMO      128
#define XB_XCNT(j)  (256  + 64 * (j))
#define XB_XSUB(j)  (1280 + 64 * (j))
#define XB_XGEN(j)  (2304 + 64 * (j))
#define XB_TOP      3328
#define XB_TOPGEN   3392
#define XCD_BAR_WORDS 3456
#define XB_SPIN_CAP (1u << 18)
__device__ __forceinline__ unsigned xb_ld(unsigned* p)              { return __hip_atomic_load(p, __ATOMIC_RELAXED, __HIP_MEMORY_SCOPE_AGENT); }
__device__ __forceinline__ unsigned xb_add(unsigned* p, unsigned v) { return __hip_atomic_fetch_add(p, v, __ATOMIC_RELAXED, __HIP_MEMORY_SCOPE_AGENT); }
__device__ __forceinline__ unsigned xb_xcc_id() { return (unsigned)__builtin_amdgcn_s_getreg((3 << 11) | 20) & 0xFu; }
#define XB_SPIN(cond, bar) do { unsigned _sp = 0; while (cond) { __builtin_amdgcn_s_sleep(1); \
    if ((++_sp & 255u) == 0u) { if (xb_ld(&(bar)[XB_TMO])) break; if (_sp > XB_SPIN_CAP) { atomicAdd(&(bar)[XB_TMO], 1u); break; } } } } while (0)
struct XcdBarrier { unsigned* bar; unsigned x; volatile LAS unsigned* st; };
__device__ __forceinline__ XcdBarrier xcd_barrier_post(unsigned* bar, volatile LAS unsigned* st) {
    XcdBarrier b; b.bar = bar; b.x = xb_xcc_id(); b.st = st;
    if (threadIdx.x == 0) (void)xb_add(&bar[XB_XCNT(b.x)], 1u);
    return b;
}
__device__ __forceinline__ void xcd_barrier_complete(unsigned* bar, unsigned x, unsigned& nloc, unsigned& nx) {
    const unsigned G = gridDim.x * gridDim.y * gridDim.z;
    unsigned sum, cnt, mine, sp = 0u;
    for (;;) {
        sum = 0u; cnt = 0u; mine = 0u;
#pragma unroll
        for (unsigned j = 0; j < 16; ++j) { const unsigned c = xb_ld(&bar[XB_XCNT(j)]); sum += c; cnt += (c > 0u) ? 1u : 0u; mine = (j == x) ? c : mine; }
        if (sum == G) break;
        __builtin_amdgcn_s_sleep(1);
        if ((++sp & 255u) == 0u) { if (xb_ld(&bar[XB_TMO])) break; if (sp > XB_SPIN_CAP) { atomicAdd(&bar[XB_TMO], 1u); break; } }
    }
    nloc = mine > 0u ? mine : 1u; nx = cnt > 0u ? cnt : 1u;
}
__device__ __forceinline__ void xcd_barrier(const XcdBarrier& b) {
    asm volatile("s_waitcnt vmcnt(0)" ::: "memory");
    __syncthreads();
    if (threadIdx.x == 0) {
        unsigned* bar = b.bar;
        __builtin_amdgcn_s_waitcnt(0);
        unsigned nloc = b.st[0], nx = b.st[1];
        if (nloc == 0u) { xcd_barrier_complete(bar, b.x, nloc, nx); b.st[0] = nloc; b.st[1] = nx; }
        const unsigned old = xb_add(&bar[XB_XSUB(b.x)], 1u);
        const unsigned gen = old / nloc;
        if (old + 1u == (gen + 1u) * nloc) {
            __builtin_amdgcn_fence(__ATOMIC_RELEASE, "agent");
            asm volatile("s_waitcnt vmcnt(0)" ::: "memory");
            const unsigned og = xb_add(&bar[XB_TOP], 1u);
            const unsigned tg = og / nx;
            if (og + 1u == (tg + 1u) * nx) xb_add(&bar[XB_TOPGEN], 1u);
            else XB_SPIN(xb_ld(&bar[XB_TOPGEN]) == tg, bar);
            __builtin_amdgcn_fence(__ATOMIC_ACQUIRE, "agent");
            xb_add(&bar[XB_XGEN(b.x)], 1u);
            asm volatile("s_waitcnt vmcnt(0)" ::: "memory");
        } else {
            XB_SPIN(xb_ld(&bar[XB_XGEN(b.x)]) == gen, bar);
            __builtin_amdgcn_fence(__ATOMIC_ACQUIRE, "agent");
            asm volatile("s_waitcnt vmcnt(0)" ::: "memory");
        }
    }
    __syncthreads();
}

namespace pg8 {
constexpr int BM = 256, BK = 64, HALF = 128, HTB = HALF * BK * 2, STAGE_BYTES = 8 * HTB, NXCD = 8, WGM = 8;
static_assert(STAGE_BYTES == RING_BYTES, "stage region");
__host__ __device__ __forceinline__ int lds_byte(int r, int c) { const int st = (r >> 4) * 2 + (c >> 5), rr = r & 15, cc = c & 31, ob = rr * 64 + cc * 2; return st * 1024 + (ob ^ (((ob >> 9) & 1) << 5)); }
__host__ __device__ __forceinline__ void stage_rc(int b, int& R, int& C) { const int st = b / 1024, sb = b % 1024, swz = sb ^ (((sb >> 9) & 1) << 5); R = (st >> 1) * 16 + swz / 64; C = (st & 1) * 32 + (swz % 64) / 2; }
__host__ __device__ __forceinline__ int perm32(int rho) { const int n = rho >> 4, i = rho & 15; return 8 * (i >> 2) + 4 * n + (i & 3); }

struct Unit { int pm, pn, ord, e, cnt; };

struct StaticOrder {
    int nM, nN, nwg, G, c;
    __device__ void init(int M, int N, int G_, int c_) { nM = M / BM; nN = N / BM; nwg = nM * nN; G = G_; c = c_; }
    __device__ bool next(int i, int& pm, int& pn) const {
        const long L = (long)i * G + c; if (L >= nwg) return false;
        int wgid = (int)L; { const int q = nwg / NXCD, r = nwg % NXCD, xcd = wgid % NXCD, off = wgid / NXCD; wgid = (xcd < r ? xcd * (q + 1) : r * (q + 1) + (xcd - r) * q) + off; }
        const int nig = WGM * nN, gid = wgid / nig, fm = gid * WGM, gsz = (nM - fm) < WGM ? (nM - fm) : WGM;
        pm = fm + ((wgid % nig) % gsz); pn = (wgid % nig) / gsz; return true;
    }
};

template <class Epi, class Prob>
__device__ __forceinline__ void gemm_phase(LAS unsigned char* lds, const Prob& S, const Epi& E) {
    const int tid = threadIdx.x, wid = __builtin_amdgcn_readfirstlane(tid >> 6), lane = tid & 63, wr = wid >> 2, wc = wid & 3, fr = lane & 15, fq = lane >> 4;
    const int K = S.K, nt = K / BK;
    int Rr[2], Cc[2]; unsigned voffB[2];
#pragma unroll
    for (int i = 0; i < 2; ++i) { stage_rc(tid * 16 + i * 8192, Rr[i], Cc[i]); const int Rb = Epi::PERM ? ((Rr[i] & ~31) + perm32(Rr[i] & 31)) : Rr[i]; voffB[i] = (unsigned)(Rb * K + Cc[i]) * 2u; }
    const size_t kstep = (size_t)(BK * 2);
    const size_t hstep = (size_t)HALF * K * 2;
    const unsigned ldsw = (unsigned)wid * 1024u;
    const int aoff = lds_byte(wr * 64 + fr, fq * 8), boff = lds_byte(wc * 32 + fr, fq * 8);
#define PG8_SA(b, h) (((b) * 2 + (h)) * HTB)
#define PG8_SB(b, h) ((4 + (b) * 2 + (h)) * HTB)
#define PG8_STAGE(bufoff, gbase, voff) do { _Pragma("unroll") for (int _i = 0; _i < 2; ++_i) \
        __builtin_amdgcn_global_load_lds((const unsigned*)((const char*)(gbase) + (voff)[_i]), (LAS unsigned*)(lds + (bufoff) + ldsw + _i * 8192), 16, 0, 0); } while (0)
#define PG8_LDA(dst, b, h) do { _Pragma("unroll") for (int m = 0; m < 4; ++m) _Pragma("unroll") for (int k = 0; k < 2; ++k) dst[m][k] = *(const LAS bf16x8*)(lds + PG8_SA(b, h) + aoff + m * 2048 + k * 1024); } while (0)
#define PG8_LDB(dst, b, h) do { _Pragma("unroll") for (int n = 0; n < 2; ++n) _Pragma("unroll") for (int k = 0; k < 2; ++k) dst[n][k] = *(const LAS bf16x8*)(lds + PG8_SB(b, h) + boff + n * 2048 + k * 1024); } while (0)
#define PG8_MMA(ai, bj, At, Bt) do { __builtin_amdgcn_s_setprio(1); _Pragma("unroll") for (int m = 0; m < 4; ++m) _Pragma("unroll") for (int n = 0; n < 2; ++n) _Pragma("unroll") for (int k = 0; k < 2; ++k) \
        acc[ai][bj][m][n] = __builtin_amdgcn_mfma_f32_16x16x32_bf16(Bt[n][k], At[m][k], acc[ai][bj][m][n], 0, 0, 0); __builtin_amdgcn_s_setprio(0); } while (0)
#define PG8_WAIT_V(n) asm volatile("s_waitcnt vmcnt(" #n ")" ::: "memory")
#define PG8_WAIT_L(n) asm volatile("s_waitcnt lgkmcnt(" #n ")" ::: "memory")
#define PG8_BAR __builtin_amdgcn_s_barrier()
#define PG8_SCHED __builtin_amdgcn_sched_barrier(0)
    Unit cur, nxt; int ui = 0;
    if (!S.next(0, cur)) return;
    f32x4 acc[2][2][4][2];
#pragma unroll
    for (int a = 0; a < 2; ++a)
#pragma unroll
        for (int b = 0; b < 2; ++b)
#pragma unroll
            for (int m = 0; m < 4; ++m)
#pragma unroll
                for (int n = 0; n < 2; ++n) acc[a][b][m][n] = (f32x4){0.f, 0.f, 0.f, 0.f};
    bf16x8 At[4][2], B0[2][2], B1[2][2];
    unsigned vc[2][2], vn[2][2];
    S.a_voff(cur, Rr, Cc, vc);
    const char* cA = S.a_base(cur); const char* cB = S.b_base(cur);
    PG8_STAGE(PG8_SB(0, 0), cB, voffB); PG8_STAGE(PG8_SB(0, 1), cB + hstep, voffB); PG8_STAGE(PG8_SA(0, 0), cA, vc[0]); PG8_STAGE(PG8_SA(0, 1), cA, vc[1]);
    if (wr == 1) PG8_BAR;
    PG8_WAIT_V(2); PG8_BAR;
    PG8_STAGE(PG8_SB(1, 0), cB + kstep, voffB); PG8_STAGE(PG8_SA(1, 0), cA + kstep, vc[0]); PG8_STAGE(PG8_SB(1, 1), cB + hstep + kstep, voffB);
    PG8_WAIT_V(6); PG8_BAR;
    for (;;) {
        const bool has_next = S.next(ui + 1, nxt);
        const char* nA = has_next ? S.a_base(nxt) : cA; const char* nB = has_next ? S.b_base(nxt) : cB;
        if (has_next) S.a_voff(nxt, Rr, Cc, vn); else { vn[0][0] = vc[0][0]; vn[0][1] = vc[0][1]; vn[1][0] = vc[1][0]; vn[1][1] = vc[1][1]; }
        for (int t = 0; t < nt; t += 2) {
            const bool last = (t == nt - 2);
            const char* a1 = cA + (size_t)(t + 1) * kstep;
            const char* a2 = last ? nA : cA + (size_t)(t + 2) * kstep; const char* b2 = last ? nB : cB + (size_t)(t + 2) * kstep;
            const char* a3 = a2 + kstep; const char* b3 = b2 + kstep;
            unsigned w0[2], w1[2]; w0[0] = last ? vn[0][0] : vc[0][0]; w0[1] = last ? vn[0][1] : vc[0][1]; w1[0] = last ? vn[1][0] : vc[1][0]; w1[1] = last ? vn[1][1] : vc[1][1];
            PG8_LDB(B0, 0, 0); PG8_LDB(B1, 0, 1); PG8_SCHED; PG8_LDA(At, 0, 0); PG8_STAGE(PG8_SA(1, 1), a1, vc[1]);
            PG8_WAIT_V(8); PG8_WAIT_L(0); PG8_BAR; PG8_MMA(0, 0, At, B0); PG8_MMA(0, 1, At, B1); PG8_BAR; PG8_SCHED;
            PG8_LDA(At, 0, 1); PG8_STAGE(PG8_SB(0, 0), b2, voffB); PG8_STAGE(PG8_SB(0, 1), b2 + hstep, voffB); PG8_STAGE(PG8_SA(0, 0), a2, w0);
            PG8_WAIT_V(8); PG8_WAIT_L(0); PG8_BAR; PG8_MMA(1, 0, At, B0); PG8_MMA(1, 1, At, B1); PG8_BAR; PG8_SCHED;
            PG8_LDB(B0, 1, 0); PG8_LDB(B1, 1, 1); PG8_SCHED; PG8_LDA(At, 1, 0); PG8_STAGE(PG8_SA(0, 1), a2, w1);
            PG8_WAIT_V(8); PG8_WAIT_L(0); PG8_BAR; PG8_MMA(0, 0, At, B0); PG8_MMA(0, 1, At, B1); PG8_BAR; PG8_SCHED;
            PG8_LDA(At, 1, 1); PG8_STAGE(PG8_SB(1, 0), b3, voffB); PG8_STAGE(PG8_SB(1, 1), b3 + hstep, voffB); PG8_STAGE(PG8_SA(1, 0), a3, w0);
            PG8_WAIT_V(8); PG8_WAIT_L(0); PG8_BAR; PG8_MMA(1, 0, At, B0); PG8_MMA(1, 1, At, B1); PG8_BAR; PG8_SCHED;
        }
        if (wr == 0) PG8_BAR;
        E(acc, cur, wr, wc, fr, fq);
        if (!has_next) break;
#pragma unroll
        for (int a = 0; a < 2; ++a)
#pragma unroll
            for (int b = 0; b < 2; ++b)
#pragma unroll
                for (int m = 0; m < 4; ++m)
#pragma unroll
                    for (int n = 0; n < 2; ++n) acc[a][b][m][n] = (f32x4){0.f, 0.f, 0.f, 0.f};
        cur = nxt; cA = nA; cB = nB; ++ui;
        vc[0][0] = vn[0][0]; vc[0][1] = vn[0][1]; vc[1][0] = vn[1][0]; vc[1][1] = vn[1][1];
        if (wr == 1) PG8_BAR;
    }
    PG8_WAIT_V(0);
    PG8_BAR;
#undef PG8_SA
#undef PG8_SB
#undef PG8_STAGE
#undef PG8_LDA
#undef PG8_LDB
#undef PG8_MMA
#undef PG8_WAIT_V
#undef PG8_WAIT_L
#undef PG8_BAR
#undef PG8_SCHED
}

struct DenseProb {
    const bf16_t* A; const bf16_t* Bt; int lda, K, acol;
    StaticOrder so;
    __device__ __forceinline__ bool next(int i, Unit& u) const { u.ord = i; u.e = 0; u.cnt = 256; return so.next(i, u.pm, u.pn); }
    __device__ __forceinline__ const char* a_base(const Unit& u) const { return (const char*)(A + (size_t)u.pm * BM * lda + (size_t)u.pn * acol); }
    __device__ __forceinline__ const char* b_base(const Unit& u) const { return (const char*)(Bt + (size_t)u.pn * BM * K); }
    __device__ __forceinline__ void a_voff(const Unit&, const int (&R)[2], const int (&C)[2], unsigned (&vo)[2][2]) const {
#pragma unroll
        for (int h = 0; h < 2; ++h)
#pragma unroll
            for (int i = 0; i < 2; ++i) vo[h][i] = (unsigned)((h * HALF + R[i]) * lda + C[i]) * 2u;
    }
};

struct MoeProb {
    const bf16_t* A; const bf16_t* Bt; int lda, K, nN, shift;
    LAS const int* tab;
    LAS const int* expt;
    int G, c;
    __device__ __forceinline__ bool next(int i, Unit& u) const {
        const int per = G >> 3, xcd = c & 7, rank = c >> 3;
        const int L = (i * 8 + xcd) * per + rank;
        if (L >= expt[32] || i >= TAB_UNITS) return false;
        int e = 0;
#pragma unroll 1
        while (e < 31 && L >= expt[e + 1]) ++e;
        const int q = L - expt[e], cnt = expt[33 + e], T = (cnt + 255) >> 8;
        u.e = e; u.pn = q / T; u.pm = q % T; u.ord = i; u.cnt = cnt - u.pm * 256; return true;
    }
    __device__ __forceinline__ const char* a_base(const Unit&) const { return (const char*)A; }
    __device__ __forceinline__ const char* b_base(const Unit& u) const { return (const char*)(Bt + ((size_t)u.e * nN + u.pn) * BM * K); }
    __device__ __forceinline__ void a_voff(const Unit& u, const int (&R)[2], const int (&C)[2], unsigned (&vo)[2][2]) const {
#pragma unroll
        for (int h = 0; h < 2; ++h)
#pragma unroll
            for (int i = 0; i < 2; ++i) { const unsigned row = ((unsigned)tab[u.ord * 256 + h * HALF + R[i]] & 0x7fffffffu) >> shift; vo[h][i] = (row * (unsigned)lda + (unsigned)C[i]) * 2u; }
    }
};

struct EpiRowScaleBf16 {
    static constexpr bool PERM = true;
    bf16_t* O; int ldc; const float* rs;
    __device__ __forceinline__ void operator()(const f32x4 (&acc)[2][2][4][2], const Unit& u, int wr, int wc, int fr, int fq) const {
        const int row0 = u.pm * BM + wr * 64 + fr, col0 = u.pn * BM + wc * 32 + 8 * fq;
#pragma unroll
        for (int ai = 0; ai < 2; ++ai)
#pragma unroll
            for (int m = 0; m < 4; ++m) { const int row = row0 + ai * HALF + m * 16; const float s = rs[row]; bf16_t* rowp = O + (size_t)row * ldc + col0;
#pragma unroll
                for (int bj = 0; bj < 2; ++bj) { const f32x4 v0 = acc[ai][bj][m][0] * s, v1 = acc[ai][bj][m][1] * s;
                    u32x4 w; w.x = cvt_pk_bf16(v0[0], v0[1]); w.y = cvt_pk_bf16(v0[2], v0[3]); w.z = cvt_pk_bf16(v1[0], v1[1]); w.w = cvt_pk_bf16(v1[2], v1[3]);
                    *(u32x4*)(rowp + bj * HALF) = w; } }
    }
};
struct EpiBf16 {
    static constexpr bool PERM = true;
    bf16_t* O; int ldc, cbase;
    __device__ __forceinline__ void operator()(const f32x4 (&acc)[2][2][4][2], const Unit& u, int wr, int wc, int fr, int fq) const {
        const int row0 = u.pm * BM + wr * 64 + fr, col0 = cbase + u.pn * BM + wc * 32 + 8 * fq;
#pragma unroll
        for (int ai = 0; ai < 2; ++ai)
#pragma unroll
            for (int m = 0; m < 4; ++m) { bf16_t* rowp = O + (size_t)(row0 + ai * HALF + m * 16) * ldc + col0;
#pragma unroll
                for (int bj = 0; bj < 2; ++bj) { const f32x4 v0 = acc[ai][bj][m][0], v1 = acc[ai][bj][m][1];
                    u32x4 w; w.x = cvt_pk_bf16(v0[0], v0[1]); w.y = cvt_pk_bf16(v0[2], v0[3]); w.z = cvt_pk_bf16(v1[0], v1[1]); w.w = cvt_pk_bf16(v1[2], v1[3]);
                    *(u32x4*)(rowp + bj * HALF) = w; } }
    }
};
struct EpiResF32 {
    static constexpr bool PERM = false;
    const float* base; float* out; int ldc;
    __device__ __forceinline__ void operator()(const f32x4 (&acc)[2][2][4][2], const Unit& u, int wr, int wc, int fr, int fq) const {
        const int row0 = u.pm * BM + wr * 64 + fr, col0 = u.pn * BM + wc * 32 + 4 * fq;
#pragma unroll
        for (int ai = 0; ai < 2; ++ai)
#pragma unroll
            for (int m = 0; m < 4; ++m) { const size_t off = (size_t)(row0 + ai * HALF + m * 16) * ldc + col0;
#pragma unroll
                for (int bj = 0; bj < 2; ++bj)
#pragma unroll
                    for (int n = 0; n < 2; ++n) { const f32x4 bs = *(const f32x4*)(base + off + bj * HALF + n * 16); *(f32x4*)(out + off + bj * HALF + n * 16) = bs + acc[ai][bj][m][n]; } }
    }
};
struct EpiSwiGLU {
    static constexpr bool PERM = true;
    bf16_t* act; const float* rtok; const float* gate; LAS const int* tab;
    __device__ __forceinline__ void operator()(const f32x4 (&acc)[2][2][4][2], const Unit& u, int wr, int wc, int fr, int fq) const {
        const int col0 = u.pn * HALF + wc * 32 + 8 * fq;
#pragma unroll
        for (int ai = 0; ai < 2; ++ai)
#pragma unroll
            for (int m = 0; m < 4; ++m) { const int rl = ai * HALF + wr * 64 + m * 16 + fr; const int a = tab[u.ord * 256 + rl];
                if (a >= 0) { const float r = rtok[a >> 1], gt = gate[a]; float o[8];
#pragma unroll
                    for (int n = 0; n < 2; ++n)
#pragma unroll
                        for (int j = 0; j < 4; ++j) { const float g = acc[ai][0][m][n][j] * r, up = acc[ai][1][m][n][j] * r; o[n * 4 + j] = g / (1.0f + __expf(-g)) * up * gt; }
                    u32x4 w; w.x = cvt_pk_bf16(o[0], o[1]); w.y = cvt_pk_bf16(o[2], o[3]); w.z = cvt_pk_bf16(o[4], o[5]); w.w = cvt_pk_bf16(o[6], o[7]);
                    *(u32x4*)(act + (size_t)a * DEXP + col0) = w; } }
    }
};
struct EpiScatterBf16 {
    static constexpr bool PERM = true;
    bf16_t* Y; int ldc; LAS const int* tab;
    __device__ __forceinline__ void operator()(const f32x4 (&acc)[2][2][4][2], const Unit& u, int wr, int wc, int fr, int fq) const {
        const int col0 = u.pn * BM + wc * 32 + 8 * fq;
#pragma unroll
        for (int ai = 0; ai < 2; ++ai)
#pragma unroll
            for (int m = 0; m < 4; ++m) { const int rl = ai * HALF + wr * 64 + m * 16 + fr; const int a = tab[u.ord * 256 + rl];
                if (a >= 0) { bf16_t* rowp = Y + (size_t)a * ldc + col0;
#pragma unroll
                    for (int bj = 0; bj < 2; ++bj) { const f32x4 v0 = acc[ai][bj][m][0], v1 = acc[ai][bj][m][1];
                        u32x4 w; w.x = cvt_pk_bf16(v0[0], v0[1]); w.y = cvt_pk_bf16(v0[2], v0[3]); w.z = cvt_pk_bf16(v1[0], v1[1]); w.w = cvt_pk_bf16(v1[2], v1[3]);
                        *(u32x4*)(rowp + bj * HALF) = w; } } }
    }
};
}

struct Frame {
    LAS unsigned char* lds;
    gu32* ctl;
    int tid, lane, wave, G, bx;
    const float *x, *norm_mix, *w_in, *q_norm, *k_norm, *sinks, *w_pool, *pool_scale, *w_out, *norm_ffn, *w_coarse, *b_coarse, *w_fine, *b_fine, *w_gate, *w_up, *w_down;
    float* out;
    float *rope, *rinv, *rtok, *gate;
    bf16_t *Wr, *Wpool, *Win, *Wout, *Wgu, *Wd, *XB, *PROJ, *MIXED, *DPOOL, *ACT, *Y;
    int* rowl;
};

__device__ __forceinline__ void tr_item(const float* W, int N, int k0, int n0, bf16_t* dst0, int Kd, const float* gk, const float* gn, LAS float* scr, int lane) {
    const float sn = gn ? gn[n0 + (lane & 31)] : 1.0f;
#pragma unroll 8
    for (int i = 0; i < 32; ++i) { const int kk = 2 * i + (lane >> 5); float v = W[(size_t)(k0 + kk) * N + n0 + (lane & 31)]; if (gk) v *= gk[k0 + kk]; scr[kk * 33 + (lane & 31)] = v * sn; }
    LDS_WAIT(); asm volatile("" ::: "memory");
    const int c = lane & 7;
#pragma unroll
    for (int j = 0; j < 4; ++j) { const int n = (lane >> 3) + 8 * j; const LAS float* s = scr + (8 * c) * 33 + n;
        u32x4 o; o.x = pk2(s[0 * 33], s[1 * 33]); o.y = pk2(s[2 * 33], s[3 * 33]); o.z = pk2(s[4 * 33], s[5 * 33]); o.w = pk2(s[6 * 33], s[7 * 33]);
        *(GAS u32x4*)(dst0 + (size_t)n * Kd + k0 + 8 * c) = o; }
    LDS_WAIT(); asm volatile("" ::: "memory");
}

__device__ __forceinline__ void p0_prologue(Frame& F) {
    const int gw = F.bx * 8 + F.wave, NGW = F.G * 8, gt = F.bx * 512 + F.tid, NGT = F.G * 512;
    LAS float* scr = (LAS float*)(F.lds + F.wave * 16384);
    for (int i = gt; i < SEQ * 8; i += NGT) {
        const int pos = i >> 3, j = i & 7;
        const double invf[8] = {1.0, 0.19392274474868576, 0.03760603093086393, 0.007292664737217109, 0.001414213562373095, 0.0002742481756762073, 5.318295896944988e-05, 1.031338537721246e-05};
        double f = invf[0];
#pragma unroll
        for (int q = 1; q < 8; ++q) f = (j == q) ? invf[q] : f;
        double s, c; sincos((double)pos * f, &s, &c);
        F.rope[pos * 16 + j] = (float)c; F.rope[pos * 16 + 8 + j] = (float)s;
    }
    for (int i = gt; i < 64 * DM; i += NGT) {
        const int j = i / DM, k = i % DM; float v = 0.f;
        if (j < 4) v = F.w_coarse[k * 4 + j] * F.norm_ffn[k]; else if (j < 36) v = F.w_fine[k * 32 + (j - 4)] * F.norm_ffn[k];
        const unsigned hi = f2bf(v); const float lo = v - bflo(hi);
        F.Wr[i] = (bf16_t)hi; F.Wr[64 * DM + i] = (bf16_t)f2bf(lo);
    }
    constexpr int I_IN = (DM / 64) * (INW / 32), I_OUT = (DM / 64) * (DM / 32), I_POOL = 4 * (256 / 64) * (256 / 32), I_G = NEXP * (DM / 64) * (DEXP / 32), I_D = NEXP * (DEXP / 64) * (DM / 32);
    constexpr int NITEMS = I_IN + I_OUT + I_POOL + 2 * I_G + I_D;
    for (int it = gw; it < NITEMS; it += NGW) {
        int r = it;
        if (r < I_IN) { const int nb = INW / 32, kb = r / nb, nn = r % nb; tr_item(F.w_in, INW, 64 * kb, 32 * nn, F.Win + (size_t)(32 * nn) * DM, DM, F.norm_mix, nullptr, scr, F.lane); continue; } r -= I_IN;
        if (r < I_OUT) { const int nb = DM / 32, kb = r / nb, nn = r % nb; tr_item(F.w_out, DM, 64 * kb, 32 * nn, F.Wout + (size_t)(32 * nn) * DM, DM, nullptr, nullptr, scr, F.lane); continue; } r -= I_OUT;
        if (r < I_POOL) { const int g = r / 32, q = r % 32, kb = q / 8, nn = q % 8;
            tr_item(F.w_pool + (size_t)g * 65536, 256, 64 * kb, 32 * nn, F.Wpool + (size_t)g * 65536 + (size_t)(32 * nn) * 256, 256, nullptr, F.pool_scale + g * 256, scr, F.lane); continue; } r -= I_POOL;
        if (r < 2 * I_G) { const int up = r >= I_G; if (up) r -= I_G; const int per = (DM / 64) * (DEXP / 32), e = r / per, q = r % per, nb = DEXP / 32, kb = q / nb, nn = q % nb, n0 = 32 * nn;
            const float* W = (up ? F.w_up : F.w_gate) + (size_t)e * DM * DEXP;
            bf16_t* dst = F.Wgu + ((size_t)e * 1024 + (size_t)(n0 >> 7) * 256 + (up ? 128 : 0) + (n0 & 127)) * DM;
            tr_item(W, DEXP, 64 * kb, n0, dst, DM, F.norm_ffn, nullptr, scr, F.lane); continue; } r -= 2 * I_G;
        { const int per = (DEXP / 64) * (DM / 32), e = r / per, q = r % per, nb = DM / 32, kb = q / nb, nn = q % nb;
          tr_item(F.w_down + (size_t)e * DEXP * DM, DM, 64 * kb, 32 * nn, F.Wd + ((size_t)e * DM + 32 * nn) * DEXP, DEXP, nullptr, nullptr, scr, F.lane); }
    }
    for (int m = gw; m < NTOK; m += NGW) {
        const GAS f32x4* xr = (const GAS f32x4*)(F.x + (size_t)m * DM) + F.lane;
        f32x4 v[8]; float s = 0.f;
#pragma unroll
        for (int j = 0; j < 8; ++j) { v[j] = xr[64 * j]; s += (v[j].x * v[j].x + v[j].y * v[j].y) + (v[j].z * v[j].z + v[j].w * v[j].w); }
        s = wave_sum(s);
        if (F.lane == 0) F.rinv[m] = 1.0f / sqrtf(s * (1.0f / DM) + EPS);
        GAS u32x2* o8 = (GAS u32x2*)(F.XB + (size_t)m * DM) + F.lane;
#pragma unroll
        for (int j = 0; j < 8; ++j) { u32x2 w; w.x = pk2(v[j].x, v[j].y); w.y = pk2(v[j].z, v[j].w); o8[64 * j] = w; }
    }
}

constexpr int AT_K = 0, AT_V = 32768, AT_VSTR = 520;
__device__ __forceinline__ void attn_unit(Frame& F, int b, int n, int kvh) {
    LAS unsigned char* lds = F.lds;
    const int tid = F.tid, lane = F.lane, wid = F.wave;
    const size_t tok0 = (size_t)b * SEQ;
#pragma unroll
    for (int i = 0; i < 4; ++i) {
        const int idx = i * 512 + tid, row = idx >> 3, c = idx & 7, pos = n * 128 - 128 + row;
        u32x4 raw = (u32x4){0u, 0u, 0u, 0u};
        if (pos >= 0) raw = *(const GAS u32x4*)(F.PROJ + (tok0 + pos) * INW + KOFF + kvh * HD + c * 8);
        float xv[8] = {bflo(raw.x), bfhi(raw.x), bflo(raw.y), bfhi(raw.y), bflo(raw.z), bfhi(raw.z), bflo(raw.w), bfhi(raw.w)};
        float ss = 0.f;
#pragma unroll
        for (int j = 0; j < 8; ++j) ss += xv[j] * xv[j];
        ss += __shfl_xor(ss, 1); ss += __shfl_xor(ss, 2); ss += __shfl_xor(ss, 4);
        const float rn = 1.0f / sqrtf(ss * (1.0f / HD) + EPS);
#pragma unroll
        for (int j = 0; j < 8; ++j) xv[j] = xv[j] * rn * F.k_norm[c * 8 + j];
        const int pp = pos >= 0 ? pos : 0;
#pragma unroll
        for (int j = 0; j < 8; ++j) { const float pr = __shfl_xor(xv[j], 1); const float cs = F.rope[pp * 16 + j], sn = F.rope[pp * 16 + 8 + j];
            const float r0 = xv[j] * cs - pr * sn, r1 = xv[j] * cs + pr * sn; xv[j] = (c == 0) ? r0 : (c == 1) ? r1 : xv[j]; }
        u32x4 w; w.x = pk2(xv[0], xv[1]); w.y = pk2(xv[2], xv[3]); w.z = pk2(xv[4], xv[5]); w.w = pk2(xv[6], xv[7]);
        *(LAS u32x4*)(lds + AT_K + row * 128 + ((c ^ (row & 7)) * 16)) = w;
    }
#pragma unroll
    for (int i = 0; i < 2; ++i) {
        const int idx = i * 512 + tid, kp = idx >> 3, c = idx & 7, pos = n * 128 - 128 + 2 * kp;
        u32x4 r0 = (u32x4){0u, 0u, 0u, 0u}, r1 = (u32x4){0u, 0u, 0u, 0u};
        if (pos >= 0) { const bf16_t* p = F.PROJ + (tok0 + pos) * INW + VOFF + kvh * HD + c * 8; r0 = *(const GAS u32x4*)p; r1 = *(const GAS u32x4*)(p + INW); }
        const unsigned a0[4] = {r0.x, r0.y, r0.z, r0.w}, a1[4] = {r1.x, r1.y, r1.z, r1.w};
#pragma unroll
        for (int q = 0; q < 4; ++q) {
            const unsigned lo = (a0[q] & 0xffffu) | (a1[q] << 16), hi = (a0[q] >> 16) | (a1[q] & 0xffff0000u);
            *(LAS unsigned*)(lds + AT_V + (c * 8 + 2 * q) * AT_VSTR + kp * 4) = lo;
            *(LAS unsigned*)(lds + AT_V + (c * 8 + 2 * q + 1) * AT_VSTR + kp * 4) = hi;
        }
    }
    __syncthreads();
    const int g = wid & 3, head = kvh * 4 + g, ql = lane & 31, hi = lane >> 5;
    const float sink2 = F.sinks[head] * 1.4426950408889634f;
    const float SC = 0.125f * 1.4426950408889634f;
#pragma unroll 1
    for (int it = 0; it < 2; ++it) {
        const int s = (wid >> 2) + 2 * it;
        const int qpos = n * 128 + 32 * s + ql;
        float qv[4][8];
        const bf16_t* qp = F.PROJ + (tok0 + qpos) * INW + QOFF + head * HD + hi * 8;
        float ss = 0.f;
#pragma unroll
        for (int d0 = 0; d0 < 4; ++d0) { const u32x4 raw = *(const GAS u32x4*)(qp + d0 * 16);
            qv[d0][0] = bflo(raw.x); qv[d0][1] = bfhi(raw.x); qv[d0][2] = bflo(raw.y); qv[d0][3] = bfhi(raw.y); qv[d0][4] = bflo(raw.z); qv[d0][5] = bfhi(raw.z); qv[d0][6] = bflo(raw.w); qv[d0][7] = bfhi(raw.w);
#pragma unroll
            for (int j = 0; j < 8; ++j) ss += qv[d0][j] * qv[d0][j]; }
        ss += __shfl_xor(ss, 32);
        const float rn = 1.0f / sqrtf(ss * (1.0f / HD) + EPS);
#pragma unroll
        for (int d0 = 0; d0 < 4; ++d0)
#pragma unroll
            for (int j = 0; j < 8; ++j) qv[d0][j] = qv[d0][j] * rn * F.q_norm[d0 * 16 + hi * 8 + j];
#pragma unroll
        for (int j = 0; j < 8; ++j) { const float pr = __shfl_xor(qv[0][j], 32); const float cs = F.rope[qpos * 16 + j], sn = F.rope[qpos * 16 + 8 + j];
            qv[0][j] = (hi == 0) ? (qv[0][j] * cs - pr * sn) : (qv[0][j] * cs + pr * sn); }
        bf16x8 qr[4];
#pragma unroll
        for (int d0 = 0; d0 < 4; ++d0) { u32x4 w; w.x = pk2(qv[d0][0] * SC, qv[d0][1] * SC); w.y = pk2(qv[d0][2] * SC, qv[d0][3] * SC); w.z = pk2(qv[d0][4] * SC, qv[d0][5] * SC); w.w = pk2(qv[d0][6] * SC, qv[d0][7] * SC);
            qr[d0] = __builtin_bit_cast(bf16x8, w); }
        f32x16 p[5];
#pragma unroll
        for (int jt = 0; jt < 5; ++jt) {
            const int krow = 32 * (s + jt) + ql;
            f32x16 a = {};
#pragma unroll
            for (int d0 = 0; d0 < 4; ++d0) { const int c = 2 * d0 + hi;
                const bf16x8 kf = *(const LAS bf16x8*)(lds + AT_K + krow * 128 + ((c ^ (krow & 7)) * 16));
                a = __builtin_amdgcn_mfma_f32_32x32x16_bf16(kf, qr[d0], a, 0, 0, 0); }
            p[jt] = a;
        }
        float mx = sink2;
#pragma unroll
        for (int jt = 0; jt < 5; ++jt) {
            const bool blk_dead = (n == 0) && (s + jt < 4);
#pragma unroll
            for (int r = 0; r < 16; ++r) { const int kl = (r & 3) + 8 * (r >> 2) + 4 * hi;
                bool ok = !blk_dead; if (jt == 0) ok = ok && (kl > ql); if (jt == 4) ok = ok && (kl <= ql);
                const float v = ok ? p[jt][r] : -1e30f; p[jt][r] = v; mx = fmaxf(mx, v); }
        }
        mx = fmaxf(mx, __shfl_xor(mx, 32));
        float sum = 0.f;
#pragma unroll
        for (int jt = 0; jt < 5; ++jt)
#pragma unroll
            for (int r = 0; r < 16; ++r) { const float e = __builtin_amdgcn_exp2f(p[jt][r] - mx); p[jt][r] = e; sum += e; }
        sum += __shfl_xor(sum, 32);
        sum += __builtin_amdgcn_exp2f(sink2 - mx);
        const float inv = 1.0f / sum;
        f32x16 o[2]; o[0] = f32x16{}; o[1] = f32x16{};
#pragma unroll
        for (int jt = 0; jt < 5; ++jt)
#pragma unroll
            for (int s2 = 0; s2 < 2; ++s2) {
                u32x4 pw; pw.x = cvt_pk_bf16(p[jt][8 * s2 + 0] * inv, p[jt][8 * s2 + 1] * inv); pw.y = cvt_pk_bf16(p[jt][8 * s2 + 2] * inv, p[jt][8 * s2 + 3] * inv);
                pw.z = cvt_pk_bf16(p[jt][8 * s2 + 4] * inv, p[jt][8 * s2 + 5] * inv); pw.w = cvt_pk_bf16(p[jt][8 * s2 + 6] * inv, p[jt][8 * s2 + 7] * inv);
                const bf16x8 pf = __builtin_bit_cast(bf16x8, pw);
                const int kb = 32 * (s + jt) + 16 * s2 + 4 * hi;
#pragma unroll
                for (int dt = 0; dt < 2; ++dt) {
                    const LAS unsigned char* vp = lds + AT_V + (dt * 32 + ql) * AT_VSTR + kb * 2;
                    const u32x2 v0 = *(const LAS u32x2*)vp, v1 = *(const LAS u32x2*)(vp + 16);
                    u32x4 vw; vw.x = v0.x; vw.y = v0.y; vw.z = v1.x; vw.w = v1.y;
                    o[dt] = __builtin_amdgcn_mfma_f32_32x32x16_bf16(pf, __builtin_bit_cast(bf16x8, vw), o[dt], 0, 0, 0);
                }
            }
        bf16_t* op = F.MIXED + (tok0 + n * 128 + 32 * s) * DM + head * HD + ql;
#pragma unroll
        for (int dt = 0; dt < 2; ++dt)
#pragma unroll
            for (int r = 0; r < 16; ++r) { const int q = (r & 3) + 8 * (r >> 2) + 4 * hi; op[(size_t)q * DM + dt * 32] = (bf16_t)f2bf(o[dt][r]); }
    }
    __syncthreads();
}

__device__ __forceinline__ void pool_diff(Frame& F) {
    const int NITEM = (NTOK / 32) * 128;
    for (int it = F.bx * 512 + F.tid; it < NITEM; it += F.G * 512) {
        const int ri = it >> 7, c8 = it & 127, w = 2 << (c8 >> 5), t0 = ri * 32, pos0 = t0 & (SEQ - 1);
        const bf16_t* up = F.PROJ + (size_t)t0 * INW + UOFF + c8 * 8;
        float S[8];
#pragma unroll
        for (int j = 0; j < 8; ++j) S[j] = 0.f;
        for (int i = 1; i < w; ++i) if (pos0 - i >= 0) { const u32x4 raw = *(const GAS u32x4*)(up - (size_t)i * INW);
            S[0] += bflo(raw.x); S[1] += bfhi(raw.x); S[2] += bflo(raw.y); S[3] += bfhi(raw.y); S[4] += bflo(raw.z); S[5] += bfhi(raw.z); S[6] += bflo(raw.w); S[7] += bfhi(raw.w); }
#pragma unroll 4
        for (int t = 0; t < 32; ++t) {
            const u32x4 raw = *(const GAS u32x4*)(up + (size_t)t * INW);
            const float xv[8] = {bflo(raw.x), bfhi(raw.x), bflo(raw.y), bfhi(raw.y), bflo(raw.z), bfhi(raw.z), bflo(raw.w), bfhi(raw.w)};
            const int pos = pos0 + t; const float ic = 1.0f / (float)((pos + 1 < w) ? (pos + 1) : w);
            float d[8];
#pragma unroll
            for (int j = 0; j < 8; ++j) { S[j] += xv[j]; d[j] = S[j] * ic - xv[j]; }
            u32x4 o; o.x = pk2(d[0], d[1]); o.y = pk2(d[2], d[3]); o.z = pk2(d[4], d[5]); o.w = pk2(d[6], d[7]);
            *(GAS u32x4*)(F.DPOOL + (size_t)(t0 + t) * PW + c8 * 8) = o;
            if (pos - w + 1 >= 0) { const u32x4 old = *(const GAS u32x4*)(up + (ptrdiff_t)(t - w + 1) * INW);
                S[0] -= bflo(old.x); S[1] -= bfhi(old.x); S[2] -= bflo(old.y); S[3] -= bfhi(old.y); S[4] -= bflo(old.z); S[5] -= bfhi(old.z); S[6] -= bflo(old.w); S[7] -= bfhi(old.w); }
        }
    }
}

constexpr int RT_WSTR = 528, RT_W = 0, RT_WLO = 64 * RT_WSTR, RT_L = 2 * 64 * RT_WSTR, RT_LSTR = 65;
__device__ __forceinline__ void route_phase(Frame& F) {
    LAS unsigned char* lds = F.lds;
    const int tid = F.tid, lane = F.lane, wid = F.wave, row = lane & 15, kq = lane >> 4;
    for (int tile = F.bx; tile < NTOK / 128; tile += F.G) {
        const int t0 = tile * 128 + wid * 16;
        const float* hp = F.out + (size_t)(t0 + row) * DM + kq * 8;
        bf16_t* hb = F.XB + (size_t)(t0 + row) * DM + kq * 8;
        f32x4 acc[4]; acc[0] = acc[1] = acc[2] = acc[3] = (f32x4){0.f, 0.f, 0.f, 0.f};
        float ssq = 0.f;
#pragma unroll 1
        for (int kc = 0; kc < 8; ++kc) {
            __syncthreads();
#pragma unroll
            for (int i = 0; i < 8; ++i) { const int p = i * 512 + tid, which = p >> 11, col = (p & 2047) >> 5, ch = p & 31;
                const u32x4 v = *(const GAS u32x4*)(F.Wr + (size_t)which * 64 * DM + (size_t)col * DM + kc * 256 + ch * 8);
                *(LAS u32x4*)(lds + which * RT_WLO + col * RT_WSTR + ch * 16) = v; }
            __syncthreads();
#pragma unroll 4
            for (int ks = 0; ks < 8; ++ks) {
                const int k = kc * 256 + ks * 32;
                const f32x4 v0 = *(const GAS f32x4*)(hp + k), v1 = *(const GAS f32x4*)(hp + k + 4);
                const float xv[8] = {v0.x, v0.y, v0.z, v0.w, v1.x, v1.y, v1.z, v1.w};
                unsigned hi16[8]; float lo[8];
#pragma unroll
                for (int j = 0; j < 8; ++j) { ssq += xv[j] * xv[j]; hi16[j] = f2bf(xv[j]); lo[j] = xv[j] - bflo(hi16[j]); }
                u32x4 ah; ah.x = hi16[0] | (hi16[1] << 16); ah.y = hi16[2] | (hi16[3] << 16); ah.z = hi16[4] | (hi16[5] << 16); ah.w = hi16[6] | (hi16[7] << 16);
                u32x4 al; al.x = pk2(lo[0], lo[1]); al.y = pk2(lo[2], lo[3]); al.z = pk2(lo[4], lo[5]); al.w = pk2(lo[6], lo[7]);
                *(GAS u32x4*)(hb + k) = ah;
                const bf16x8 Ah = __builtin_bit_cast(bf16x8, ah), Al = __builtin_bit_cast(bf16x8, al);
#pragma unroll
                for (int tc = 0; tc < 4; ++tc) {
                    const LAS unsigned char* bp = lds + (tc * 16 + row) * RT_WSTR + (ks * 32 + kq * 8) * 2;
                    const bf16x8 Bh = *(const LAS bf16x8*)bp, Bl = *(const LAS bf16x8*)(bp + RT_WLO);
                    acc[tc] = __builtin_amdgcn_mfma_f32_16x16x32_bf16(Ah, Bh, acc[tc], 0, 0, 0);
                    acc[tc] = __builtin_amdgcn_mfma_f32_16x16x32_bf16(Al, Bh, acc[tc], 0, 0, 0);
                    acc[tc] = __builtin_amdgcn_mfma_f32_16x16x32_bf16(Ah, Bl, acc[tc], 0, 0, 0);
                }
            }
        }
        ssq += __shfl_xor(ssq, 16); ssq += __shfl_xor(ssq, 32);
        const float rt = 1.0f / sqrtf(ssq * (1.0f / DM) + EPS);
        LAS float* L = (LAS float*)(lds + RT_L) + wid * 16 * RT_LSTR;
#pragma unroll
        for (int tc = 0; tc < 4; ++tc)
#pragma unroll
            for (int r = 0; r < 4; ++r) L[(kq * 4 + r) * RT_LSTR + tc * 16 + row] = acc[tc][r];
        __syncthreads();
        if (lane < 16) {
            const int t = t0 + lane; const LAS float* Lt = L + lane * RT_LSTR;
            float c[4]; int grp = 0; float cm;
#pragma unroll
            for (int j = 0; j < 4; ++j) c[j] = Lt[j] * rt + F.b_coarse[j];
            cm = c[0];
#pragma unroll
            for (int j = 1; j < 4; ++j) if (c[j] > cm) { cm = c[j]; grp = j; }
            float den = 0.f;
#pragma unroll
            for (int j = 0; j < 4; ++j) den += __expf(c[j] - cm);
            const float pg = 1.0f / den;
            float f[8];
#pragma unroll
            for (int j = 0; j < 8; ++j) f[j] = Lt[4 + grp * 8 + j] * rt + F.b_fine[grp * 8 + j];
            int i1 = 0; float l1 = f[0];
#pragma unroll
            for (int j = 1; j < 8; ++j) if (f[j] > l1) { l1 = f[j]; i1 = j; }
            int i2 = -1; float l2 = -3.0e38f;
#pragma unroll
            for (int j = 0; j < 8; ++j) if (j != i1 && f[j] > l2) { l2 = f[j]; i2 = j; }
            const float e2 = __expf(l2 - l1), g1 = pg / (1.0f + e2), g2 = pg * e2 / (1.0f + e2);
            F.rtok[t] = rt; F.gate[2 * t] = g1; F.gate[2 * t + 1] = g2;
            const int e1 = grp * 8 + i1, ee2 = grp * 8 + i2;
            const unsigned p1 = __hip_atomic_fetch_add((unsigned*)(F.ctl + CW_CNT + 64 * e1), 1u, RLX_AGENT);
            F.rowl[(size_t)e1 * RCAP + p1] = 2 * t;
            const unsigned p2 = __hip_atomic_fetch_add((unsigned*)(F.ctl + CW_CNT + 64 * ee2), 1u, RLX_AGENT);
            F.rowl[(size_t)ee2 * RCAP + p2] = 2 * t + 1;
        }
    }
}

__device__ __forceinline__ void moe_setup(Frame& F, int nN) {
    LAS int* expt = (LAS int*)(F.lds + EXPT_OFF); LAS int* tab = (LAS int*)(F.lds + TAB_OFF);
    __syncthreads();
    if (F.tid == 0) { int acc = 0;
        for (int e = 0; e < NEXP; ++e) { const int cnt = (int)__hip_atomic_load((unsigned*)(F.ctl + CW_CNT + 64 * e), RLX_AGENT); expt[e] = acc; expt[33 + e] = cnt; acc += ((cnt + 255) >> 8) * nN; }
        expt[32] = acc; }
    __syncthreads();
    pg8::MoeProb P; P.expt = expt; P.nN = nN; P.G = F.G; P.c = F.bx;
    pg8::Unit u;
    for (int i = 0; P.next(i, u); ++i) {
        if (F.tid < 256) { const int j = u.pm * 256 + F.tid; const int cnt = expt[33 + u.e];
            const int v = F.rowl[(size_t)u.e * RCAP + (j < cnt ? j : 0)];
            tab[i * 256 + F.tid] = (j < cnt) ? v : (v | (int)0x80000000); }
    }
    __syncthreads();
}

__device__ __forceinline__ void combine_phase(Frame& F) {
    const size_t NIT = (size_t)NTOK * (DM / 8);
    for (size_t it = (size_t)F.bx * 512 + F.tid; it < NIT; it += (size_t)F.G * 512) {
        const size_t t = it >> 8; const int c = (int)(it & 255) * 8;
        float* op = F.out + t * DM + c;
        const f32x4 h0 = *(const GAS f32x4*)op, h1 = *(const GAS f32x4*)(op + 4);
        const u32x4 y0 = *(const GAS u32x4*)(F.Y + (2 * t) * DM + c), y1 = *(const GAS u32x4*)(F.Y + (2 * t + 1) * DM + c);
        f32x4 o0, o1;
        o0.x = h0.x + bflo(y0.x) + bflo(y1.x); o0.y = h0.y + bfhi(y0.x) + bfhi(y1.x); o0.z = h0.z + bflo(y0.y) + bflo(y1.y); o0.w = h0.w + bfhi(y0.y) + bfhi(y1.y);
        o1.x = h1.x + bflo(y0.z) + bflo(y1.z); o1.y = h1.y + bfhi(y0.z) + bfhi(y1.z); o1.z = h1.z + bflo(y0.w) + bflo(y1.w); o1.w = h1.w + bfhi(y0.w) + bfhi(y1.w);
        *(GAS f32x4*)op = o0; *(GAS f32x4*)(op + 4) = o1;
    }
}

struct Args { const float* in[17]; float* out; unsigned char* ws; int ph_lo, ph_hi, use_bar, pad; };
__global__ void __launch_bounds__(512, 2) hymba_fwd(Args args) {
    extern __shared__ __attribute__((aligned(16))) unsigned char lds[];
    Frame F;
    F.lds = (LAS unsigned char*)lds;
    F.tid = threadIdx.x; F.lane = F.tid & 63; F.wave = __builtin_amdgcn_readfirstlane(F.tid >> 6);
    F.G = gridDim.x; F.bx = blockIdx.x;
    unsigned char* ws = args.ws;
    F.ctl = (gu32*)(ws + WS_CTL);
    F.x = args.in[0]; F.norm_mix = args.in[1]; F.w_in = args.in[2]; F.q_norm = args.in[3]; F.k_norm = args.in[4]; F.sinks = args.in[5]; F.w_pool = args.in[6]; F.pool_scale = args.in[7];
    F.w_out = args.in[8]; F.norm_ffn = args.in[9]; F.w_coarse = args.in[10]; F.b_coarse = args.in[11]; F.w_fine = args.in[12]; F.b_fine = args.in[13]; F.w_gate = args.in[14]; F.w_up = args.in[15]; F.w_down = args.in[16];
    F.out = args.out;
    F.rope = (float*)(ws + WS_ROPE); F.rinv = (float*)(ws + WS_RINV); F.rtok = (float*)(ws + WS_RTOK); F.gate = (float*)(ws + WS_GATE);
    F.Wr = (bf16_t*)(ws + WS_WR); F.Wpool = (bf16_t*)(ws + WS_WPOOL); F.Win = (bf16_t*)(ws + WS_WIN); F.Wout = (bf16_t*)(ws + WS_WOUT); F.Wgu = (bf16_t*)(ws + WS_WGU); F.Wd = (bf16_t*)(ws + WS_WD);
    F.XB = (bf16_t*)(ws + WS_XB); F.PROJ = (bf16_t*)(ws + WS_PROJ); F.MIXED = (bf16_t*)(ws + WS_MIXED); F.DPOOL = (bf16_t*)(ws + WS_DPOOL); F.ACT = (bf16_t*)(ws + WS_ACT); F.Y = (bf16_t*)(ws + WS_Y);
    F.rowl = (int*)(ws + WS_ROWL);
    if (F.tid < 4) ((LAS unsigned*)(F.lds + MISC_OFF))[F.tid] = 0u;
    __syncthreads();
    XcdBarrier bar; bar.bar = (unsigned*)(F.ctl + CW_BAR); bar.x = 0; bar.st = nullptr;
    if (args.use_bar) bar = xcd_barrier_post((unsigned*)(F.ctl + CW_BAR), (volatile LAS unsigned*)(F.lds + MISC_OFF));
    const int lo = args.ph_lo, hi = args.ph_hi;
#define IN(k) (lo <= (k) && (k) < hi)
#define SEAM(k) do { if (IN(k) && IN((k) + 1)) xcd_barrier(bar); } while (0)

    if (IN(0)) { p0_prologue(F); SEAM(0); }
    if (IN(1)) {
        pg8::DenseProb P; P.A = F.XB; P.Bt = F.Win; P.lda = DM; P.K = DM; P.acol = 0; P.so.init(NTOK, INW, F.G, F.bx);
        pg8::EpiRowScaleBf16 E{F.PROJ, INW, F.rinv};
        pg8::gemm_phase(F.lds, P, E);
        SEAM(1);
    }
    if (IN(2)) {
        for (int u = F.bx; u < BATCH * (SEQ / 128) * NKV; u += F.G) { const int kvh = u & 3, n = (u >> 2) & 31, b = u >> 7; attn_unit(F, b, n, kvh); }
        pool_diff(F);
        SEAM(2);
    }
    if (IN(3)) {
        pg8::DenseProb P; P.A = F.DPOOL; P.Bt = F.Wpool; P.lda = PW; P.K = 256; P.acol = 256; P.so.init(NTOK, PW, F.G, F.bx);
        pg8::EpiBf16 E{F.MIXED, DM, 1024};
        pg8::gemm_phase(F.lds, P, E);
        SEAM(3);
    }
    if (IN(4)) {
        pg8::DenseProb P; P.A = F.MIXED; P.Bt = F.Wout; P.lda = DM; P.K = DM; P.acol = 0; P.so.init(NTOK, DM, F.G, F.bx);
        pg8::EpiResF32 E{F.x, F.out, DM};
        pg8::gemm_phase(F.lds, P, E);
        SEAM(4);
    }
    if (IN(5)) { route_phase(F); SEAM(5); }
    if (IN(6)) {
        moe_setup(F, 4);
        pg8::MoeProb P; P.A = F.XB; P.Bt = F.Wgu; P.lda = DM; P.K = DM; P.nN = 4; P.shift = 1; P.tab = (LAS const int*)(F.lds + TAB_OFF); P.expt = (LAS const int*)(F.lds + EXPT_OFF); P.G = F.G; P.c = F.bx;
        pg8::EpiSwiGLU E{F.ACT, F.rtok, F.gate, (LAS const int*)(F.lds + TAB_OFF)};
        pg8::gemm_phase(F.lds, P, E);
        SEAM(6);
    }
    if (IN(7)) {
        moe_setup(F, 8);
        pg8::MoeProb P; P.A = F.ACT; P.Bt = F.Wd; P.lda = DEXP; P.K = DEXP; P.nN = 8; P.shift = 0; P.tab = (LAS const int*)(F.lds + TAB_OFF); P.expt = (LAS const int*)(F.lds + EXPT_OFF); P.G = F.G; P.c = F.bx;
        pg8::EpiScatterBf16 E{F.Y, DM, (LAS const int*)(F.lds + TAB_OFF)};
        pg8::gemm_phase(F.lds, P, E);
        SEAM(7);
    }
    if (IN(8)) { combine_phase(F); }
#undef IN
#undef SEAM
}

extern "C" void kernel_launch(void* const* d_in, const int* in_sizes, int n_in, void* d_out, int out_size, void* d_ws, size_t ws_size, hipStream_t stream) {
    static int grid = 0;
    if (grid == 0) {
        if (n_in != 17 || out_size != NTOK * DM || ws_size < WS_END) { fprintf(stderr, "kernel_launch: unexpected problem (n_in %d, out %d, ws %zu)\n", n_in, out_size, ws_size); grid = -1; return; }
        int dev = 0, cus = 0;
        if (hipGetDevice(&dev) != hipSuccess || hipDeviceGetAttribute(&cus, hipDeviceAttributeMultiprocessorCount, dev) != hipSuccess) { grid = -1; return; }
        if (hipFuncSetAttribute((const void*)hymba_fwd, hipFuncAttributeMaxDynamicSharedMemorySize, LDS_BYTES) != hipSuccess) { fprintf(stderr, "kernel_launch: hipFuncSetAttribute failed\n"); grid = -1; return; }
        int per_cu = 0;
        if (hipOccupancyMaxActiveBlocksPerMultiprocessor(&per_cu, (const void*)hymba_fwd, 512, LDS_BYTES) != hipSuccess || per_cu < 1) { fprintf(stderr, "kernel_launch: occupancy query says %d\n", per_cu); }
        (void)hipGetLastError();
        grid = cus - (cus % 8);
        if (grid <= 0) grid = -1;
    }
    if (grid < 0) return;
    if (hipMemsetAsync((char*)d_ws + WS_CTL, 0, CTL_ZERO_BYTES, stream) != hipSuccess) return;
    Args a{};
    for (int i = 0; i < 17; ++i) a.in[i] = (const float*)d_in[i];
    a.out = (float*)d_out; a.ws = (unsigned char*)d_ws;
    if (MK_N_LAUNCHES == 1) { a.ph_lo = 0; a.ph_hi = NPHASE; a.use_bar = 1; hipLaunchKernelGGL(hymba_fwd, dim3(grid), dim3(512), LDS_BYTES, stream, a); }
    else for (int p = 0; p < NPHASE; ++p) { a.ph_lo = p; a.ph_hi = p + 1; a.use_bar = 0; hipLaunchKernelGGL(hymba_fwd, dim3(grid), dim3(512), LDS_BYTES, stream, a); }
}
```

```cpp
#include <hip/hip_runtime.h>
#include <cstdio>
#include <cstdint>

#ifndef MK_N_LAUNCHES
#define MK_N_LAUNCHES 1
#endif

#define GAS __attribute__((address_space(1)))
#define LAS __attribute__((address_space(3)))
typedef unsigned short bf16_t;
typedef short bf16x8 __attribute__((ext_vector_type(8)));
typedef short s16x4 __attribute__((ext_vector_type(4)));
typedef float f32x4 __attribute__((ext_vector_type(4)));
typedef float f32x2 __attribute__((ext_vector_type(2)));
typedef float f32x16 __attribute__((ext_vector_type(16)));
typedef unsigned u32x4 __attribute__((ext_vector_type(4)));
typedef unsigned u32x2 __attribute__((ext_vector_type(2)));
typedef GAS unsigned gu32;

constexpr int BATCH = 8, SEQ = 4096, NTOK = BATCH * SEQ, DM = 2048;
constexpr int NH = 16, NKV = 4, HD = 64, INW = 2560, QOFF = 0, KOFF = 1024, VOFF = 1280, UOFF = 1536, PW = 1024;
constexpr int NEXP = 32, DEXP = 512, NASG = NTOK * 2, RCAP = NASG;
constexpr float EPS = 1e-6f;
constexpr int NPHASE = 9;

constexpr size_t MiB = 1u << 20;
constexpr size_t WS_CTL = 0, CTL_ZERO_BYTES = 64 * 1024;
constexpr size_t WS_ROPE = 1 * MiB;
constexpr size_t WS_RINV = WS_ROPE + 256 * 1024;
constexpr size_t WS_RTOK = WS_RINV + 128 * 1024;
constexpr size_t WS_GATE = WS_RTOK + 128 * 1024;
constexpr size_t WS_WR = 2 * MiB;
constexpr size_t WS_WPOOL = WS_WR + 512 * 1024;
constexpr size_t WS_WIN = 3 * MiB;
constexpr size_t WS_WOUT = 13 * MiB;
constexpr size_t WS_ROWL = 21 * MiB;
constexpr size_t WS_WGU = 29 * MiB;
constexpr size_t WS_WD = 157 * MiB;
constexpr size_t WS_XB = 221 * MiB;
constexpr size_t WS_PROJ = 349 * MiB;
constexpr size_t WS_MIXED = 509 * MiB;
constexpr size_t WS_DPOOL = 637 * MiB;
constexpr size_t WS_ACT = WS_DPOOL;
constexpr size_t WS_Y = WS_PROJ;
constexpr size_t WS_END = 701 * MiB;
static_assert(WS_Y + (size_t)NASG * DM * 2 <= WS_DPOOL, "Y overlay");
constexpr int CW_TMO = 0, CW_BAR = 1024, CW_CNT = 8192;

constexpr int RING_BYTES = 131072;
constexpr int TAB_OFF = RING_BYTES;
constexpr int TAB_UNITS = 14;
constexpr int EXPT_OFF = TAB_OFF + TAB_UNITS * 1024;
constexpr int MISC_OFF = EXPT_OFF + 512;
constexpr int LDS_BYTES = 147456;
static_assert(MISC_OFF + 16 <= LDS_BYTES, "LDS map");

#define RLX_AGENT __ATOMIC_RELAXED, __HIP_MEMORY_SCOPE_AGENT
#define LDS_WAIT() asm volatile("s_waitcnt lgkmcnt(0)" ::: "memory")
#define VM_WAIT() asm volatile("s_waitcnt vmcnt(0)" ::: "memory")

__device__ __forceinline__ unsigned f2bf(float f) { unsigned u = __builtin_bit_cast(unsigned, f); return (u + 0x7fffu + ((u >> 16) & 1u)) >> 16; }
__device__ __forceinline__ unsigned pk2(float lo, float hi) { return f2bf(lo) | (f2bf(hi) << 16); }
__device__ __forceinline__ float bflo(unsigned w) { return __builtin_bit_cast(float, w << 16); }
__device__ __forceinline__ float bfhi(unsigned w) { return __builtin_bit_cast(float, w & 0xffff0000u); }
__device__ __forceinline__ unsigned cvt_pk_bf16(float lo, float hi) { unsigned r; asm volatile("v_cvt_pk_bf16_f32 %0, %1, %2" : "=v"(r) : "v"(lo), "v"(hi)); return r; }
__device__ __forceinline__ float wave_sum(float v) {
#pragma unroll
    for (int o = 1; o < 64; o <<= 1) v += __shfl_xor(v, o);
    return v;
}

#define XB_TMO      128
#define XB_XCNT(j)  (256  + 64 * (j))
#define XB_XSUB(j)  (1280 + 64 * (j))
#define XB_XGEN(j)  (2304 + 64 * (j))
#define XB_TOP      3328
#define XB_TOPGEN   3392
#define XCD_BAR_WORDS 3456
#define XB_SPIN_CAP (1u << 18)
__device__ __forceinline__ unsigned xb_ld(unsigned* p)              { return __hip_atomic_load(p, __ATOMIC_RELAXED, __HIP_MEMORY_SCOPE_AGENT); }
__device__ __forceinline__ unsigned xb_add(unsigned* p, unsigned v) { return __hip_atomic_fetch_add(p, v, __ATOMIC_RELAXED, __HIP_MEMORY_SCOPE_AGENT); }
__device__ __forceinline__ unsigned xb_xcc_id() { return (unsigned)__builtin_amdgcn_s_getreg((3 << 11) | 20) & 0xFu; }
#define XB_SPIN(cond, bar) do { unsigned _sp = 0; while (cond) { __builtin_amdgcn_s_sleep(1); \
    if ((++_sp & 255u) == 0u) { if (xb_ld(&(bar)[XB_TMO])) break; if (_sp > XB_SPIN_CAP) { atomicAdd(&(bar)[XB_TMO], 1u); break; } } } } while (0)
struct XcdBarrier { unsigned* bar; unsigned x; volatile LAS unsigned* st; };
__device__ __forceinline__ XcdBarrier xcd_barrier_post(unsigned* bar, volatile LAS unsigned* st) {
    XcdBarrier b; b.bar = bar; b.x = xb_xcc_id(); b.st = st;
    if (threadIdx.x == 0) (void)xb_add(&bar[XB_XCNT(b.x)], 1u);
    return b;
}
__device__ __forceinline__ void xcd_barrier_complete(unsigned* bar, unsigned x, unsigned& nloc, unsigned& nx) {
    const unsigned G = gridDim.x * gridDim.y * gridDim.z;
    unsigned sum, cnt, mine, sp = 0u;
    for (;;) {
        sum = 0u; cnt = 0u; mine = 0u;
#pragma unroll
        for (unsigned j = 0; j < 16; ++j) { const unsigned c = xb_ld(&bar[XB_XCNT(j)]); sum += c; cnt += (c > 0u) ? 1u : 0u; mine = (j == x) ? c : mine; }
        if (sum == G) break;
        __builtin_amdgcn_s_sleep(1);
        if ((++sp & 255u) == 0u) { if (xb_ld(&bar[XB_TMO])) break; if (sp > XB_SPIN_CAP) { atomicAdd(&bar[XB_TMO], 1u); break; } }
    }
    nloc = mine > 0u ? mine : 1u; nx = cnt > 0u ? cnt : 1u;
}
__device__ __forceinline__ void xcd_barrier(const XcdBarrier& b) {
    asm volatile("s_waitcnt vmcnt(0)" ::: "memory");
    __syncthreads();
    if (threadIdx.x == 0) {
        unsigned* bar = b.bar;
        __builtin_amdgcn_s_waitcnt(0);
        unsigned nloc = b.st[0], nx = b.st[1];
        if (nloc == 0u) { xcd_barrier_complete(bar, b.x, nloc, nx); b.st[0] = nloc; b.st[1] = nx; }
        const unsigned old = xb_add(&bar[XB_XSUB(b.x)], 1u);
        const unsigned gen = old / nloc;
        if (old + 1u == (gen + 1u) * nloc) {
            __builtin_amdgcn_fence(__ATOMIC_RELEASE, "agent");
            asm volatile("s_waitcnt vmcnt(0)" ::: "memory");
            const unsigned og = xb_add(&bar[XB_TOP], 1u);
            const unsigned tg = og / nx;
            if (og + 1u == (tg + 1u) * nx) xb_add(&bar[XB_TOPGEN], 1u);
            else XB_SPIN(xb_ld(&bar[XB_TOPGEN]) == tg, bar);
            __builtin_amdgcn_fence(__ATOMIC_ACQUIRE, "agent");
            xb_add(&bar[XB_XGEN(b.x)], 1u);
            asm volatile("s_waitcnt vmcnt(0)" ::: "memory");
        } else {
            XB_SPIN(xb_ld(&bar[XB_XGEN(b.x)]) == gen, bar);
            __builtin_amdgcn_fence(__ATOMIC_ACQUIRE, "agent");
            asm volatile("s_waitcnt vmcnt(0)" ::: "memory");
        }
    }
    __syncthreads();
}

namespace pg8 {
constexpr int BM = 256, BK = 64, HALF = 128, HTB = HALF * BK * 2, STAGE_BYTES = 8 * HTB, NXCD = 8, WGM = 8;
static_assert(STAGE_BYTES == RING_BYTES, "stage region");
__host__ __device__ __forceinline__ int lds_byte(int r, int c) { const int st = (r >> 4) * 2 + (c >> 5), rr = r & 15, cc = c & 31, ob = rr * 64 + cc * 2; return st * 1024 + (ob ^ (((ob >> 9) & 1) << 5)); }
__host__ __device__ __forceinline__ void stage_rc(int b, int& R, int& C) { const int st = b / 1024, sb = b % 1024, swz = sb ^ (((sb >> 9) & 1) << 5); R = (st >> 1) * 16 + swz / 64; C = (st & 1) * 32 + (swz % 64) / 2; }
__host__ __device__ __forceinline__ int perm32(int rho) { const int n = rho >> 4, i = rho & 15; return 8 * (i >> 2) + 4 * n + (i & 3); }

struct Unit { int pm, pn, ord, e, cnt; };

struct StaticOrder {
    int nM, nN, nwg, G, c;
    __device__ void init(int M, int N, int G_, int c_) { nM = M / BM; nN = N / BM; nwg = nM * nN; G = G_; c = c_; }
    __device__ bool next(int i, int& pm, int& pn) const {
        const long L = (long)i * G + c; if (L >= nwg) return false;
        int wgid = (int)L; { const int q = nwg / NXCD, r = nwg % NXCD, xcd = wgid % NXCD, off = wgid / NXCD; wgid = (xcd < r ? xcd * (q + 1) : r * (q + 1) + (xcd - r) * q) + off; }
        const int nig = WGM * nN, gid = wgid / nig, fm = gid * WGM, gsz = (nM - fm) < WGM ? (nM - fm) : WGM;
        pm = fm + ((wgid % nig) % gsz); pn = (wgid % nig) / gsz; return true;
    }
};

template <class Epi, class Prob>
__device__ __forceinline__ void gemm_phase(LAS unsigned char* lds, const Prob& S, const Epi& E) {
    const int tid = threadIdx.x, wid = __builtin_amdgcn_readfirstlane(tid >> 6), lane = tid & 63, wr = wid >> 2, wc = wid & 3, fr = lane & 15, fq = lane >> 4;
    const int K = S.K, nt = K / BK;
    int Rr[2], Cc[2]; unsigned voffB[2];
#pragma unroll
    for (int i = 0; i < 2; ++i) { stage_rc(tid * 16 + i * 8192, Rr[i], Cc[i]); const int Rb = Epi::PERM ? ((Rr[i] & ~31) + perm32(Rr[i] & 31)) : Rr[i]; voffB[i] = (unsigned)(Rb * K + Cc[i]) * 2u; }
    const size_t kstep = (size_t)(BK * 2);
    const size_t hstep = (size_t)HALF * K * 2;
    const unsigned ldsw = (unsigned)wid * 1024u;
    const int aoff = lds_byte(wr * 64 + fr, fq * 8), boff = lds_byte(wc * 32 + fr, fq * 8);
#define PG8_SA(b, h) (((b) * 2 + (h)) * HTB)
#define PG8_SB(b, h) ((4 + (b) * 2 + (h)) * HTB)
#define PG8_STAGE(bufoff, gbase, voff) do { _Pragma("unroll") for (int _i = 0; _i < 2; ++_i) \
        __builtin_amdgcn_global_load_lds((const unsigned*)((const char*)(gbase) + (voff)[_i]), (LAS unsigned*)(lds + (bufoff) + ldsw + _i * 8192), 16, 0, 0); } while (0)
#define PG8_LDA(dst, b, h) do { _Pragma("unroll") for (int m = 0; m < 4; ++m) _Pragma("unroll") for (int k = 0; k < 2; ++k) dst[m][k] = *(const LAS bf16x8*)(lds + PG8_SA(b, h) + aoff + m * 2048 + k * 1024); } while (0)
#define PG8_LDB(dst, b, h) do { _Pragma("unroll") for (int n = 0; n < 2; ++n) _Pragma("unroll") for (int k = 0; k < 2; ++k) dst[n][k] = *(const LAS bf16x8*)(lds + PG8_SB(b, h) + boff + n * 2048 + k * 1024); } while (0)
#define PG8_MMA(ai, bj, At, Bt) do { __builtin_amdgcn_s_setprio(1); _Pragma("unroll") for (int m = 0; m < 4; ++m) _Pragma("unroll") for (int n = 0; n < 2; ++n) _Pragma("unroll") for (int k = 0; k < 2; ++k) \
        acc[ai][bj][m][n] = __builtin_amdgcn_mfma_f32_16x16x32_bf16(Bt[n][k], At[m][k], acc[ai][bj][m][n], 0, 0, 0); __builtin_amdgcn_s_setprio(0); } while (0)
#define PG8_WAIT_V(n) asm volatile("s_waitcnt vmcnt(" #n ")" ::: "memory")
#define PG8_WAIT_L(n) asm volatile("s_waitcnt lgkmcnt(" #n ")" ::: "memory")
#define PG8_BAR __builtin_amdgcn_s_barrier()
#define PG8_SCHED __builtin_amdgcn_sched_barrier(0)
    Unit cur, nxt; int ui = 0;
    if (!S.next(0, cur)) return;
    f32x4 acc[2][2][4][2];
#pragma unroll
    for (int a = 0; a < 2; ++a)
#pragma unroll
        for (int b = 0; b < 2; ++b)
#pragma unroll
            for (int m = 0; m < 4; ++m)
#pragma unroll
                for (int n = 0; n < 2; ++n) acc[a][b][m][n] = (f32x4){0.f, 0.f, 0.f, 0.f};
    bf16x8 At[4][2], B0[2][2], B1[2][2];
    unsigned vc[2][2], vn[2][2];
    S.a_voff(cur, Rr, Cc, vc);
    const char* cA = S.a_base(cur); const char* cB = S.b_base(cur);
    PG8_STAGE(PG8_SB(0, 0), cB, voffB); PG8_STAGE(PG8_SB(0, 1), cB + hstep, voffB); PG8_STAGE(PG8_SA(0, 0), cA, vc[0]); PG8_STAGE(PG8_SA(0, 1), cA, vc[1]);
    if (wr == 1) PG8_BAR;
    PG8_WAIT_V(2); PG8_BAR;
    PG8_STAGE(PG8_SB(1, 0), cB + kstep, voffB); PG8_STAGE(PG8_SA(1, 0), cA + kstep, vc[0]); PG8_STAGE(PG8_SB(1, 1), cB + hstep + kstep, voffB);
    PG8_WAIT_V(6); PG8_BAR;
    for (;;) {
        const bool has_next = S.next(ui + 1, nxt);
        const char* nA = has_next ? S.a_base(nxt) : cA; const char* nB = has_next ? S.b_base(nxt) : cB;
        if (has_next) S.a_voff(nxt, Rr, Cc, vn); else { vn[0][0] = vc[0][0]; vn[0][1] = vc[0][1]; vn[1][0] = vc[1][0]; vn[1][1] = vc[1][1]; }
        for (int t = 0; t < nt; t += 2) {
            const bool last = (t == nt - 2);
            const char* a1 = cA + (size_t)(t + 1) * kstep;
            const char* a2 = last ? nA : cA + (size_t)(t + 2) * kstep; const char* b2 = last ? nB : cB + (size_t)(t + 2) * kstep;
            const char* a3 = a2 + kstep; const char* b3 = b2 + kstep;
            unsigned w0[2], w1[2]; w0[0] = last ? vn[0][0] : vc[0][0]; w0[1] = last ? vn[0][1] : vc[0][1]; w1[0] = last ? vn[1][0] : vc[1][0]; w1[1] = last ? vn[1][1] : vc[1][1];
            PG8_LDB(B0, 0, 0); PG8_LDB(B1, 0, 1); PG8_SCHED; PG8_LDA(At, 0, 0); PG8_STAGE(PG8_SA(1, 1), a1, vc[1]);
            PG8_WAIT_V(8); PG8_WAIT_L(0); PG8_BAR; PG8_MMA(0, 0, At, B0); PG8_MMA(0, 1, At, B1); PG8_BAR; PG8_SCHED;
            PG8_LDA(At, 0, 1); PG8_STAGE(PG8_SB(0, 0), b2, voffB); PG8_STAGE(PG8_SB(0, 1), b2 + hstep, voffB); PG8_STAGE(PG8_SA(0, 0), a2, w0);
            PG8_WAIT_V(8); PG8_WAIT_L(0); PG8_BAR; PG8_MMA(1, 0, At, B0); PG8_MMA(1, 1, At, B1); PG8_BAR; PG8_SCHED;
            PG8_LDB(B0, 1, 0); PG8_LDB(B1, 1, 1); PG8_SCHED; PG8_LDA(At, 1, 0); PG8_STAGE(PG8_SA(0, 1), a2, w1);
            PG8_WAIT_V(8); PG8_WAIT_L(0); PG8_BAR; PG8_MMA(0, 0, At, B0); PG8_MMA(0, 1, At, B1); PG8_BAR; PG8_SCHED;
            PG8_LDA(At, 1, 1); PG8_STAGE(PG8_SB(1, 0), b3, voffB); PG8_STAGE(PG8_SB(1, 1), b3 + hstep, voffB); PG8_STAGE(PG8_SA(1, 0), a3, w0);
            PG8_WAIT_V(8); PG8_WAIT_L(0); PG8_BAR; PG8_MMA(1, 0, At, B0); PG8_MMA(1, 1, At, B1); PG8_BAR; PG8_SCHED;
        }
        if (wr == 0) PG8_BAR;
        E(acc, cur, wr, wc, fr, fq);
        if (!has_next) break;
#pragma unroll
        for (int a = 0; a < 2; ++a)
#pragma unroll
            for (int b = 0; b < 2; ++b)
#pragma unroll
                for (int m = 0; m < 4; ++m)
#pragma unroll
                    for (int n = 0; n < 2; ++n) acc[a][b][m][n] = (f32x4){0.f, 0.f, 0.f, 0.f};
        cur = nxt; cA = nA; cB = nB; ++ui;
        vc[0][0] = vn[0][0]; vc[0][1] = vn[0][1]; vc[1][0] = vn[1][0]; vc[1][1] = vn[1][1];
        if (wr == 1) PG8_BAR;
    }
    PG8_WAIT_V(0);
    PG8_BAR;
#undef PG8_SA
#undef PG8_SB
#undef PG8_STAGE
#undef PG8_LDA
#undef PG8_LDB
#undef PG8_MMA
#undef PG8_WAIT_V
#undef PG8_WAIT_L
#undef PG8_BAR
#undef PG8_SCHED
}

struct DenseProb {
    const bf16_t* A; const bf16_t* Bt; int lda, K, acol;
    StaticOrder so;
    __device__ __forceinline__ bool next(int i, Unit& u) const { u.ord = i; u.e = 0; u.cnt = 256; return so.next(i, u.pm, u.pn); }
    __device__ __forceinline__ const char* a_base(const Unit& u) const { return (const char*)(A + (size_t)u.pm * BM * lda + (size_t)u.pn * acol); }
    __device__ __forceinline__ const char* b_base(const Unit& u) const { return (const char*)(Bt + (size_t)u.pn * BM * K); }
    __device__ __forceinline__ void a_voff(const Unit&, const int (&R)[2], const int (&C)[2], unsigned (&vo)[2][2]) const {
#pragma unroll
        for (int h = 0; h < 2; ++h)
#pragma unroll
            for (int i = 0; i < 2; ++i) vo[h][i] = (unsigned)((h * HALF + R[i]) * lda + C[i]) * 2u;
    }
};

struct MoeProb {
    const bf16_t* A; const bf16_t* Bt; int lda, K, nN, shift;
    LAS const int* tab;
    LAS const int* expt;
    int G, c;
    __device__ __forceinline__ bool next(int i, Unit& u) const {
        const int per = G >> 3, xcd = c & 7, rank = c >> 3;
        const int L = (i * 8 + xcd) * per + rank;
        if (L >= expt[32] || i >= TAB_UNITS) return false;
        int e = 0;
#pragma unroll 1
        while (e < 31 && L >= expt[e + 1]) ++e;
        const int q = L - expt[e], cnt = expt[33 + e], T = (cnt + 255) >> 8;
        u.e = e; u.pn = q / T; u.pm = q % T; u.ord = i; u.cnt = cnt - u.pm * 256; return true;
    }
    __device__ __forceinline__ const char* a_base(const Unit&) const { return (const char*)A; }
    __device__ __forceinline__ const char* b_base(const Unit& u) const { return (const char*)(Bt + ((size_t)u.e * nN + u.pn) * BM * K); }
    __device__ __forceinline__ void a_voff(const Unit& u, const int (&R)[2], const int (&C)[2], unsigned (&vo)[2][2]) const {
#pragma unroll
        for (int h = 0; h < 2; ++h)
#pragma unroll
            for (int i = 0; i < 2; ++i) { const unsigned row = ((unsigned)tab[u.ord * 256 + h * HALF + R[i]] & 0x7fffffffu) >> shift; vo[h][i] = (row * (unsigned)lda + (unsigned)C[i]) * 2u; }
    }
};

struct EpiRowScaleBf16 {
    static constexpr bool PERM = true;
    bf16_t* O; int ldc; const float* rs;
    __device__ __forceinline__ void operator()(const f32x4 (&acc)[2][2][4][2], const Unit& u, int wr, int wc, int fr, int fq) const {
        const int row0 = u.pm * BM + wr * 64 + fr, col0 = u.pn * BM + wc * 32 + 8 * fq;
#pragma unroll
        for (int ai = 0; ai < 2; ++ai)
#pragma unroll
            for (int m = 0; m < 4; ++m) { const int row = row0 + ai * HALF + m * 16; const float s = rs[row]; bf16_t* rowp = O + (size_t)row * ldc + col0;
#pragma unroll
                for (int bj = 0; bj < 2; ++bj) { const f32x4 v0 = acc[ai][bj][m][0] * s, v1 = acc[ai][bj][m][1] * s;
                    u32x4 w; w.x = cvt_pk_bf16(v0[0], v0[1]); w.y = cvt_pk_bf16(v0[2], v0[3]); w.z = cvt_pk_bf16(v1[0], v1[1]); w.w = cvt_pk_bf16(v1[2], v1[3]);
                    *(u32x4*)(rowp + bj * HALF) = w; } }
    }
};
struct EpiBf16 {
    static constexpr bool PERM = true;
    bf16_t* O; int ldc, cbase;
    __device__ __forceinline__ void operator()(const f32x4 (&acc)[2][2][4][2], const Unit& u, int wr, int wc, int fr, int fq) const {
        const int row0 = u.pm * BM + wr * 64 + fr, col0 = cbase + u.pn * BM + wc * 32 + 8 * fq;
#pragma unroll
        for (int ai = 0; ai < 2; ++ai)
#pragma unroll
            for (int m = 0; m < 4; ++m) { bf16_t* rowp = O + (size_t)(row0 + ai * HALF + m * 16) * ldc + col0;
#pragma unroll
                for (int bj = 0; bj < 2; ++bj) { const f32x4 v0 = acc[ai][bj][m][0], v1 = acc[ai][bj][m][1];
                    u32x4 w; w.x = cvt_pk_bf16(v0[0], v0[1]); w.y = cvt_pk_bf16(v0[2], v0[3]); w.z = cvt_pk_bf16(v1[0], v1[1]); w.w = cvt_pk_bf16(v1[2], v1[3]);
                    *(u32x4*)(rowp + bj * HALF) = w; } }
    }
};
struct EpiResF32 {
    static constexpr bool PERM = false;
    const float* base; float* out; int ldc;
    __device__ __forceinline__ void operator()(const f32x4 (&acc)[2][2][4][2], const Unit& u, int wr, int wc, int fr, int fq) const {
        const int row0 = u.pm * BM + wr * 64 + fr, col0 = u.pn * BM + wc * 32 + 4 * fq;
#pragma unroll
        for (int ai = 0; ai < 2; ++ai)
#pragma unroll
            for (int m = 0; m < 4; ++m) { const size_t off = (size_t)(row0 + ai * HALF + m * 16) * ldc + col0;
#pragma unroll
                for (int bj = 0; bj < 2; ++bj)
#pragma unroll
                    for (int n = 0; n < 2; ++n) { const f32x4 bs = *(const f32x4*)(base + off + bj * HALF + n * 16); *(f32x4*)(out + off + bj * HALF + n * 16) = bs + acc[ai][bj][m][n]; } }
    }
};
struct EpiSwiGLU {
    static constexpr bool PERM = true;
    bf16_t* act; const float* rtok; const float* gate; LAS const int* tab;
    __device__ __forceinline__ void operator()(const f32x4 (&acc)[2][2][4][2], const Unit& u, int wr, int wc, int fr, int fq) const {
        const int col0 = u.pn * HALF + wc * 32 + 8 * fq;
#pragma unroll
        for (int ai = 0; ai < 2; ++ai)
#pragma unroll
            for (int m = 0; m < 4; ++m) { const int rl = ai * HALF + wr * 64 + m * 16 + fr; const int a = tab[u.ord * 256 + rl];
                if (a >= 0) { const float r = rtok[a >> 1], gt = gate[a]; float o[8];
#pragma unroll
                    for (int n = 0; n < 2; ++n)
#pragma unroll
                        for (int j = 0; j < 4; ++j) { const float g = acc[ai][0][m][n][j] * r, up = acc[ai][1][m][n][j] * r; o[n * 4 + j] = g / (1.0f + __expf(-g)) * up * gt; }
                    u32x4 w; w.x = cvt_pk_bf16(o[0], o[1]); w.y = cvt_pk_bf16(o[2], o[3]); w.z = cvt_pk_bf16(o[4], o[5]); w.w = cvt_pk_bf16(o[6], o[7]);
                    *(u32x4*)(act + (size_t)a * DEXP + col0) = w; } }
    }
};
struct EpiScatterBf16 {
    static constexpr bool PERM = true;
    bf16_t* Y; int ldc; LAS const int* tab;
    __device__ __forceinline__ void operator()(const f32x4 (&acc)[2][2][4][2], const Unit& u, int wr, int wc, int fr, int fq) const {
        const int col0 = u.pn * BM + wc * 32 + 8 * fq;
#pragma unroll
        for (int ai = 0; ai < 2; ++ai)
#pragma unroll
            for (int m = 0; m < 4; ++m) { const int rl = ai * HALF + wr * 64 + m * 16 + fr; const int a = tab[u.ord * 256 + rl];
                if (a >= 0) { bf16_t* rowp = Y + (size_t)a * ldc + col0;
#pragma unroll
                    for (int bj = 0; bj < 2; ++bj) { const f32x4 v0 = acc[ai][bj][m][0], v1 = acc[ai][bj][m][1];
                        u32x4 w; w.x = cvt_pk_bf16(v0[0], v0[1]); w.y = cvt_pk_bf16(v0[2], v0[3]); w.z = cvt_pk_bf16(v1[0], v1[1]); w.w = cvt_pk_bf16(v1[2], v1[3]);
                        *(u32x4*)(rowp + bj * HALF) = w; } } }
    }
};
}

struct Frame {
    LAS unsigned char* lds;
    gu32* ctl;
    int tid, lane, wave, G, bx;
    const float *x, *norm_mix, *w_in, *q_norm, *k_norm, *sinks, *w_pool, *pool_scale, *w_out, *norm_ffn, *w_coarse, *b_coarse, *w_fine, *b_fine, *w_gate, *w_up, *w_down;
    float* out;
    float *rope, *rinv, *rtok, *gate;
    bf16_t *Wr, *Wpool, *Win, *Wout, *Wgu, *Wd, *XB, *PROJ, *MIXED, *DPOOL, *ACT, *Y;
    int* rowl;
};

__device__ __forceinline__ void tr_item(const float* W, int N, int k0, int n0, bf16_t* dst0, int Kd, const float* gk, const float* gn, LAS float* scr, int lane) {
    const float sn = gn ? gn[n0 + (lane & 31)] : 1.0f;
#pragma unroll 8
    for (int i = 0; i < 32; ++i) { const int kk = 2 * i + (lane >> 5); float v = W[(size_t)(k0 + kk) * N + n0 + (lane & 31)]; if (gk) v *= gk[k0 + kk]; scr[kk * 33 + (lane & 31)] = v * sn; }
    LDS_WAIT(); asm volatile("" ::: "memory");
    const int c = lane & 7;
#pragma unroll
    for (int j = 0; j < 4; ++j) { const int n = (lane >> 3) + 8 * j; const LAS float* s = scr + (8 * c) * 33 + n;
        u32x4 o; o.x = pk2(s[0 * 33], s[1 * 33]); o.y = pk2(s[2 * 33], s[3 * 33]); o.z = pk2(s[4 * 33], s[5 * 33]); o.w = pk2(s[6 * 33], s[7 * 33]);
        *(GAS u32x4*)(dst0 + (size_t)n * Kd + k0 + 8 * c) = o; }
    LDS_WAIT(); asm volatile("" ::: "memory");
}

__device__ __forceinline__ void p0_prologue(Frame& F) {
    const int gw = F.bx * 8 + F.wave, NGW = F.G * 8, gt = F.bx * 512 + F.tid, NGT = F.G * 512;
    LAS float* scr = (LAS float*)(F.lds + F.wave * 16384);
    for (int i = gt; i < SEQ * 8; i += NGT) {
        const int pos = i >> 3, j = i & 7;
        const double invf[8] = {1.0, 0.19392274474868576, 0.03760603093086393, 0.007292664737217109, 0.001414213562373095, 0.0002742481756762073, 5.318295896944988e-05, 1.031338537721246e-05};
        double f = invf[0];
#pragma unroll
        for (int q = 1; q < 8; ++q) f = (j == q) ? invf[q] : f;
        double s, c; sincos((double)pos * f, &s, &c);
        F.rope[pos * 16 + j] = (float)c; F.rope[pos * 16 + 8 + j] = (float)s;
    }
    for (int i = gt; i < 64 * DM; i += NGT) {
        const int j = i / DM, k = i % DM; float v = 0.f;
        if (j < 4) v = F.w_coarse[k * 4 + j] * F.norm_ffn[k]; else if (j < 36) v = F.w_fine[k * 32 + (j - 4)] * F.norm_ffn[k];
        const unsigned hi = f2bf(v); const float lo = v - bflo(hi);
        F.Wr[i] = (bf16_t)hi; F.Wr[64 * DM + i] = (bf16_t)f2bf(lo);
    }
    constexpr int I_IN = (DM / 64) * (INW / 32), I_OUT = (DM / 64) * (DM / 32), I_POOL = 4 * (256 / 64) * (256 / 32), I_G = NEXP * (DM / 64) * (DEXP / 32), I_D = NEXP * (DEXP / 64) * (DM / 32);
    constexpr int NITEMS = I_IN + I_OUT + I_POOL + 2 * I_G + I_D;
    for (int it = gw; it < NITEMS; it += NGW) {
        int r = it;
        if (r < I_IN) { const int nb = INW / 32, kb = r / nb, nn = r % nb; tr_item(F.w_in, INW, 64 * kb, 32 * nn, F.Win + (size_t)(32 * nn) * DM, DM, F.norm_mix, nullptr, scr, F.lane); continue; } r -= I_IN;
        if (r < I_OUT) { const int nb = DM / 32, kb = r / nb, nn = r % nb; tr_item(F.w_out, DM, 64 * kb, 32 * nn, F.Wout + (size_t)(32 * nn) * DM, DM, nullptr, nullptr, scr, F.lane); continue; } r -= I_OUT;
        if (r < I_POOL) { const int g = r / 32, q = r % 32, kb = q / 8, nn = q % 8;
            tr_item(F.w_pool + (size_t)g * 65536, 256, 64 * kb, 32 * nn, F.Wpool + (size_t)g * 65536 + (size_t)(32 * nn) * 256, 256, nullptr, F.pool_scale + g * 256, scr, F.lane); continue; } r -= I_POOL;
        if (r < 2 * I_G) { const int up = r >= I_G; if (up) r -= I_G; const int per = (DM / 64) * (DEXP / 32), e = r / per, q = r % per, nb = DEXP / 32, kb = q / nb, nn = q % nb, n0 = 32 * nn;
            const float* W = (up ? F.w_up : F.w_gate) + (size_t)e * DM * DEXP;
            bf16_t* dst = F.Wgu + ((size_t)e * 1024 + (size_t)(n0 >> 7) * 256 + (up ? 128 : 0) + (n0 & 127)) * DM;
            tr_item(W, DEXP, 64 * kb, n0, dst, DM, F.norm_ffn, nullptr, scr, F.lane); continue; } r -= 2 * I_G;
        { const int per = (DEXP / 64) * (DM / 32), e = r / per, q = r % per, nb = DM / 32, kb = q / nb, nn = q % nb;
          tr_item(F.w_down + (size_t)e * DEXP * DM, DM, 64 * kb, 32 * nn, F.Wd + ((size_t)e * DM + 32 * nn) * DEXP, DEXP, nullptr, nullptr, scr, F.lane); }
    }
    for (int m = gw; m < NTOK; m += NGW) {
        const GAS f32x4* xr = (const GAS f32x4*)(F.x + (size_t)m * DM) + F.lane;
        f32x4 v[8]; float s = 0.f;
#pragma unroll
        for (int j = 0; j < 8; ++j) { v[j] = xr[64 * j]; s += (v[j].x * v[j].x + v[j].y * v[j].y) + (v[j].z * v[j].z + v[j].w * v[j].w); }
        s = wave_sum(s);
        if (F.lane == 0) F.rinv[m] = 1.0f / sqrtf(s * (1.0f / DM) + EPS);
        GAS u32x2* o8 = (GAS u32x2*)(F.XB + (size_t)m * DM) + F.lane;
#pragma unroll
        for (int j = 0; j < 8; ++j) { u32x2 w; w.x = pk2(v[j].x, v[j].y); w.y = pk2(v[j].z, v[j].w); o8[64 * j] = w; }
    }
}

constexpr int AT_K = 0, AT_V = 32768, AT_VSTR = 520;
__device__ __forceinline__ void attn_unit(Frame& F, int b, int n, int kvh) {
    LAS unsigned char* lds = F.lds;
    const int tid = F.tid, lane = F.lane, wid = F.wave;
    const size_t tok0 = (size_t)b * SEQ;
#pragma unroll
    for (int i = 0; i < 4; ++i) {
        const int idx = i * 512 + tid, row = idx >> 3, c = idx & 7, pos = n * 128 - 128 + row;
        u32x4 raw = (u32x4){0u, 0u, 0u, 0u};
        if (pos >= 0) raw = *(const GAS u32x4*)(F.PROJ + (tok0 + pos) * INW + KOFF + kvh * HD + c * 8);
        float xv[8] = {bflo(raw.x), bfhi(raw.x), bflo(raw.y), bfhi(raw.y), bflo(raw.z), bfhi(raw.z), bflo(raw.w), bfhi(raw.w)};
        float ss = 0.f;
#pragma unroll
        for (int j = 0; j < 8; ++j) ss += xv[j] * xv[j];
        ss += __shfl_xor(ss, 1); ss += __shfl_xor(ss, 2); ss += __shfl_xor(ss, 4);
        const float rn = 1.0f / sqrtf(ss * (1.0f / HD) + EPS);
#pragma unroll
        for (int j = 0; j < 8; ++j) xv[j] = xv[j] * rn * F.k_norm[c * 8 + j];
        const int pp = pos >= 0 ? pos : 0;
#pragma unroll
        for (int j = 0; j < 8; ++j) { const float pr = __shfl_xor(xv[j], 1); const float cs = F.rope[pp * 16 + j], sn = F.rope[pp * 16 + 8 + j];
            const float r0 = xv[j] * cs - pr * sn, r1 = xv[j] * cs + pr * sn; xv[j] = (c == 0) ? r0 : (c == 1) ? r1 : xv[j]; }
        u32x4 w; w.x = pk2(xv[0], xv[1]); w.y = pk2(xv[2], xv[3]); w.z = pk2(xv[4], xv[5]); w.w = pk2(xv[6], xv[7]);
        *(LAS u32x4*)(lds + AT_K + row * 128 + ((c ^ (row & 7)) * 16)) = w;
    }
#pragma unroll
    for (int i = 0; i < 2; ++i) {
        const int idx = i * 512 + tid, kp = idx >> 3, c = idx & 7, pos = n * 128 - 128 + 2 * kp;
        u32x4 r0 = (u32x4){0u, 0u, 0u, 0u}, r1 = (u32x4){0u, 0u, 0u, 0u};
        if (pos >= 0) { const bf16_t* p = F.PROJ + (tok0 + pos) * INW + VOFF + kvh * HD + c * 8; r0 = *(const GAS u32x4*)p; r1 = *(const GAS u32x4*)(p + INW); }
        const unsigned a0[4] = {r0.x, r0.y, r0.z, r0.w}, a1[4] = {r1.x, r1.y, r1.z, r1.w};
#pragma unroll
        for (int q = 0; q < 4; ++q) {
            const unsigned lo = (a0[q] & 0xffffu) | (a1[q] << 16), hi = (a0[q] >> 16) | (a1[q] & 0xffff0000u);
            *(LAS unsigned*)(lds + AT_V + (c * 8 + 2 * q) * AT_VSTR + kp * 4) = lo;
            *(LAS unsigned*)(lds + AT_V + (c * 8 + 2 * q + 1) * AT_VSTR + kp * 4) = hi;
        }
    }
    __syncthreads();
    const int g = wid & 3, head = kvh * 4 + g, ql = lane & 31, hi = lane >> 5;
    const float sink2 = F.sinks[head] * 1.4426950408889634f;
    const float SC = 0.125f * 1.4426950408889634f;
#pragma unroll 1
    for (int it = 0; it < 2; ++it) {
        const int s = (wid >> 2) + 2 * it;
        const int qpos = n * 128 + 32 * s + ql;
        float qv[4][8];
        const bf16_t* qp = F.PROJ + (tok0 + qpos) * INW + QOFF + head * HD + hi * 8;
        float ss = 0.f;
#pragma unroll
        for (int d0 = 0; d0 < 4; ++d0) { const u32x4 raw = *(const GAS u32x4*)(qp + d0 * 16);
            qv[d0][0] = bflo(raw.x); qv[d0][1] = bfhi(raw.x); qv[d0][2] = bflo(raw.y); qv[d0][3] = bfhi(raw.y); qv[d0][4] = bflo(raw.z); qv[d0][5] = bfhi(raw.z); qv[d0][6] = bflo(raw.w); qv[d0][7] = bfhi(raw.w);
#pragma unroll
            for (int j = 0; j < 8; ++j) ss += qv[d0][j] * qv[d0][j]; }
        ss += __shfl_xor(ss, 32);
        const float rn = 1.0f / sqrtf(ss * (1.0f / HD) + EPS);
#pragma unroll
        for (int d0 = 0; d0 < 4; ++d0)
#pragma unroll
            for (int j = 0; j < 8; ++j) qv[d0][j] = qv[d0][j] * rn * F.q_norm[d0 * 16 + hi * 8 + j];
#pragma unroll
        for (int j = 0; j < 8; ++j) { const float pr = __shfl_xor(qv[0][j], 32); const float cs = F.rope[qpos * 16 + j], sn = F.rope[qpos * 16 + 8 + j];
            qv[0][j] = (hi == 0) ? (qv[0][j] * cs - pr * sn) : (qv[0][j] * cs + pr * sn); }
        bf16x8 qr[4];
#pragma unroll
        for (int d0 = 0; d0 < 4; ++d0) { u32x4 w; w.x = pk2(qv[d0][0] * SC, qv[d0][1] * SC); w.y = pk2(qv[d0][2] * SC, qv[d0][3] * SC); w.z = pk2(qv[d0][4] * SC, qv[d0][5] * SC); w.w = pk2(qv[d0][6] * SC, qv[d0][7] * SC);
            qr[d0] = __builtin_bit_cast(bf16x8, w); }
        f32x16 p[5];
#pragma unroll
        for (int jt = 0; jt < 5; ++jt) {
            const int krow = 32 * (s + jt) + ql;
            f32x16 a = {};
#pragma unroll
            for (int d0 = 0; d0 < 4; ++d0) { const int c = 2 * d0 + hi;
                const bf16x8 kf = *(const LAS bf16x8*)(lds + AT_K + krow * 128 + ((c ^ (krow & 7)) * 16));
                a = __builtin_amdgcn_mfma_f32_32x32x16_bf16(kf, qr[d0], a, 0, 0, 0); }
            p[jt] = a;
        }
        float mx = sink2;
#pragma unroll
        for (int jt = 0; jt < 5; ++jt) {
            const bool blk_dead = (n == 0) && (s + jt < 4);
#pragma unroll
            for (int r = 0; r < 16; ++r) { const int kl = (r & 3) + 8 * (r >> 2) + 4 * hi;
                bool ok = !blk_dead; if (jt == 0) ok = ok && (kl > ql); if (jt == 4) ok = ok && (kl <= ql);
                const float v = ok ? p[jt][r] : -1e30f; p[jt][r] = v; mx = fmaxf(mx, v); }
        }
        mx = fmaxf(mx, __shfl_xor(mx, 32));
        float sum = 0.f;
#pragma unroll
        for (int jt = 0; jt < 5; ++jt)
#pragma unroll
            for (int r = 0; r < 16; ++r) { const float e = __builtin_amdgcn_exp2f(p[jt][r] - mx); p[jt][r] = e; sum += e; }
        sum += __shfl_xor(sum, 32);
        sum += __builtin_amdgcn_exp2f(sink2 - mx);
        const float inv = 1.0f / sum;
        f32x16 o[2]; o[0] = f32x16{}; o[1] = f32x16{};
#pragma unroll
        for (int jt = 0; jt < 5; ++jt)
#pragma unroll
            for (int s2 = 0; s2 < 2; ++s2) {
                u32x4 pw; pw.x = cvt_pk_bf16(p[jt][8 * s2 + 0] * inv, p[jt][8 * s2 + 1] * inv); pw.y = cvt_pk_bf16(p[jt][8 * s2 + 2] * inv, p[jt][8 * s2 + 3] * inv);
                pw.z = cvt_pk_bf16(p[jt][8 * s2 + 4] * inv, p[jt][8 * s2 + 5] * inv); pw.w = cvt_pk_bf16(p[jt][8 * s2 + 6] * inv, p[jt][8 * s2 + 7] * inv);
                const bf16x8 pf = __builtin_bit_cast(bf16x8, pw);
                const int kb = 32 * (s + jt) + 16 * s2 + 4 * hi;
#pragma unroll
                for (int dt = 0; dt < 2; ++dt) {
                    const LAS unsigned char* vp = lds + AT_V + (dt * 32 + ql) * AT_VSTR + kb * 2;
                    const u32x2 v0 = *(const LAS u32x2*)vp, v1 = *(const LAS u32x2*)(vp + 16);
                    u32x4 vw; vw.x = v0.x; vw.y = v0.y; vw.z = v1.x; vw.w = v1.y;
                    o[dt] = __builtin_amdgcn_mfma_f32_32x32x16_bf16(pf, __builtin_bit_cast(bf16x8, vw), o[dt], 0, 0, 0);
                }
            }
        bf16_t* op = F.MIXED + (tok0 + n * 128 + 32 * s) * DM + head * HD + ql;
#pragma unroll
        for (int dt = 0; dt < 2; ++dt)
#pragma unroll
            for (int r = 0; r < 16; ++r) { const int q = (r & 3) + 8 * (r >> 2) + 4 * hi; op[(size_t)q * DM + dt * 32] = (bf16_t)f2bf(o[dt][r]); }
    }
    __syncthreads();
}

__device__ __forceinline__ void pool_diff(Frame& F) {
    const int NITEM = (NTOK / 32) * 128;
    for (int it = F.bx * 512 + F.tid; it < NITEM; it += F.G * 512) {
        const int ri = it >> 7, c8 = it & 127, w = 2 << (c8 >> 5), t0 = ri * 32, pos0 = t0 & (SEQ - 1);
        const bf16_t* up = F.PROJ + (size_t)t0 * INW + UOFF + c8 * 8;
        float S[8];
#pragma unroll
        for (int j = 0; j < 8; ++j) S[j] = 0.f;
        for (int i = 1; i < w; ++i) if (pos0 - i >= 0) { const u32x4 raw = *(const GAS u32x4*)(up - (size_t)i * INW);
            S[0] += bflo(raw.x); S[1] += bfhi(raw.x); S[2] += bflo(raw.y); S[3] += bfhi(raw.y); S[4] += bflo(raw.z); S[5] += bfhi(raw.z); S[6] += bflo(raw.w); S[7] += bfhi(raw.w); }
#pragma unroll 4
        for (int t = 0; t < 32; ++t) {
            const u32x4 raw = *(const GAS u32x4*)(up + (size_t)t * INW);
            const float xv[8] = {bflo(raw.x), bfhi(raw.x), bflo(raw.y), bfhi(raw.y), bflo(raw.z), bfhi(raw.z), bflo(raw.w), bfhi(raw.w)};
            const int pos = pos0 + t; const float ic = 1.0f / (float)((pos + 1 < w) ? (pos + 1) : w);
            float d[8];
#pragma unroll
            for (int j = 0; j < 8; ++j) { S[j] += xv[j]; d[j] = S[j] * ic - xv[j]; }
            u32x4 o; o.x = pk2(d[0], d[1]); o.y = pk2(d[2], d[3]); o.z = pk2(d[4], d[5]); o.w = pk2(d[6], d[7]);
            *(GAS u32x4*)(F.DPOOL + (size_t)(t0 + t) * PW + c8 * 8) = o;
            if (pos - w + 1 >= 0) { const u32x4 old = *(const GAS u32x4*)(up + (ptrdiff_t)(t - w + 1) * INW);
                S[0] -= bflo(old.x); S[1] -= bfhi(old.x); S[2] -= bflo(old.y); S[3] -= bfhi(old.y); S[4] -= bflo(old.z); S[5] -= bfhi(old.z); S[6] -= bflo(old.w); S[7] -= bfhi(old.w); }
        }
    }
}

constexpr int RT_WSTR = 528, RT_W = 0, RT_WLO = 64 * RT_WSTR, RT_L = 2 * 64 * RT_WSTR, RT_LSTR = 65;
__device__ __forceinline__ void route_phase(Frame& F) {
    LAS unsigned char* lds = F.lds;
    const int tid = F.tid, lane = F.lane, wid = F.wave, row = lane & 15, kq = lane >> 4;
    for (int tile = F.bx; tile < NTOK / 128; tile += F.G) {
        const int t0 = tile * 128 + wid * 16;
        const float* hp = F.out + (size_t)(t0 + row) * DM + kq * 8;
        bf16_t* hb = F.XB + (size_t)(t0 + row) * DM + kq * 8;
        f32x4 acc[4]; acc[0] = acc[1] = acc[2] = acc[3] = (f32x4){0.f, 0.f, 0.f, 0.f};
        float ssq = 0.f;
#pragma unroll 1
        for (int kc = 0; kc < 8; ++kc) {
            __syncthreads();
#pragma unroll
            for (int i = 0; i < 8; ++i) { const int p = i * 512 + tid, which = p >> 11, col = (p & 2047) >> 5, ch = p & 31;
                const u32x4 v = *(const GAS u32x4*)(F.Wr + (size_t)which * 64 * DM + (size_t)col * DM + kc * 256 + ch * 8);
                *(LAS u32x4*)(lds + which * RT_WLO + col * RT_WSTR + ch * 16) = v; }
            __syncthreads();
#pragma unroll 4
            for (int ks = 0; ks < 8; ++ks) {
                const int k = kc * 256 + ks * 32;
                const f32x4 v0 = *(const GAS f32x4*)(hp + k), v1 = *(const GAS f32x4*)(hp + k + 4);
                const float xv[8] = {v0.x, v0.y, v0.z, v0.w, v1.x, v1.y, v1.z, v1.w};
                unsigned hi16[8]; float lo[8];
#pragma unroll
                for (int j = 0; j < 8; ++j) { ssq += xv[j] * xv[j]; hi16[j] = f2bf(xv[j]); lo[j] = xv[j] - bflo(hi16[j]); }
                u32x4 ah; ah.x = hi16[0] | (hi16[1] << 16); ah.y = hi16[2] | (hi16[3] << 16); ah.z = hi16[4] | (hi16[5] << 16); ah.w = hi16[6] | (hi16[7] << 16);
                u32x4 al; al.x = pk2(lo[0], lo[1]); al.y = pk2(lo[2], lo[3]); al.z = pk2(lo[4], lo[5]); al.w = pk2(lo[6], lo[7]);
                *(GAS u32x4*)(hb + k) = ah;
                const bf16x8 Ah = __builtin_bit_cast(bf16x8, ah), Al = __builtin_bit_cast(bf16x8, al);
#pragma unroll
                for (int tc = 0; tc < 4; ++tc) {
                    const LAS unsigned char* bp = lds + (tc * 16 + row) * RT_WSTR + (ks * 32 + kq * 8) * 2;
                    const bf16x8 Bh = *(const LAS bf16x8*)bp, Bl = *(const LAS bf16x8*)(bp + RT_WLO);
                    acc[tc] = __builtin_amdgcn_mfma_f32_16x16x32_bf16(Ah, Bh, acc[tc], 0, 0, 0);
                    acc[tc] = __builtin_amdgcn_mfma_f32_16x16x32_bf16(Al, Bh, acc[tc], 0, 0, 0);
                    acc[tc] = __builtin_amdgcn_mfma_f32_16x16x32_bf16(Ah, Bl, acc[tc], 0, 0, 0);
                }
            }
        }
        ssq += __shfl_xor(ssq, 16); ssq += __shfl_xor(ssq, 32);
        const float rt = 1.0f / sqrtf(ssq * (1.0f / DM) + EPS);
        LAS float* L = (LAS float*)(lds + RT_L) + wid * 16 * RT_LSTR;
#pragma unroll
        for (int tc = 0; tc < 4; ++tc)
#pragma unroll
            for (int r = 0; r < 4; ++r) L[(kq * 4 + r) * RT_LSTR + tc * 16 + row] = acc[tc][r];
        __syncthreads();
        if (lane < 16) {
            const int t = t0 + lane; const LAS float* Lt = L + lane * RT_LSTR;
            float c[4]; int grp = 0; float cm;
#pragma unroll
            for (int j = 0; j < 4; ++j) c[j] = Lt[j] * rt + F.b_coarse[j];
            cm = c[0];
#pragma unroll
            for (int j = 1; j < 4; ++j) if (c[j] > cm) { cm = c[j]; grp = j; }
            float den = 0.f;
#pragma unroll
            for (int j = 0; j < 4; ++j) den += __expf(c[j] - cm);
            const float pg = 1.0f / den;
            float f[8];
#pragma unroll
            for (int j = 0; j < 8; ++j) f[j] = Lt[4 + grp * 8 + j] * rt + F.b_fine[grp * 8 + j];
            int i1 = 0; float l1 = f[0];
#pragma unroll
            for (int j = 1; j < 8; ++j) if (f[j] > l1) { l1 = f[j]; i1 = j; }
            int i2 = -1; float l2 = -3.0e38f;
#pragma unroll
            for (int j = 0; j < 8; ++j) if (j != i1 && f[j] > l2) { l2 = f[j]; i2 = j; }
            const float e2 = __expf(l2 - l1), g1 = pg / (1.0f + e2), g2 = pg * e2 / (1.0f + e2);
            F.rtok[t] = rt; F.gate[2 * t] = g1; F.gate[2 * t + 1] = g2;
            const int e1 = grp * 8 + i1, ee2 = grp * 8 + i2;
            const unsigned p1 = __hip_atomic_fetch_add((unsigned*)(F.ctl + CW_CNT + 64 * e1), 1u, RLX_AGENT);
            F.rowl[(size_t)e1 * RCAP + p1] = 2 * t;
            const unsigned p2 = __hip_atomic_fetch_add((unsigned*)(F.ctl + CW_CNT + 64 * ee2), 1u, RLX_AGENT);
            F.rowl[(size_t)ee2 * RCAP + p2] = 2 * t + 1;
        }
    }
}

__device__ __forceinline__ void moe_setup(Frame& F, int nN) {
    LAS int* expt = (LAS int*)(F.lds + EXPT_OFF); LAS int* tab = (LAS int*)(F.lds + TAB_OFF);
    __syncthreads();
    if (F.tid == 0) { int acc = 0;
        for (int e = 0; e < NEXP; ++e) { const int cnt = (int)__hip_atomic_load((unsigned*)(F.ctl + CW_CNT + 64 * e), RLX_AGENT); expt[e] = acc; expt[33 + e] = cnt; acc += ((cnt + 255) >> 8) * nN; }
        expt[32] = acc; }
    __syncthreads();
    pg8::MoeProb P; P.expt = expt; P.nN = nN; P.G = F.G; P.c = F.bx;
    pg8::Unit u;
    for (int i = 0; P.next(i, u); ++i) {
        if (F.tid < 256) { const int j = u.pm * 256 + F.tid; const int cnt = expt[33 + u.e];
            const int v = F.rowl[(size_t)u.e * RCAP + (j < cnt ? j : 0)];
            tab[i * 256 + F.tid] = (j < cnt) ? v : (v | (int)0x80000000); }
    }
    __syncthreads();
}

__device__ __forceinline__ void combine_phase(Frame& F) {
    const size_t NIT = (size_t)NTOK * (DM / 8);
    for (size_t it = (size_t)F.bx * 512 + F.tid; it < NIT; it += (size_t)F.G * 512) {
        const size_t t = it >> 8; const int c = (int)(it & 255) * 8;
        float* op = F.out + t * DM + c;
        const f32x4 h0 = *(const GAS f32x4*)op, h1 = *(const GAS f32x4*)(op + 4);
        const u32x4 y0 = *(const GAS u32x4*)(F.Y + (2 * t) * DM + c), y1 = *(const GAS u32x4*)(F.Y + (2 * t + 1) * DM + c);
        f32x4 o0, o1;
        o0.x = h0.x + bflo(y0.x) + bflo(y1.x); o0.y = h0.y + bfhi(y0.x) + bfhi(y1.x); o0.z = h0.z + bflo(y0.y) + bflo(y1.y); o0.w = h0.w + bfhi(y0.y) + bfhi(y1.y);
        o1.x = h1.x + bflo(y0.z) + bflo(y1.z); o1.y = h1.y + bfhi(y0.z) + bfhi(y1.z); o1.z = h1.z + bflo(y0.w) + bflo(y1.w); o1.w = h1.w + bfhi(y0.w) + bfhi(y1.w);
        *(GAS f32x4*)op = o0; *(GAS f32x4*)(op + 4) = o1;
    }
}

struct Args { const float* in[17]; float* out; unsigned char* ws; int ph_lo, ph_hi, use_bar, pad; };
__global__ void __launch_bounds__(512, 2) hymba_fwd(Args args) {
    extern __shared__ __attribute__((aligned(16))) unsigned char lds[];
    Frame F;
    F.lds = (LAS unsigned char*)lds;
    F.tid = threadIdx.x; F.lane = F.tid & 63; F.wave = __builtin_amdgcn_readfirstlane(F.tid >> 6);
    F.G = gridDim.x; F.bx = blockIdx.x;
    unsigned char* ws = args.ws;
    F.ctl = (gu32*)(ws + WS_CTL);
    F.x = args.in[0]; F.norm_mix = args.in[1]; F.w_in = args.in[2]; F.q_norm = args.in[3]; F.k_norm = args.in[4]; F.sinks = args.in[5]; F.w_pool = args.in[6]; F.pool_scale = args.in[7];
    F.w_out = args.in[8]; F.norm_ffn = args.in[9]; F.w_coarse = args.in[10]; F.b_coarse = args.in[11]; F.w_fine = args.in[12]; F.b_fine = args.in[13]; F.w_gate = args.in[14]; F.w_up = args.in[15]; F.w_down = args.in[16];
    F.out = args.out;
    F.rope = (float*)(ws + WS_ROPE); F.rinv = (float*)(ws + WS_RINV); F.rtok = (float*)(ws + WS_RTOK); F.gate = (float*)(ws + WS_GATE);
    F.Wr = (bf16_t*)(ws + WS_WR); F.Wpool = (bf16_t*)(ws + WS_WPOOL); F.Win = (bf16_t*)(ws + WS_WIN); F.Wout = (bf16_t*)(ws + WS_WOUT); F.Wgu = (bf16_t*)(ws + WS_WGU); F.Wd = (bf16_t*)(ws + WS_WD);
    F.XB = (bf16_t*)(ws + WS_XB); F.PROJ = (bf16_t*)(ws + WS_PROJ); F.MIXED = (bf16_t*)(ws + WS_MIXED); F.DPOOL = (bf16_t*)(ws + WS_DPOOL); F.ACT = (bf16_t*)(ws + WS_ACT); F.Y = (bf16_t*)(ws + WS_Y);
    F.rowl = (int*)(ws + WS_ROWL);
    if (F.tid < 4) ((LAS unsigned*)(F.lds + MISC_OFF))[F.tid] = 0u;
    __syncthreads();
    XcdBarrier bar; bar.bar = (unsigned*)(F.ctl + CW_BAR); bar.x = 0; bar.st = nullptr;
    if (args.use_bar) bar = xcd_barrier_post((unsigned*)(F.ctl + CW_BAR), (volatile LAS unsigned*)(F.lds + MISC_OFF));
    const int lo = args.ph_lo, hi = args.ph_hi;
#define IN(k) (lo <= (k) && (k) < hi)
#define SEAM(k) do { if (IN(k) && IN((k) + 1)) xcd_barrier(bar); } while (0)

    if (IN(0)) { p0_prologue(F); SEAM(0); }
    if (IN(1)) {
        pg8::DenseProb P; P.A = F.XB; P.Bt = F.Win; P.lda = DM; P.K = DM; P.acol = 0; P.so.init(NTOK, INW, F.G, F.bx);
        pg8::EpiRowScaleBf16 E{F.PROJ, INW, F.rinv};
        pg8::gemm_phase(F.lds, P, E);
        SEAM(1);
    }
    if (IN(2)) {
        for (int u = F.bx; u < BATCH * (SEQ / 128) * NKV; u += F.G) { const int kvh = u & 3, n = (u >> 2) & 31, b = u >> 7; attn_unit(F, b, n, kvh); }
        pool_diff(F);
        SEAM(2);
    }
    if (IN(3)) {
        pg8::DenseProb P; P.A = F.DPOOL; P.Bt = F.Wpool; P.lda = PW; P.K = 256; P.acol = 256; P.so.init(NTOK, PW, F.G, F.bx);
        pg8::EpiBf16 E{F.MIXED, DM, 1024};
        pg8::gemm_phase(F.lds, P, E);
        SEAM(3);
    }
    if (IN(4)) {
        pg8::DenseProb P; P.A = F.MIXED; P.Bt = F.Wout; P.lda = DM; P.K = DM; P.acol = 0; P.so.init(NTOK, DM, F.G, F.bx);
        pg8::EpiResF32 E{F.x, F.out, DM};
        pg8::gemm_phase(F.lds, P, E);
        SEAM(4);
    }
    if (IN(5)) { route_phase(F); SEAM(5); }
    if (IN(6)) {
        moe_setup(F, 4);
        pg8::MoeProb P; P.A = F.XB; P.Bt = F.Wgu; P.lda = DM; P.K = DM; P.nN = 4; P.shift = 1; P.tab = (LAS const int*)(F.lds + TAB_OFF); P.expt = (LAS const int*)(F.lds + EXPT_OFF); P.G = F.G; P.c = F.bx;
        pg8::EpiSwiGLU E{F.ACT, F.rtok, F.gate, (LAS const int*)(F.lds + TAB_OFF)};
        pg8::gemm_phase(F.lds, P, E);
        SEAM(6);
    }
    if (IN(7)) {
        moe_setup(F, 8);
        pg8::MoeProb P; P.A = F.ACT; P.Bt = F.Wd; P.lda = DEXP; P.K = DEXP; P.nN = 8; P.shift = 0; P.tab = (LAS const int*)(F.lds + TAB_OFF); P.expt = (LAS const int*)(F.lds + EXPT_OFF); P.G = F.G; P.c = F.bx;
        pg8::EpiScatterBf16 E{F.Y, DM, (LAS const int*)(F.lds + TAB_OFF)};
        pg8::gemm_phase(F.lds, P, E);
        SEAM(7);
    }
    if (IN(8)) { combine_phase(F); }
#undef IN
#undef SEAM
}

extern "C" void kernel_launch(void* const* d_in, const int* in_sizes, int n_in, void* d_out, int out_size, void* d_ws, size_t ws_size, hipStream_t stream) {
    static int grid = 0;
    if (grid == 0) {
        if (n_in != 17 || out_size != NTOK * DM || ws_size < WS_END) { fprintf(stderr, "kernel_launch: unexpected problem (n_in %d, out %d, ws %zu)\n", n_in, out_size, ws_size); grid = -1; return; }
        int dev = 0, cus = 0;
        if (hipGetDevice(&dev) != hipSuccess || hipDeviceGetAttribute(&cus, hipDeviceAttributeMultiprocessorCount, dev) != hipSuccess) { grid = -1; return; }
        if (hipFuncSetAttribute((const void*)hymba_fwd, hipFuncAttributeMaxDynamicSharedMemorySize, LDS_BYTES) != hipSuccess) { fprintf(stderr, "kernel_launch: hipFuncSetAttribute failed\n"); grid = -1; return; }
        int per_cu = 0;
        if (hipOccupancyMaxActiveBlocksPerMultiprocessor(&per_cu, (const void*)hymba_fwd, 512, LDS_BYTES) != hipSuccess || per_cu < 1) { fprintf(stderr, "kernel_launch: occupancy query says %d\n", per_cu); }
        (void)hipGetLastError();
        grid = cus - (cus % 8);
        if (grid <= 0) grid = -1;
    }
    if (grid < 0) return;
    if (hipMemsetAsync((char*)d_ws + WS_CTL, 0, CTL_ZERO_BYTES, stream) != hipSuccess) return;
    Args a{};
    for (int i = 0; i < 17; ++i) a.in[i] = (const float*)d_in[i];
    a.out = (float*)d_out; a.ws = (unsigned char*)d_ws;
    if (MK_N_LAUNCHES == 1) { a.ph_lo = 0; a.ph_hi = NPHASE; a.use_bar = 1; hipLaunchKernelGGL(hymba_fwd, dim3(grid), dim3(512), LDS_BYTES, stream, a); }
    else for (int p = 0; p < NPHASE; ++p) { a.ph_lo = p; a.ph_hi = p + 1; a.use_bar = 0; hipLaunchKernelGGL(hymba_fwd, dim3(grid), dim3(512), LDS_BYTES, stream, a); }
}
```

```cpp
#include <hip/hip_runtime.h>
#include <cstdio>
#include <cstdint>

#ifndef MK_N_LAUNCHES
#define MK_N_LAUNCHES 1
#endif
#ifndef PROBE_DUP
#define PROBE_DUP -1
#endif

#define GAS __attribute__((address_space(1)))
#define LAS __attribute__((address_space(3)))
typedef unsigned short bf16_t;
typedef short bf16x8 __attribute__((ext_vector_type(8)));
typedef short s16x4 __attribute__((ext_vector_type(4)));
typedef float f32x4 __attribute__((ext_vector_type(4)));
typedef float f32x2 __attribute__((ext_vector_type(2)));
typedef float f32x16 __attribute__((ext_vector_type(16)));
typedef unsigned u32x4 __attribute__((ext_vector_type(4)));
typedef unsigned u32x2 __attribute__((ext_vector_type(2)));
typedef GAS unsigned gu32;

constexpr int BATCH = 8, SEQ = 4096, NTOK = BATCH * SEQ, DM = 2048;
constexpr int NH = 16, NKV = 4, HD = 64, INW = 2560, QOFF = 0, KOFF = 1024, VOFF = 1280, UOFF = 1536, PW = 1024;
constexpr int NEXP = 32, DEXP = 512, NASG = NTOK * 2, RCAP = NASG;
constexpr float EPS = 1e-6f;
constexpr int NPHASE = 9;

constexpr size_t MiB = 1u << 20;
constexpr size_t WS_CTL = 0, CTL_ZERO_BYTES = 64 * 1024;
constexpr size_t WS_ROPE = 1 * MiB;
constexpr size_t WS_RINV = WS_ROPE + 256 * 1024;
constexpr size_t WS_RTOK = WS_RINV + 128 * 1024;
constexpr size_t WS_GATE = WS_RTOK + 128 * 1024;
constexpr size_t WS_WR = 2 * MiB;
constexpr size_t WS_WPOOL = WS_WR + 512 * 1024;
constexpr size_t WS_WIN = 3 * MiB;
constexpr size_t WS_WOUT = 13 * MiB;
constexpr size_t WS_ROWL = 21 * MiB;
constexpr size_t WS_WGU = 29 * MiB;
constexpr size_t WS_WD = 157 * MiB;
constexpr size_t WS_XB = 221 * MiB;
constexpr size_t WS_PROJ = 349 * MiB;
constexpr size_t WS_MIXED = 509 * MiB;
constexpr size_t WS_DPOOL = 637 * MiB;
constexpr size_t WS_ACT = WS_DPOOL;
constexpr size_t WS_Y = WS_PROJ;
constexpr size_t WS_END = 701 * MiB;
static_assert(WS_Y + (size_t)NASG * DM * 2 <= WS_DPOOL, "Y overlay");
constexpr int CW_TMO = 0, CW_BAR = 1024, CW_CNT = 8192;

constexpr int RING_BYTES = 131072;
constexpr int TAB_OFF = RING_BYTES;
constexpr int TAB_UNITS = 14;
constexpr int EXPT_OFF = TAB_OFF + TAB_UNITS * 1024;
constexpr int MISC_OFF = EXPT_OFF + 512;
constexpr int LDS_BYTES = 147456;
static_assert(MISC_OFF + 16 <= LDS_BYTES, "LDS map");

#define RLX_AGENT __ATOMIC_RELAXED, __HIP_MEMORY_SCOPE_AGENT
#define LDS_WAIT() asm volatile("s_waitcnt lgkmcnt(0)" ::: "memory")
#define VM_WAIT() asm volatile("s_waitcnt vmcnt(0)" ::: "memory")

__device__ __forceinline__ unsigned f2bf(float f) { unsigned u = __builtin_bit_cast(unsigned, f); return (u + 0x7fffu + ((u >> 16) & 1u)) >> 16; }

__device__ __forceinline__ float bflo(unsigned w) { return __builtin_bit_cast(float, w << 16); }
__device__ __forceinline__ float bfhi(unsigned w) { return __builtin_bit_cast(float, w & 0xffff0000u); }
typedef __bf16 bf16x2_t __attribute__((ext_vector_type(2)));
__device__ __forceinline__ unsigned cvt_pk_bf16(float lo, float hi) { f32x2 v = {lo, hi}; bf16x2_t b = __builtin_convertvector(v, bf16x2_t); return __builtin_bit_cast(unsigned, b); }
__device__ __forceinline__ unsigned pk2(float lo, float hi) { return cvt_pk_bf16(lo, hi); }
__device__ __forceinline__ float wave_sum(float v) {
#pragma unroll
    for (int o = 1; o < 64; o <<= 1) v += __shfl_xor(v, o);
    return v;
}

#define XB_TMO      128
#define XB_XCNT(j)  (256  + 64 * (j))
#define XB_XSUB(j)  (1280 + 64 * (j))
#define XB_XGEN(j)  (2304 + 64 * (j))
#define XB_TOP      3328
#define XB_TOPGEN   3392
#define XCD_BAR_WORDS 3456
#define XB_SPIN_CAP (1u << 18)
__device__ __forceinline__ unsigned xb_ld(unsigned* p)              { return __hip_atomic_load(p, __ATOMIC_RELAXED, __HIP_MEMORY_SCOPE_AGENT); }
__device__ __forceinline__ unsigned xb_add(unsigned* p, unsigned v) { return __hip_atomic_fetch_add(p, v, __ATOMIC_RELAXED, __HIP_MEMORY_SCOPE_AGENT); }
__device__ __forceinline__ unsigned xb_xcc_id() { return (unsigned)__builtin_amdgcn_s_getreg((3 << 11) | 20) & 0xFu; }
#define XB_SPIN(cond, bar) do { unsigned _sp = 0; while (cond) { __builtin_amdgcn_s_sleep(1); \
    if ((++_sp & 255u) == 0u) { if (xb_ld(&(bar)[XB_TMO])) break; if (_sp > XB_SPIN_CAP) { atomicAdd(&(bar)[XB_TMO], 1u); break; } } } } while (0)
struct XcdBarrier { unsigned* bar; unsigned x; volatile LAS unsigned* st; };
__device__ __forceinline__ XcdBarrier xcd_barrier_post(unsigned* bar, volatile LAS unsigned* st) {
    XcdBarrier b; b.bar = bar; b.x = xb_xcc_id(); b.st = st;
    if (threadIdx.x == 0) (void)xb_add(&bar[XB_XCNT(b.x)], 1u);
    return b;
}
__device__ __forceinline__ void xcd_barrier_complete(unsigned* bar, unsigned x, unsigned& nloc, unsigned& nx) {
    const unsigned G = gridDim.x * gridDim.y * gridDim.z;
    unsigned sum, cnt, mine, sp = 0u;
    for (;;) {
        sum = 0u; cnt = 0u; mine = 0u;
#pragma unroll
        for (unsigned j = 0; j < 16; ++j) { const unsigned c = xb_ld(&bar[XB_XCNT(j)]); sum += c; cnt += (c > 0u) ? 1u : 0u; mine = (j == x) ? c : mine; }
        if (sum == G) break;
        __builtin_amdgcn_s_sleep(1);
        if ((++sp & 255u) == 0u) { if (xb_ld(&bar[XB_TMO])) break; if (sp > XB_SPIN_CAP) { atomicAdd(&bar[XB_TMO], 1u); break; } }
    }
    nloc = mine > 0u ? mine : 1u; nx = cnt > 0u ? cnt : 1u;
}
__device__ __forceinline__ void xcd_barrier(const XcdBarrier& b) {
    asm volatile("s_waitcnt vmcnt(0)" ::: "memory");
    __syncthreads();
    if (threadIdx.x == 0) {
        unsigned* bar = b.bar;
        __builtin_amdgcn_s_waitcnt(0);
        unsigned nloc = b.st[0], nx = b.st[1];
        if (nloc == 0u) { xcd_barrier_complete(bar, b.x, nloc, nx); b.st[0] = nloc; b.st[1] = nx; }
        const unsigned old = xb_add(&bar[XB_XSUB(b.x)], 1u);
        const unsigned gen = old / nloc;
        if (old + 1u == (gen + 1u) * nloc) {
            __builtin_amdgcn_fence(__ATOMIC_RELEASE, "agent");
            asm volatile("s_waitcnt vmcnt(0)" ::: "memory");
            const unsigned og = xb_add(&bar[XB_TOP], 1u);
            const unsigned tg = og / nx;
            if (og + 1u == (tg + 1u) * nx) xb_add(&bar[XB_TOPGEN], 1u);
            else XB_SPIN(xb_ld(&bar[XB_TOPGEN]) == tg, bar);
            __builtin_amdgcn_fence(__ATOMIC_ACQUIRE, "agent");
            xb_add(&bar[XB_XGEN(b.x)], 1u);
            asm volatile("s_waitcnt vmcnt(0)" ::: "memory");
        } else {
            XB_SPIN(xb_ld(&bar[XB_XGEN(b.x)]) == gen, bar);
            __builtin_amdgcn_fence(__ATOMIC_ACQUIRE, "agent");
            asm volatile("s_waitcnt vmcnt(0)" ::: "memory");
        }
    }
    __syncthreads();
}

namespace pg8 {
constexpr int BM = 256, BK = 64, HALF = 128, HTB = HALF * BK * 2, STAGE_BYTES = 8 * HTB, NXCD = 8, WGM = 8;
static_assert(STAGE_BYTES == RING_BYTES, "stage region");
__host__ __device__ __forceinline__ int lds_byte(int r, int c) { const int st = (r >> 4) * 2 + (c >> 5), rr = r & 15, cc = c & 31, ob = rr * 64 + cc * 2; return st * 1024 + (ob ^ (((ob >> 9) & 1) << 5)); }
__host__ __device__ __forceinline__ void stage_rc(int b, int& R, int& C) { const int st = b / 1024, sb = b % 1024, swz = sb ^ (((sb >> 9) & 1) << 5); R = (st >> 1) * 16 + swz / 64; C = (st & 1) * 32 + (swz % 64) / 2; }
__host__ __device__ __forceinline__ int perm32(int rho) { const int n = rho >> 4, i = rho & 15; return 8 * (i >> 2) + 4 * n + (i & 3); }

struct Unit { int pm, pn, ord, e, cnt; };

struct StaticOrder {
    int nM, nN, nwg, G, c;
    __device__ void init(int M, int N, int G_, int c_) { nM = M / BM; nN = N / BM; nwg = nM * nN; G = G_; c = c_; }
    __device__ bool next(int i, int& pm, int& pn) const {
        const long L = (long)i * G + c; if (L >= nwg) return false;
        int wgid = (int)L; { const int q = nwg / NXCD, r = nwg % NXCD, xcd = wgid % NXCD, off = wgid / NXCD; wgid = (xcd < r ? xcd * (q + 1) : r * (q + 1) + (xcd - r) * q) + off; }
        const int nig = WGM * nN, gid = wgid / nig, fm = gid * WGM, gsz = (nM - fm) < WGM ? (nM - fm) : WGM;
        pm = fm + ((wgid % nig) % gsz); pn = (wgid % nig) / gsz; return true;
    }
};

template <class Epi, class Prob>
__device__ __forceinline__ void gemm_phase(LAS unsigned char* lds, const Prob& S, const Epi& E) {
    const int tid = threadIdx.x, wid = __builtin_amdgcn_readfirstlane(tid >> 6), lane = tid & 63, wr = wid >> 2, wc = wid & 3, fr = lane & 15, fq = lane >> 4;
    const int K = S.K, nt = K / BK;
    int Rr[2], Cc[2]; unsigned voffB[2];
#pragma unroll
    for (int i = 0; i < 2; ++i) { stage_rc(tid * 16 + i * 8192, Rr[i], Cc[i]); const int Rb = Epi::PERM ? ((Rr[i] & ~31) + perm32(Rr[i] & 31)) : Rr[i]; voffB[i] = (unsigned)(Rb * K + Cc[i]) * 2u; }
    const size_t kstep = (size_t)(BK * 2);
    const size_t hstep = (size_t)HALF * K * 2;
    const unsigned ldsw = (unsigned)wid * 1024u;
    const int aoff = lds_byte(wr * 64 + fr, fq * 8), boff = lds_byte(wc * 32 + fr, fq * 8);
#define PG8_SA(b, h) (((b) * 2 + (h)) * HTB)
#define PG8_SB(b, h) ((4 + (b) * 2 + (h)) * HTB)
#define PG8_STAGE(bufoff, gbase, voff) do { _Pragma("unroll") for (int _i = 0; _i < 2; ++_i) \
        __builtin_amdgcn_global_load_lds((const unsigned*)((const char*)(gbase) + (voff)[_i]), (LAS unsigned*)(lds + (bufoff) + ldsw + _i * 8192), 16, 0, 0); } while (0)
#define PG8_LDA(dst, b, h) do { _Pragma("unroll") for (int m = 0; m < 4; ++m) _Pragma("unroll") for (int k = 0; k < 2; ++k) dst[m][k] = *(const LAS bf16x8*)(lds + PG8_SA(b, h) + aoff + m * 2048 + k * 1024); } while (0)
#define PG8_LDB(dst, b, h) do { _Pragma("unroll") for (int n = 0; n < 2; ++n) _Pragma("unroll") for (int k = 0; k < 2; ++k) dst[n][k] = *(const LAS bf16x8*)(lds + PG8_SB(b, h) + boff + n * 2048 + k * 1024); } while (0)
#define PG8_MMA(ai, bj, At, Bt) do { __builtin_amdgcn_s_setprio(1); _Pragma("unroll") for (int m = 0; m < 4; ++m) _Pragma("unroll") for (int n = 0; n < 2; ++n) _Pragma("unroll") for (int k = 0; k < 2; ++k) \
        acc[ai][bj][m][n] = __builtin_amdgcn_mfma_f32_16x16x32_bf16(Bt[n][k], At[m][k], acc[ai][bj][m][n], 0, 0, 0); __builtin_amdgcn_s_setprio(0); } while (0)
#define PG8_WAIT_V(n) asm volatile("s_waitcnt vmcnt(" #n ")" ::: "memory")
#define PG8_WAIT_L(n) asm volatile("s_waitcnt lgkmcnt(" #n ")" ::: "memory")
#define PG8_BAR __builtin_amdgcn_s_barrier()
#define PG8_SCHED __builtin_amdgcn_sched_barrier(0)
    Unit cur, nxt; int ui = 0;
    if (!S.next(0, cur)) return;
    f32x4 acc[2][2][4][2];
#pragma unroll
    for (int a = 0; a < 2; ++a)
#pragma unroll
        for (int b = 0; b < 2; ++b)
#pragma unroll
            for (int m = 0; m < 4; ++m)
#pragma unroll
                for (int n = 0; n < 2; ++n) acc[a][b][m][n] = (f32x4){0.f, 0.f, 0.f, 0.f};
    bf16x8 At[4][2], B0[2][2], B1[2][2];
    unsigned vc[2][2], vn[2][2];
    S.a_voff(cur, Rr, Cc, vc);
    const char* cA = S.a_base(cur); const char* cB = S.b_base(cur);
    PG8_STAGE(PG8_SB(0, 0), cB, voffB); PG8_STAGE(PG8_SB(0, 1), cB + hstep, voffB); PG8_STAGE(PG8_SA(0, 0), cA, vc[0]); PG8_STAGE(PG8_SA(0, 1), cA, vc[1]);
    if (wr == 1) PG8_BAR;
    PG8_WAIT_V(2); PG8_BAR;
    PG8_STAGE(PG8_SB(1, 0), cB + kstep, voffB); PG8_STAGE(PG8_SA(1, 0), cA + kstep, vc[0]); PG8_STAGE(PG8_SB(1, 1), cB + hstep + kstep, voffB);
    PG8_WAIT_V(6); PG8_BAR;
    for (;;) {
        const bool has_next = S.next(ui + 1, nxt);
        const char* nA = has_next ? S.a_base(nxt) : cA; const char* nB = has_next ? S.b_base(nxt) : cB;
        if (has_next) S.a_voff(nxt, Rr, Cc, vn); else { vn[0][0] = vc[0][0]; vn[0][1] = vc[0][1]; vn[1][0] = vc[1][0]; vn[1][1] = vc[1][1]; }
        for (int t = 0; t < nt; t += 2) {
            const bool last = (t == nt - 2);
            const char* a1 = cA + (size_t)(t + 1) * kstep;
            const char* a2 = last ? nA : cA + (size_t)(t + 2) * kstep; const char* b2 = last ? nB : cB + (size_t)(t + 2) * kstep;
            const char* a3 = a2 + kstep; const char* b3 = b2 + kstep;
            unsigned w0[2], w1[2]; w0[0] = last ? vn[0][0] : vc[0][0]; w0[1] = last ? vn[0][1] : vc[0][1]; w1[0] = last ? vn[1][0] : vc[1][0]; w1[1] = last ? vn[1][1] : vc[1][1];
            PG8_LDB(B0, 0, 0); PG8_LDB(B1, 0, 1); PG8_SCHED; PG8_LDA(At, 0, 0); PG8_STAGE(PG8_SA(1, 1), a1, vc[1]);
            PG8_WAIT_V(8); PG8_WAIT_L(0); PG8_BAR; PG8_MMA(0, 0, At, B0); PG8_MMA(0, 1, At, B1); PG8_BAR; PG8_SCHED;
            PG8_LDA(At, 0, 1); PG8_STAGE(PG8_SB(0, 0), b2, voffB); PG8_STAGE(PG8_SB(0, 1), b2 + hstep, voffB); PG8_STAGE(PG8_SA(0, 0), a2, w0);
            PG8_WAIT_V(8); PG8_WAIT_L(0); PG8_BAR; PG8_MMA(1, 0, At, B0); PG8_MMA(1, 1, At, B1); PG8_BAR; PG8_SCHED;
            PG8_LDB(B0, 1, 0); PG8_LDB(B1, 1, 1); PG8_SCHED; PG8_LDA(At, 1, 0); PG8_STAGE(PG8_SA(0, 1), a2, w1);
            PG8_WAIT_V(8); PG8_WAIT_L(0); PG8_BAR; PG8_MMA(0, 0, At, B0); PG8_MMA(0, 1, At, B1); PG8_BAR; PG8_SCHED;
            PG8_LDA(At, 1, 1); PG8_STAGE(PG8_SB(1, 0), b3, voffB); PG8_STAGE(PG8_SB(1, 1), b3 + hstep, voffB); PG8_STAGE(PG8_SA(1, 0), a3, w0);
            PG8_WAIT_V(8); PG8_WAIT_L(0); PG8_BAR; PG8_MMA(1, 0, At, B0); PG8_MMA(1, 1, At, B1); PG8_BAR; PG8_SCHED;
        }
        if (wr == 0) PG8_BAR;
        E(acc, cur, wr, wc, fr, fq);
        if (!has_next) break;
#pragma unroll
        for (int a = 0; a < 2; ++a)
#pragma unroll
            for (int b = 0; b < 2; ++b)
#pragma unroll
                for (int m = 0; m < 4; ++m)
#pragma unroll
                    for (int n = 0; n < 2; ++n) acc[a][b][m][n] = (f32x4){0.f, 0.f, 0.f, 0.f};
        cur = nxt; cA = nA; cB = nB; ++ui;
        vc[0][0] = vn[0][0]; vc[0][1] = vn[0][1]; vc[1][0] = vn[1][0]; vc[1][1] = vn[1][1];
        if (wr == 1) PG8_BAR;
    }
    PG8_WAIT_V(0);
    PG8_BAR;
#undef PG8_SA
#undef PG8_SB
#undef PG8_STAGE
#undef PG8_LDA
#undef PG8_LDB
#undef PG8_MMA
#undef PG8_WAIT_V
#undef PG8_WAIT_L
#undef PG8_BAR
#undef PG8_SCHED
}

struct DenseProb {
    const bf16_t* A; const bf16_t* Bt; int lda, K, acol;
    StaticOrder so;
    __device__ __forceinline__ bool next(int i, Unit& u) const { u.ord = i; u.e = 0; u.cnt = 256; return so.next(i, u.pm, u.pn); }
    __device__ __forceinline__ const char* a_base(const Unit& u) const { return (const char*)(A + (size_t)u.pm * BM * lda + (size_t)u.pn * acol); }
    __device__ __forceinline__ const char* b_base(const Unit& u) const { return (const char*)(Bt + (size_t)u.pn * BM * K); }
    __device__ __forceinline__ void a_voff(const Unit&, const int (&R)[2], const int (&C)[2], unsigned (&vo)[2][2]) const {
#pragma unroll
        for (int h = 0; h < 2; ++h)
#pragma unroll
            for (int i = 0; i < 2; ++i) vo[h][i] = (unsigned)((h * HALF + R[i]) * lda + C[i]) * 2u;
    }
};

struct MoeProb {
    const bf16_t* A; const bf16_t* Bt; int lda, K, nN, shift;
    LAS const int* tab;
    LAS const int* expt;
    int G, c;
    __device__ __forceinline__ bool next(int i, Unit& u) const {
        const int per = G >> 3, xcd = c & 7, rank = c >> 3;
        const int L = (i * 8 + xcd) * per + rank;
        if (L >= expt[32] || i >= TAB_UNITS) return false;
        int e = 0;
#pragma unroll 1
        while (e < 31 && L >= expt[e + 1]) ++e;
        const int q = L - expt[e], cnt = expt[33 + e], T = (cnt + 255) >> 8;
        u.e = e; u.pn = q / T; u.pm = q % T; u.ord = i; u.cnt = cnt - u.pm * 256; return true;
    }
    __device__ __forceinline__ const char* a_base(const Unit&) const { return (const char*)A; }
    __device__ __forceinline__ const char* b_base(const Unit& u) const { return (const char*)(Bt + ((size_t)u.e * nN + u.pn) * BM * K); }
    __device__ __forceinline__ void a_voff(const Unit& u, const int (&R)[2], const int (&C)[2], unsigned (&vo)[2][2]) const {
#pragma unroll
        for (int h = 0; h < 2; ++h)
#pragma unroll
            for (int i = 0; i < 2; ++i) { const unsigned row = ((unsigned)tab[u.ord * 256 + h * HALF + R[i]] & 0x7fffffffu) >> shift; vo[h][i] = (row * (unsigned)lda + (unsigned)C[i]) * 2u; }
    }
};

struct EpiRowScaleBf16 {
    static constexpr bool PERM = true;
    bf16_t* O; int ldc; const float* rs;
    __device__ __forceinline__ void operator()(const f32x4 (&acc)[2][2][4][2], const Unit& u, int wr, int wc, int fr, int fq) const {
        const int row0 = u.pm * BM + wr * 64 + fr, col0 = u.pn * BM + wc * 32 + 8 * fq;
#pragma unroll
        for (int ai = 0; ai < 2; ++ai)
#pragma unroll
            for (int m = 0; m < 4; ++m) { const int row = row0 + ai * HALF + m * 16; const float s = rs[row]; bf16_t* rowp = O + (size_t)row * ldc + col0;
#pragma unroll
                for (int bj = 0; bj < 2; ++bj) { const f32x4 v0 = acc[ai][bj][m][0] * s, v1 = acc[ai][bj][m][1] * s;
                    u32x4 w; w.x = cvt_pk_bf16(v0[0], v0[1]); w.y = cvt_pk_bf16(v0[2], v0[3]); w.z = cvt_pk_bf16(v1[0], v1[1]); w.w = cvt_pk_bf16(v1[2], v1[3]);
                    *(u32x4*)(rowp + bj * HALF) = w; } }
    }
};
struct EpiBf16 {
    static constexpr bool PERM = true;
    bf16_t* O; int ldc, cbase;
    __device__ __forceinline__ void operator()(const f32x4 (&acc)[2][2][4][2], const Unit& u, int wr, int wc, int fr, int fq) const {
        const int row0 = u.pm * BM + wr * 64 + fr, col0 = cbase + u.pn * BM + wc * 32 + 8 * fq;
#pragma unroll
        for (int ai = 0; ai < 2; ++ai)
#pragma unroll
            for (int m = 0; m < 4; ++m) { bf16_t* rowp = O + (size_t)(row0 + ai * HALF + m * 16) * ldc + col0;
#pragma unroll
                for (int bj = 0; bj < 2; ++bj) { const f32x4 v0 = acc[ai][bj][m][0], v1 = acc[ai][bj][m][1];
                    u32x4 w; w.x = cvt_pk_bf16(v0[0], v0[1]); w.y = cvt_pk_bf16(v0[2], v0[3]); w.z = cvt_pk_bf16(v1[0], v1[1]); w.w = cvt_pk_bf16(v1[2], v1[3]);
                    *(u32x4*)(rowp + bj * HALF) = w; } }
    }
};
struct EpiResF32 {
    static constexpr bool PERM = false;
    const float* base; float* out; int ldc;
    __device__ __forceinline__ void operator()(const f32x4 (&acc)[2][2][4][2], const Unit& u, int wr, int wc, int fr, int fq) const {
        const int row0 = u.pm * BM + wr * 64 + fr, col0 = u.pn * BM + wc * 32 + 4 * fq;
#pragma unroll
        for (int ai = 0; ai < 2; ++ai)
#pragma unroll
            for (int m = 0; m < 4; ++m) { const size_t off = (size_t)(row0 + ai * HALF + m * 16) * ldc + col0;
#pragma unroll
                for (int bj = 0; bj < 2; ++bj)
#pragma unroll
                    for (int n = 0; n < 2; ++n) { const f32x4 bs = *(const f32x4*)(base + off + bj * HALF + n * 16); *(f32x4*)(out + off + bj * HALF + n * 16) = bs + acc[ai][bj][m][n]; } }
    }
};
struct EpiSwiGLU {
    static constexpr bool PERM = true;
    bf16_t* act; const float* rtok; const float* gate; LAS const int* tab;
    __device__ __forceinline__ void operator()(const f32x4 (&acc)[2][2][4][2], const Unit& u, int wr, int wc, int fr, int fq) const {
        const int col0 = u.pn * HALF + wc * 32 + 8 * fq;
#pragma unroll
        for (int ai = 0; ai < 2; ++ai)
#pragma unroll
            for (int m = 0; m < 4; ++m) { const int rl = ai * HALF + wr * 64 + m * 16 + fr; const int a = tab[u.ord * 256 + rl];
                if (a >= 0) { const float r = rtok[a >> 1], gt = gate[a]; float o[8];
#pragma unroll
                    for (int n = 0; n < 2; ++n)
#pragma unroll
                        for (int j = 0; j < 4; ++j) { const float g = acc[ai][0][m][n][j] * r, up = acc[ai][1][m][n][j] * r; o[n * 4 + j] = g / (1.0f + __expf(-g)) * up * gt; }
                    u32x4 w; w.x = cvt_pk_bf16(o[0], o[1]); w.y = cvt_pk_bf16(o[2], o[3]); w.z = cvt_pk_bf16(o[4], o[5]); w.w = cvt_pk_bf16(o[6], o[7]);
                    *(u32x4*)(act + (size_t)a * DEXP + col0) = w; } }
    }
};
struct EpiScatterBf16 {
    static constexpr bool PERM = true;
    bf16_t* Y; int ldc; LAS const int* tab;
    __device__ __forceinline__ void operator()(const f32x4 (&acc)[2][2][4][2], const Unit& u, int wr, int wc, int fr, int fq) const {
        const int col0 = u.pn * BM + wc * 32 + 8 * fq;
#pragma unroll
        for (int ai = 0; ai < 2; ++ai)
#pragma unroll
            for (int m = 0; m < 4; ++m) { const int rl = ai * HALF + wr * 64 + m * 16 + fr; const int a = tab[u.ord * 256 + rl];
                if (a >= 0) { bf16_t* rowp = Y + (size_t)a * ldc + col0;
#pragma unroll
                    for (int bj = 0; bj < 2; ++bj) { const f32x4 v0 = acc[ai][bj][m][0], v1 = acc[ai][bj][m][1];
                        u32x4 w; w.x = cvt_pk_bf16(v0[0], v0[1]); w.y = cvt_pk_bf16(v0[2], v0[3]); w.z = cvt_pk_bf16(v1[0], v1[1]); w.w = cvt_pk_bf16(v1[2], v1[3]);
                        *(u32x4*)(rowp + bj * HALF) = w; } } }
    }
};
}

struct Frame {
    LAS unsigned char* lds;
    gu32* ctl;
    int tid, lane, wave, G, bx;
    const float *x, *norm_mix, *w_in, *q_norm, *k_norm, *sinks, *w_pool, *pool_scale, *w_out, *norm_ffn, *w_coarse, *b_coarse, *w_fine, *b_fine, *w_gate, *w_up, *w_down;
    float* out;
    float *rope, *rinv, *rtok, *gate;
    bf16_t *Wr, *Wpool, *Win, *Wout, *Wgu, *Wd, *XB, *PROJ, *MIXED, *DPOOL, *ACT, *Y;
    int* rowl;
};

__device__ __forceinline__ void tr_item(const float* W, int N, int k0, int n0, bf16_t* dst0, int Kd, const float* gk, const float* gn, LAS float* scr, int lane) {
    const int kk0 = lane >> 3, n4 = (lane & 7) * 4;
    f32x4 v[8];
#pragma unroll
    for (int i = 0; i < 8; ++i) v[i] = *(const GAS f32x4*)(W + (size_t)(k0 + 8 * i + kk0) * N + n0 + n4);
    f32x4 sn = (f32x4){1.f, 1.f, 1.f, 1.f}; if (gn) sn = *(const GAS f32x4*)(gn + n0 + n4);
#pragma unroll
    for (int i = 0; i < 8; ++i) { const float g = gk ? gk[k0 + 8 * i + kk0] : 1.0f; const f32x4 w = v[i] * sn * g; LAS float* d = scr + (8 * i + kk0) * 33 + n4; d[0] = w.x; d[1] = w.y; d[2] = w.z; d[3] = w.w; }
    LDS_WAIT(); asm volatile("" ::: "memory");
    const int c = lane & 7;
#pragma unroll
    for (int j = 0; j < 4; ++j) { const int n = (lane >> 3) + 8 * j; const LAS float* s = scr + (8 * c) * 33 + n;
        u32x4 o; o.x = pk2(s[0 * 33], s[1 * 33]); o.y = pk2(s[2 * 33], s[3 * 33]); o.z = pk2(s[4 * 33], s[5 * 33]); o.w = pk2(s[6 * 33], s[7 * 33]);
        *(GAS u32x4*)(dst0 + (size_t)n * Kd + k0 + 8 * c) = o; }
    LDS_WAIT(); asm volatile("" ::: "memory");
}

__device__ __forceinline__ void p0_prologue(Frame& F) {
    const int gw = F.bx * 8 + F.wave, NGW = F.G * 8, gt = F.bx * 512 + F.tid, NGT = F.G * 512;
    LAS float* scr = (LAS float*)(F.lds + F.wave * 16384);
    for (int i = gt; i < SEQ * 8; i += NGT) {
        const int pos = i >> 3, j = i & 7;
        const double invf[8] = {1.0, 0.19392274474868576, 0.03760603093086393, 0.007292664737217109, 0.001414213562373095, 0.0002742481756762073, 5.318295896944988e-05, 1.031338537721246e-05};
        double f = invf[0];
#pragma unroll
        for (int q = 1; q < 8; ++q) f = (j == q) ? invf[q] : f;
        double s, c; sincos((double)pos * f, &s, &c);
        F.rope[pos * 16 + j] = (float)c; F.rope[pos * 16 + 8 + j] = (float)s;
    }
    for (int i = gt; i < 64 * DM; i += NGT) {
        const int j = i / DM, k = i % DM; float v = 0.f;
        if (j < 4) v = F.w_coarse[k * 4 + j] * F.norm_ffn[k]; else if (j < 36) v = F.w_fine[k * 32 + (j - 4)] * F.norm_ffn[k];
        const unsigned hi = f2bf(v); const float lo = v - bflo(hi);
        F.Wr[i] = (bf16_t)hi; F.Wr[64 * DM + i] = (bf16_t)f2bf(lo);
    }
    constexpr int I_IN = (DM / 64) * (INW / 32), I_OUT = (DM / 64) * (DM / 32), I_POOL = 4 * (256 / 64) * (256 / 32), I_G = NEXP * (DM / 64) * (DEXP / 32), I_D = NEXP * (DEXP / 64) * (DM / 32);
    constexpr int NITEMS = I_IN + I_OUT + I_POOL + 2 * I_G + I_D;
    for (int it = gw; it < NITEMS; it += NGW) {
        int r = it;
        if (r < I_IN) { const int nb = INW / 32, kb = r / nb, nn = r % nb; tr_item(F.w_in, INW, 64 * kb, 32 * nn, F.Win + (size_t)(32 * nn) * DM, DM, F.norm_mix, nullptr, scr, F.lane); continue; } r -= I_IN;
        if (r < I_OUT) { const int nb = DM / 32, kb = r / nb, nn = r % nb; tr_item(F.w_out, DM, 64 * kb, 32 * nn, F.Wout + (size_t)(32 * nn) * DM, DM, nullptr, nullptr, scr, F.lane); continue; } r -= I_OUT;
        if (r < I_POOL) { const int g = r / 32, q = r % 32, kb = q / 8, nn = q % 8;
            tr_item(F.w_pool + (size_t)g * 65536, 256, 64 * kb, 32 * nn, F.Wpool + (size_t)g * 65536 + (size_t)(32 * nn) * 256, 256, nullptr, F.pool_scale + g * 256, scr, F.lane); continue; } r -= I_POOL;
        if (r < 2 * I_G) { const int up = r >= I_G; if (up) r -= I_G; const int per = (DM / 64) * (DEXP / 32), e = r / per, q = r % per, nb = DEXP / 32, kb = q / nb, nn = q % nb, n0 = 32 * nn;
            const float* W = (up ? F.w_up : F.w_gate) + (size_t)e * DM * DEXP;
            bf16_t* dst = F.Wgu + ((size_t)e * 1024 + (size_t)(n0 >> 7) * 256 + (up ? 128 : 0) + (n0 & 127)) * DM;
            tr_item(W, DEXP, 64 * kb, n0, dst, DM, F.norm_ffn, nullptr, scr, F.lane); continue; } r -= 2 * I_G;
        { const int per = (DEXP / 64) * (DM / 32), e = r / per, q = r % per, nb = DM / 32, kb = q / nb, nn = q % nb;
          tr_item(F.w_down + (size_t)e * DEXP * DM, DM, 64 * kb, 32 * nn, F.Wd + ((size_t)e * DM + 32 * nn) * DEXP, DEXP, nullptr, nullptr, scr, F.lane); }
    }
    for (int m = gw; m < NTOK; m += NGW) {
        const GAS f32x4* xr = (const GAS f32x4*)(F.x + (size_t)m * DM) + F.lane;
        f32x4 v[8]; float s = 0.f;
#pragma unroll
        for (int j = 0; j < 8; ++j) { v[j] = xr[64 * j]; s += (v[j].x * v[j].x + v[j].y * v[j].y) + (v[j].z * v[j].z + v[j].w * v[j].w); }
        s = wave_sum(s);
        if (F.lane == 0) F.rinv[m] = 1.0f / sqrtf(s * (1.0f / DM) + EPS);
        GAS u32x2* o8 = (GAS u32x2*)(F.XB + (size_t)m * DM) + F.lane;
#pragma unroll
        for (int j = 0; j < 8; ++j) { u32x2 w; w.x = pk2(v[j].x, v[j].y); w.y = pk2(v[j].z, v[j].w); o8[64 * j] = w; }
    }
}

constexpr int AT_K = 0, AT_V = 32768, AT_VSTR = 520;
__device__ __forceinline__ void attn_unit(Frame& F, int b, int n, int kvh) {
    LAS unsigned char* lds = F.lds;
    const int tid = F.tid, lane = F.lane, wid = F.wave;
    const size_t tok0 = (size_t)b * SEQ;
    const int g = wid & 3, head = kvh * 4 + g, ql = lane & 31, hi = lane >> 5;
    u32x4 qraw[2][4];
#pragma unroll
    for (int it = 0; it < 2; ++it) { const int s = (wid >> 2) + 2 * it; const bf16_t* qp = F.PROJ + (tok0 + n * 128 + 32 * s + ql) * INW + QOFF + head * HD + hi * 8;
#pragma unroll
        for (int d0 = 0; d0 < 4; ++d0) qraw[it][d0] = *(const GAS u32x4*)(qp + d0 * 16); }
    u32x4 kraw[4], vraw[2][2];
#pragma unroll
    for (int i = 0; i < 4; ++i) { const int idx = i * 512 + tid, row = idx >> 3, c = idx & 7, pos = n * 128 - 128 + row;
        kraw[i] = (u32x4){0u, 0u, 0u, 0u};
        if (pos >= 0) kraw[i] = *(const GAS u32x4*)(F.PROJ + (tok0 + pos) * INW + KOFF + kvh * HD + c * 8); }
#pragma unroll
    for (int i = 0; i < 2; ++i) { const int idx = i * 512 + tid, kp = idx >> 3, c = idx & 7, pos = n * 128 - 128 + 2 * kp;
        vraw[i][0] = (u32x4){0u, 0u, 0u, 0u}; vraw[i][1] = (u32x4){0u, 0u, 0u, 0u};
        if (pos >= 0) { const bf16_t* p = F.PROJ + (tok0 + pos) * INW + VOFF + kvh * HD + c * 8; vraw[i][0] = *(const GAS u32x4*)p; vraw[i][1] = *(const GAS u32x4*)(p + INW); } }
#pragma unroll
    for (int i = 0; i < 4; ++i) {
        const int idx = i * 512 + tid, row = idx >> 3, c = idx & 7, pos = n * 128 - 128 + row;
        const u32x4 raw = kraw[i];
        float xv[8] = {bflo(raw.x), bfhi(raw.x), bflo(raw.y), bfhi(raw.y), bflo(raw.z), bfhi(raw.z), bflo(raw.w), bfhi(raw.w)};
        float ss = 0.f;
#pragma unroll
        for (int j = 0; j < 8; ++j) ss += xv[j] * xv[j];
        ss += __shfl_xor(ss, 1); ss += __shfl_xor(ss, 2); ss += __shfl_xor(ss, 4);
        const float rn = 1.0f / sqrtf(ss * (1.0f / HD) + EPS);
#pragma unroll
        for (int j = 0; j < 8; ++j) xv[j] = xv[j] * rn * F.k_norm[c * 8 + j];
        const int pp = pos >= 0 ? pos : 0;
#pragma unroll
        for (int j = 0; j < 8; ++j) { const float pr = __shfl_xor(xv[j], 1); const float cs = F.rope[pp * 16 + j], sn = F.rope[pp * 16 + 8 + j];
            const float r0 = xv[j] * cs - pr * sn, r1 = xv[j] * cs + pr * sn; xv[j] = (c == 0) ? r0 : (c == 1) ? r1 : xv[j]; }
        u32x4 w; w.x = pk2(xv[0], xv[1]); w.y = pk2(xv[2], xv[3]); w.z = pk2(xv[4], xv[5]); w.w = pk2(xv[6], xv[7]);
        *(LAS u32x4*)(lds + AT_K + row * 128 + ((c ^ (row & 7)) * 16)) = w;
    }
#pragma unroll
    for (int i = 0; i < 2; ++i) {
        const int idx = i * 512 + tid, kp = idx >> 3, c = idx & 7;
        const u32x4 r0 = vraw[i][0], r1 = vraw[i][1];
        const unsigned a0[4] = {r0.x, r0.y, r0.z, r0.w}, a1[4] = {r1.x, r1.y, r1.z, r1.w};
#pragma unroll
        for (int q = 0; q < 4; ++q) {
            const unsigned lo = (a0[q] & 0xffffu) | (a1[q] << 16), hi2 = (a0[q] >> 16) | (a1[q] & 0xffff0000u);
            *(LAS unsigned*)(lds + AT_V + (c * 8 + 2 * q) * AT_VSTR + kp * 4) = lo;
            *(LAS unsigned*)(lds + AT_V + (c * 8 + 2 * q + 1) * AT_VSTR + kp * 4) = hi2;
        }
    }
    __syncthreads();
    const float sink2 = F.sinks[head] * 1.4426950408889634f;
    const float SC = 0.125f * 1.4426950408889634f;
#pragma unroll
    for (int it = 0; it < 2; ++it) {
        const int s = (wid >> 2) + 2 * it;
        const int qpos = n * 128 + 32 * s + ql;
        float qv[4][8];
        float ss = 0.f;
#pragma unroll
        for (int d0 = 0; d0 < 4; ++d0) { const u32x4 raw = qraw[it][d0];
            qv[d0][0] = bflo(raw.x); qv[d0][1] = bfhi(raw.x); qv[d0][2] = bflo(raw.y); qv[d0][3] = bfhi(raw.y); qv[d0][4] = bflo(raw.z); qv[d0][5] = bfhi(raw.z); qv[d0][6] = bflo(raw.w); qv[d0][7] = bfhi(raw.w);
#pragma unroll
            for (int j = 0; j < 8; ++j) ss += qv[d0][j] * qv[d0][j]; }
        ss += __shfl_xor(ss, 32);
        const float rn = SC / sqrtf(ss * (1.0f / HD) + EPS);
#pragma unroll
        for (int d0 = 0; d0 < 4; ++d0)
#pragma unroll
            for (int j = 0; j < 8; ++j) qv[d0][j] = qv[d0][j] * rn * F.q_norm[d0 * 16 + hi * 8 + j];
#pragma unroll
        for (int j = 0; j < 8; ++j) { const float pr = __shfl_xor(qv[0][j], 32); const float cs = F.rope[qpos * 16 + j], sn = F.rope[qpos * 16 + 8 + j];
            qv[0][j] = (hi == 0) ? (qv[0][j] * cs - pr * sn) : (qv[0][j] * cs + pr * sn); }
        bf16x8 qr[4];
#pragma unroll
        for (int d0 = 0; d0 < 4; ++d0) { u32x4 w; w.x = pk2(qv[d0][0], qv[d0][1]); w.y = pk2(qv[d0][2], qv[d0][3]); w.z = pk2(qv[d0][4], qv[d0][5]); w.w = pk2(qv[d0][6], qv[d0][7]);
            qr[d0] = __builtin_bit_cast(bf16x8, w); }
        f32x16 p[5];
#pragma unroll
        for (int jt = 0; jt < 5; ++jt) {
            const int krow = 32 * (s + jt) + ql;
            f32x16 a = {};
#pragma unroll
            for (int d0 = 0; d0 < 4; ++d0) { const int c = 2 * d0 + hi;
                const bf16x8 kf = *(const LAS bf16x8*)(lds + AT_K + krow * 128 + ((c ^ (krow & 7)) * 16));
                a = __builtin_amdgcn_mfma_f32_32x32x16_bf16(kf, qr[d0], a, 0, 0, 0); }
            p[jt] = a;
        }
        float mx = sink2;
#pragma unroll
        for (int jt = 0; jt < 5; ++jt) {
            const bool blk_dead = (n == 0) && (s + jt < 4);
#pragma unroll
            for (int r = 0; r < 16; ++r) { const int kl = (r & 3) + 8 * (r >> 2) + 4 * hi;
                bool ok = !blk_dead; if (jt == 0) ok = ok && (kl > ql); if (jt == 4) ok = ok && (kl <= ql);
                const float v = ok ? p[jt][r] : -1e30f; p[jt][r] = v; mx = fmaxf(mx, v); }
        }
        mx = fmaxf(mx, __shfl_xor(mx, 32));
        float sum = 0.f;
#pragma unroll
        for (int jt = 0; jt < 5; ++jt)
#pragma unroll
            for (int r = 0; r < 16; ++r) { const float e = __builtin_amdgcn_exp2f(p[jt][r] - mx); p[jt][r] = e; sum += e; }
        sum += __shfl_xor(sum, 32);
        sum += __builtin_amdgcn_exp2f(sink2 - mx);
        const float inv = 1.0f / sum;
        f32x16 o[2]; o[0] = f32x16{}; o[1] = f32x16{};
#pragma unroll
        for (int jt = 0; jt < 5; ++jt)
#pragma unroll
            for (int s2 = 0; s2 < 2; ++s2) {
                u32x4 pw; pw.x = cvt_pk_bf16(p[jt][8 * s2 + 0] * inv, p[jt][8 * s2 + 1] * inv); pw.y = cvt_pk_bf16(p[jt][8 * s2 + 2] * inv, p[jt][8 * s2 + 3] * inv);
                pw.z = cvt_pk_bf16(p[jt][8 * s2 + 4] * inv, p[jt][8 * s2 + 5] * inv); pw.w = cvt_pk_bf16(p[jt][8 * s2 + 6] * inv, p[jt][8 * s2 + 7] * inv);
                const bf16x8 pf = __builtin_bit_cast(bf16x8, pw);
                const int kb = 32 * (s + jt) + 16 * s2 + 4 * hi;
#pragma unroll
                for (int dt = 0; dt < 2; ++dt) {
                    const LAS unsigned char* vp = lds + AT_V + (dt * 32 + ql) * AT_VSTR + kb * 2;
                    const u32x2 v0 = *(const LAS u32x2*)vp, v1 = *(const LAS u32x2*)(vp + 16);
                    u32x4 vw; vw.x = v0.x; vw.y = v0.y; vw.z = v1.x; vw.w = v1.y;
                    o[dt] = __builtin_amdgcn_mfma_f32_32x32x16_bf16(__builtin_bit_cast(bf16x8, vw), pf, o[dt], 0, 0, 0);
                }
            }
        bf16_t* op = F.MIXED + (tok0 + qpos) * DM + head * HD + (hi ? 8 : 0);
#pragma unroll
        for (int dt = 0; dt < 2; ++dt)
#pragma unroll
            for (int gp = 0; gp < 2; ++gp) {
                const int r0 = 8 * gp;
                unsigned ax = cvt_pk_bf16(o[dt][r0 + 0], o[dt][r0 + 1]), ay = cvt_pk_bf16(o[dt][r0 + 2], o[dt][r0 + 3]);
                unsigned bx = cvt_pk_bf16(o[dt][r0 + 4], o[dt][r0 + 5]), by = cvt_pk_bf16(o[dt][r0 + 6], o[dt][r0 + 7]);
                { auto rr = __builtin_amdgcn_permlane32_swap(ax, bx, false, false); ax = rr[0]; bx = rr[1]; }
                { auto rr = __builtin_amdgcn_permlane32_swap(ay, by, false, false); ay = rr[0]; by = rr[1]; }
                u32x4 w; w.x = ax; w.y = ay; w.z = bx; w.w = by;
                *(GAS u32x4*)(op + dt * 32 + 16 * gp) = w;
            }
    }
    __syncthreads();
}

__device__ __forceinline__ void pool_diff(Frame& F) {
    const int NITEM = (NTOK / 32) * 128;
    for (int it = F.bx * 512 + F.tid; it < NITEM; it += F.G * 512) {
        const int ri = it >> 7, c8 = it & 127, w = 2 << (c8 >> 5), t0 = ri * 32, pos0 = t0 & (SEQ - 1);
        const bf16_t* up = F.PROJ + (size_t)t0 * INW + UOFF + c8 * 8;
        float S[8];
#pragma unroll
        for (int j = 0; j < 8; ++j) S[j] = 0.f;
        for (int i = 1; i < w; ++i) if (pos0 - i >= 0) { const u32x4 raw = *(const GAS u32x4*)(up - (size_t)i * INW);
            S[0] += bflo(raw.x); S[1] += bfhi(raw.x); S[2] += bflo(raw.y); S[3] += bfhi(raw.y); S[4] += bflo(raw.z); S[5] += bfhi(raw.z); S[6] += bflo(raw.w); S[7] += bfhi(raw.w); }
#pragma unroll 4
        for (int t = 0; t < 32; ++t) {
            const u32x4 raw = *(const GAS u32x4*)(up + (size_t)t * INW);
            const float xv[8] = {bflo(raw.x), bfhi(raw.x), bflo(raw.y), bfhi(raw.y), bflo(raw.z), bfhi(raw.z), bflo(raw.w), bfhi(raw.w)};
            const int pos = pos0 + t; const float ic = 1.0f / (float)((pos + 1 < w) ? (pos + 1) : w);
            float d[8];
#pragma unroll
            for (int j = 0; j < 8; ++j) { S[j] += xv[j]; d[j] = S[j] * ic - xv[j]; }
            u32x4 o; o.x = pk2(d[0], d[1]); o.y = pk2(d[2], d[3]); o.z = pk2(d[4], d[5]); o.w = pk2(d[6], d[7]);
            *(GAS u32x4*)(F.DPOOL + (size_t)(t0 + t) * PW + c8 * 8) = o;
            if (pos - w + 1 >= 0) { const u32x4 old = *(const GAS u32x4*)(up + (ptrdiff_t)(t - w + 1) * INW);
                S[0] -= bflo(old.x); S[1] -= bfhi(old.x); S[2] -= bflo(old.y); S[3] -= bfhi(old.y); S[4] -= bflo(old.z); S[5] -= bfhi(old.z); S[6] -= bflo(old.w); S[7] -= bfhi(old.w); }
        }
    }
}

constexpr int RT_WSTR = 528, RT_W = 0, RT_WLO = 64 * RT_WSTR, RT_L = 2 * 64 * RT_WSTR, RT_LSTR = 65;
__device__ __forceinline__ void route_phase(Frame& F, bool dry) {
    LAS unsigned char* lds = F.lds;
    const int tid = F.tid, lane = F.lane, wid = F.wave, row = lane & 15, kq = lane >> 4;
    for (int tile = F.bx; tile < NTOK / 128; tile += F.G) {
        const int t0 = tile * 128 + wid * 16;
        const float* hp = F.out + (size_t)(t0 + row) * DM + kq * 8;
        bf16_t* hb = F.XB + (size_t)(t0 + row) * DM + kq * 8;
        f32x4 acc[4]; acc[0] = acc[1] = acc[2] = acc[3] = (f32x4){0.f, 0.f, 0.f, 0.f};
        float ssq = 0.f;
#pragma unroll 1
        for (int kc = 0; kc < 8; ++kc) {
            __syncthreads();
#pragma unroll
            for (int i = 0; i < 8; ++i) { const int p = i * 512 + tid, which = p >> 11, col = (p & 2047) >> 5, ch = p & 31;
                const u32x4 v = *(const GAS u32x4*)(F.Wr + (size_t)which * 64 * DM + (size_t)col * DM + kc * 256 + ch * 8);
                *(LAS u32x4*)(lds + which * RT_WLO + col * RT_WSTR + ch * 16) = v; }
            __syncthreads();
#pragma unroll 4
            for (int ks = 0; ks < 8; ++ks) {
                const int k = kc * 256 + ks * 32;
                const f32x4 v0 = *(const GAS f32x4*)(hp + k), v1 = *(const GAS f32x4*)(hp + k + 4);
                const float xv[8] = {v0.x, v0.y, v0.z, v0.w, v1.x, v1.y, v1.z, v1.w};
                u32x4 ah, al;
                { unsigned hw[4], lw[4];
#pragma unroll
                  for (int j = 0; j < 4; ++j) { const float a0 = xv[2 * j], a1 = xv[2 * j + 1]; ssq += a0 * a0 + a1 * a1; hw[j] = cvt_pk_bf16(a0, a1); lw[j] = cvt_pk_bf16(a0 - bflo(hw[j]), a1 - bfhi(hw[j])); }
                  ah.x = hw[0]; ah.y = hw[1]; ah.z = hw[2]; ah.w = hw[3]; al.x = lw[0]; al.y = lw[1]; al.z = lw[2]; al.w = lw[3]; }
                *(GAS u32x4*)(hb + k) = ah;
                const bf16x8 Ah = __builtin_bit_cast(bf16x8, ah), Al = __builtin_bit_cast(bf16x8, al);
#pragma unroll
                for (int tc = 0; tc < 4; ++tc) {
                    const LAS unsigned char* bp = lds + (tc * 16 + row) * RT_WSTR + (ks * 32 + kq * 8) * 2;
                    const bf16x8 Bh = *(const LAS bf16x8*)bp, Bl = *(const LAS bf16x8*)(bp + RT_WLO);
                    acc[tc] = __builtin_amdgcn_mfma_f32_16x16x32_bf16(Ah, Bh, acc[tc], 0, 0, 0);
                    acc[tc] = __builtin_amdgcn_mfma_f32_16x16x32_bf16(Al, Bh, acc[tc], 0, 0, 0);
                    acc[tc] = __builtin_amdgcn_mfma_f32_16x16x32_bf16(Ah, Bl, acc[tc], 0, 0, 0);
                }
            }
        }
        ssq += __shfl_xor(ssq, 16); ssq += __shfl_xor(ssq, 32);
        const float rt = 1.0f / sqrtf(ssq * (1.0f / DM) + EPS);
        LAS float* L = (LAS float*)(lds + RT_L) + wid * 16 * RT_LSTR;
#pragma unroll
        for (int tc = 0; tc < 4; ++tc)
#pragma unroll
            for (int r = 0; r < 4; ++r) L[(kq * 4 + r) * RT_LSTR + tc * 16 + row] = acc[tc][r];
        __syncthreads();
        if (lane < 16) {
            const int t = t0 + lane; const LAS float* Lt = L + lane * RT_LSTR;
            float c[4]; int grp = 0; float cm;
#pragma unroll
            for (int j = 0; j < 4; ++j) c[j] = Lt[j] * rt + F.b_coarse[j];
            cm = c[0];
#pragma unroll
            for (int j = 1; j < 4; ++j) if (c[j] > cm) { cm = c[j]; grp = j; }
            float den = 0.f;
#pragma unroll
            for (int j = 0; j < 4; ++j) den += __expf(c[j] - cm);
            const float pg = 1.0f / den;
            float f[8];
#pragma unroll
            for (int j = 0; j < 8; ++j) f[j] = Lt[4 + grp * 8 + j] * rt + F.b_fine[grp * 8 + j];
            int i1 = 0; float l1 = f[0];
#pragma unroll
            for (int j = 1; j < 8; ++j) if (f[j] > l1) { l1 = f[j]; i1 = j; }
            int i2 = -1; float l2 = -3.0e38f;
#pragma unroll
            for (int j = 0; j < 8; ++j) if (j != i1 && f[j] > l2) { l2 = f[j]; i2 = j; }
            const float e2 = __expf(l2 - l1), g1 = pg / (1.0f + e2), g2 = pg * e2 / (1.0f + e2);
            F.rtok[t] = rt; F.gate[2 * t] = g1; F.gate[2 * t + 1] = g2;
            const int e1 = grp * 8 + i1, ee2 = grp * 8 + i2;
            if (!dry) {
            const unsigned p1 = __hip_atomic_fetch_add((unsigned*)(F.ctl + CW_CNT + 64 * e1), 1u, RLX_AGENT);
            F.rowl[(size_t)e1 * RCAP + p1] = 2 * t;
            const unsigned p2 = __hip_atomic_fetch_add((unsigned*)(F.ctl + CW_CNT + 64 * ee2), 1u, RLX_AGENT);
            F.rowl[(size_t)ee2 * RCAP + p2] = 2 * t + 1; }
        }
    }
}

__device__ __forceinline__ void moe_setup(Frame& F, int nN) {
    LAS int* expt = (LAS int*)(F.lds + EXPT_OFF); LAS int* tab = (LAS int*)(F.lds + TAB_OFF);
    __syncthreads();
    if (F.tid == 0) { int acc = 0;
        for (int e = 0; e < NEXP; ++e) { const int cnt = (int)__hip_atomic_load((unsigned*)(F.ctl + CW_CNT + 64 * e), RLX_AGENT); expt[e] = acc; expt[33 + e] = cnt; acc += ((cnt + 255) >> 8) * nN; }
        expt[32] = acc; }
    __syncthreads();
    pg8::MoeProb P; P.expt = expt; P.nN = nN; P.G = F.G; P.c = F.bx;
    pg8::Unit u;
    for (int i = 0; P.next(i, u); ++i) {
        if (F.tid < 256) { const int j = u.pm * 256 + F.tid; const int cnt = expt[33 + u.e];
            const int v = F.rowl[(size_t)u.e * RCAP + (j < cnt ? j : 0)];
            tab[i * 256 + F.tid] = (j < cnt) ? v : (v | (int)0x80000000); }
    }
    __syncthreads();
}

__device__ __forceinline__ void combine_phase(Frame& F, float* dst) {
    const size_t NIT = (size_t)NTOK * (DM / 8);
    for (size_t it = (size_t)F.bx * 512 + F.tid; it < NIT; it += (size_t)F.G * 512) {
        const size_t t = it >> 8; const int c = (int)(it & 255) * 8;
        float* op = F.out + t * DM + c; float* wp = dst + t * DM + c;
        const f32x4 h0 = *(const GAS f32x4*)op, h1 = *(const GAS f32x4*)(op + 4);
        const u32x4 y0 = *(const GAS u32x4*)(F.Y + (2 * t) * DM + c), y1 = *(const GAS u32x4*)(F.Y + (2 * t + 1) * DM + c);
        f32x4 o0, o1;
        o0.x = h0.x + bflo(y0.x) + bflo(y1.x); o0.y = h0.y + bfhi(y0.x) + bfhi(y1.x); o0.z = h0.z + bflo(y0.y) + bflo(y1.y); o0.w = h0.w + bfhi(y0.y) + bfhi(y1.y);
        o1.x = h1.x + bflo(y0.z) + bflo(y1.z); o1.y = h1.y + bfhi(y0.z) + bfhi(y1.z); o1.z = h1.z + bflo(y0.w) + bflo(y1.w); o1.w = h1.w + bfhi(y0.w) + bfhi(y1.w);
        *(GAS f32x4*)wp = o0; *(GAS f32x4*)(wp + 4) = o1;
    }
}

struct Args { const float* in[17]; float* out; unsigned char* ws; int ph_lo, ph_hi, use_bar, pad; };
__global__ void __launch_bounds__(512, 2) hymba_fwd(Args args) {
    extern __shared__ __attribute__((aligned(16))) unsigned char lds[];
    Frame F;
    F.lds = (LAS unsigned char*)lds;
    F.tid = threadIdx.x; F.lane = F.tid & 63; F.wave = __builtin_amdgcn_readfirstlane(F.tid >> 6);
    F.G = gridDim.x; F.bx = blockIdx.x;
    unsigned char* ws = args.ws;
    F.ctl = (gu32*)(ws + WS_CTL);
    F.x = args.in[0]; F.norm_mix = args.in[1]; F.w_in = args.in[2]; F.q_norm = args.in[3]; F.k_norm = args.in[4]; F.sinks = args.in[5]; F.w_pool = args.in[6]; F.pool_scale = args.in[7];
    F.w_out = args.in[8]; F.norm_ffn = args.in[9]; F.w_coarse = args.in[10]; F.b_coarse = args.in[11]; F.w_fine = args.in[12]; F.b_fine = args.in[13]; F.w_gate = args.in[14]; F.w_up = args.in[15]; F.w_down = args.in[16];
    F.out = args.out;
    F.rope = (float*)(ws + WS_ROPE); F.rinv = (float*)(ws + WS_RINV); F.rtok = (float*)(ws + WS_RTOK); F.gate = (float*)(ws + WS_GATE);
    F.Wr = (bf16_t*)(ws + WS_WR); F.Wpool = (bf16_t*)(ws + WS_WPOOL); F.Win = (bf16_t*)(ws + WS_WIN); F.Wout = (bf16_t*)(ws + WS_WOUT); F.Wgu = (bf16_t*)(ws + WS_WGU); F.Wd = (bf16_t*)(ws + WS_WD);
    F.XB = (bf16_t*)(ws + WS_XB); F.PROJ = (bf16_t*)(ws + WS_PROJ); F.MIXED = (bf16_t*)(ws + WS_MIXED); F.DPOOL = (bf16_t*)(ws + WS_DPOOL); F.ACT = (bf16_t*)(ws + WS_ACT); F.Y = (bf16_t*)(ws + WS_Y);
    F.rowl = (int*)(ws + WS_ROWL);
    if (F.tid < 4) ((LAS unsigned*)(F.lds + MISC_OFF))[F.tid] = 0u;
    __syncthreads();
    XcdBarrier bar; bar.bar = (unsigned*)(F.ctl + CW_BAR); bar.x = 0; bar.st = nullptr;
    if (args.use_bar) bar = xcd_barrier_post((unsigned*)(F.ctl + CW_BAR), (volatile LAS unsigned*)(F.lds + MISC_OFF));
    const int lo = args.ph_lo, hi = args.ph_hi;
#define IN(k) (lo <= (k) && (k) < hi)
#define SEAM(k) do { if (IN(k) && IN((k) + 1)) xcd_barrier(bar); } while (0)

#define REPS(k) ((PROBE_DUP == (k)) ? 2 : 1)
    if (IN(0)) { for (int rep = 0; rep < REPS(0); ++rep) { if (rep) xcd_barrier(bar); p0_prologue(F); } SEAM(0); }
    if (IN(1)) {
        for (int rep = 0; rep < REPS(1); ++rep) { if (rep) xcd_barrier(bar);
        pg8::DenseProb P; P.A = F.XB; P.Bt = F.Win; P.lda = DM; P.K = DM; P.acol = 0; P.so.init(NTOK, INW, F.G, F.bx);
        pg8::EpiRowScaleBf16 E{F.PROJ, INW, F.rinv};
        pg8::gemm_phase(F.lds, P, E); }
        SEAM(1);
    }
    if (IN(2)) {
        for (int rep = 0; rep < REPS(2); ++rep) { if (rep) xcd_barrier(bar);
        for (int u = F.bx; u < BATCH * (SEQ / 128) * NKV; u += F.G) { const int kvh = u & 3, n = (u >> 2) & 31, b = u >> 7; attn_unit(F, b, n, kvh); }
        pool_diff(F); }
        SEAM(2);
    }
    if (IN(3)) {
        for (int rep = 0; rep < REPS(3); ++rep) { if (rep) xcd_barrier(bar);
        pg8::DenseProb P; P.A = F.DPOOL; P.Bt = F.Wpool; P.lda = PW; P.K = 256; P.acol = 256; P.so.init(NTOK, PW, F.G, F.bx);
        pg8::EpiBf16 E{F.MIXED, DM, 1024};
        pg8::gemm_phase(F.lds, P, E); }
        SEAM(3);
    }
    if (IN(4)) {
        for (int rep = 0; rep < REPS(4); ++rep) { if (rep) xcd_barrier(bar);
        pg8::DenseProb P; P.A = F.MIXED; P.Bt = F.Wout; P.lda = DM; P.K = DM; P.acol = 0; P.so.init(NTOK, DM, F.G, F.bx);
        pg8::EpiResF32 E{F.x, F.out, DM};
        pg8::gemm_phase(F.lds, P, E); }
        SEAM(4);
    }
    if (IN(5)) { for (int rep = 0; rep < REPS(5); ++rep) { if (rep) xcd_barrier(bar); route_phase(F, rep + 1 < REPS(5)); } SEAM(5); }
    if (IN(6)) {
        for (int rep = 0; rep < REPS(6); ++rep) { if (rep) xcd_barrier(bar);
        moe_setup(F, 4);
        pg8::MoeProb P; P.A = F.XB; P.Bt = F.Wgu; P.lda = DM; P.K = DM; P.nN = 4; P.shift = 1; P.tab = (LAS const int*)(F.lds + TAB_OFF); P.expt = (LAS const int*)(F.lds + EXPT_OFF); P.G = F.G; P.c = F.bx;
        pg8::EpiSwiGLU E{F.ACT, F.rtok, F.gate, (LAS const int*)(F.lds + TAB_OFF)};
        pg8::gemm_phase(F.lds, P, E); }
        SEAM(6);
    }
    if (IN(7)) {
        for (int rep = 0; rep < REPS(7); ++rep) { if (rep) xcd_barrier(bar);
        moe_setup(F, 8);
        pg8::MoeProb P; P.A = F.ACT; P.Bt = F.Wd; P.lda = DEXP; P.K = DEXP; P.nN = 8; P.shift = 0; P.tab = (LAS const int*)(F.lds + TAB_OFF); P.expt = (LAS const int*)(F.lds + EXPT_OFF); P.G = F.G; P.c = F.bx;
        pg8::EpiScatterBf16 E{F.Y, DM, (LAS const int*)(F.lds + TAB_OFF)};
        pg8::gemm_phase(F.lds, P, E); }
        SEAM(7);
    }
    if (IN(8)) { for (int rep = 0; rep < REPS(8); ++rep) { if (rep) xcd_barrier(bar); combine_phase(F, (rep + 1 < REPS(8)) ? (float*)(ws + WS_WGU) : F.out); } }
#undef REPS
#undef IN
#undef SEAM
}

extern "C" void kernel_launch(void* const* d_in, const int* in_sizes, int n_in, void* d_out, int out_size, void* d_ws, size_t ws_size, hipStream_t stream) {
    static int grid = 0;
    if (grid == 0) {
        if (n_in != 17 || out_size != NTOK * DM || ws_size < WS_END) { fprintf(stderr, "kernel_launch: unexpected problem (n_in %d, out %d, ws %zu)\n", n_in, out_size, ws_size); grid = -1; return; }
        int dev = 0, cus = 0;
        if (hipGetDevice(&dev) != hipSuccess || hipDeviceGetAttribute(&cus, hipDeviceAttributeMultiprocessorCount, dev) != hipSuccess) { grid = -1; return; }
        if (hipFuncSetAttribute((const void*)hymba_fwd, hipFuncAttributeMaxDynamicSharedMemorySize, LDS_BYTES) != hipSuccess) { fprintf(stderr, "kernel_launch: hipFuncSetAttribute failed\n"); grid = -1; return; }
        int per_cu = 0;
        if (hipOccupancyMaxActiveBlocksPerMultiprocessor(&per_cu, (const void*)hymba_fwd, 512, LDS_BYTES) != hipSuccess || per_cu < 1) { fprintf(stderr, "kernel_launch: occupancy query says %d\n", per_cu); }
        (void)hipGetLastError();
        grid = cus - (cus % 8);
        if (grid <= 0) grid = -1;
    }
    if (grid < 0) return;
    if (hipMemsetAsync((char*)d_ws + WS_CTL, 0, CTL_ZERO_BYTES, stream) != hipSuccess) return;
    Args a{};
    for (int i = 0; i < 17; ++i) a.in[i] = (const float*)d_in[i];
    a.out = (float*)d_out; a.ws = (unsigned char*)d_ws;
    if (MK_N_LAUNCHES == 1) { a.ph_lo = 0; a.ph_hi = NPHASE; a.use_bar = 1; hipLaunchKernelGGL(hymba_fwd, dim3(grid), dim3(512), LDS_BYTES, stream, a); }
    else for (int p = 0; p < NPHASE; ++p) { a.ph_lo = p; a.ph_hi = p + 1; a.use_bar = 0; hipLaunchKernelGGL(hymba_fwd, dim3(grid), dim3(512), LDS_BYTES, stream, a); }
}
```

```cpp
#include <hip/hip_runtime.h>
#include <cstdio>
#include <cstdint>

#ifndef MK_N_LAUNCHES
#define MK_N_LAUNCHES 1
#endif
#ifndef PROBE_K2
#define PROBE_K2 0
#endif
#ifndef PROBE_DUP
#define PROBE_DUP -1
#endif

#define GAS __attribute__((address_space(1)))
#define LAS __attribute__((address_space(3)))
typedef unsigned short bf16_t;
typedef short bf16x8 __attribute__((ext_vector_type(8)));
typedef short s16x4 __attribute__((ext_vector_type(4)));
typedef float f32x4 __attribute__((ext_vector_type(4)));
typedef float f32x2 __attribute__((ext_vector_type(2)));
typedef float f32x16 __attribute__((ext_vector_type(16)));
typedef unsigned u32x4 __attribute__((ext_vector_type(4)));
typedef unsigned u32x2 __attribute__((ext_vector_type(2)));
typedef GAS unsigned gu32;

constexpr int BATCH = 8, SEQ = 4096, NTOK = BATCH * SEQ, DM = 2048;
constexpr int NH = 16, NKV = 4, HD = 64, INW = 2560, QOFF = 0, KOFF = 1024, VOFF = 1280, UOFF = 1536, PW = 1024;
constexpr int NEXP = 32, DEXP = 512, NASG = NTOK * 2, RCAP = NASG;
constexpr float EPS = 1e-6f;
constexpr int NPHASE = 9;

constexpr size_t MiB = 1u << 20;
constexpr size_t WS_CTL = 0, CTL_ZERO_BYTES = 64 * 1024;
constexpr size_t WS_ROPE = 1 * MiB;
constexpr size_t WS_RINV = WS_ROPE + 256 * 1024;
constexpr size_t WS_RTOK = WS_RINV + 128 * 1024;
constexpr size_t WS_GATE = WS_RTOK + 128 * 1024;
constexpr size_t WS_WR = 2 * MiB;
constexpr size_t WS_WPOOL = WS_WR + 512 * 1024;
constexpr size_t WS_WIN = 3 * MiB;
constexpr size_t WS_WOUT = 13 * MiB;
constexpr size_t WS_ROWL = 21 * MiB;
constexpr size_t WS_WGU = 29 * MiB;
constexpr size_t WS_WD = 157 * MiB;
constexpr size_t WS_XB = 221 * MiB;
constexpr size_t WS_PROJ = 349 * MiB;
constexpr size_t WS_MIXED = 509 * MiB;
constexpr size_t WS_DPOOL = 637 * MiB;
constexpr size_t WS_ACT = WS_DPOOL;
constexpr size_t WS_Y = WS_PROJ;
constexpr size_t WS_END = 701 * MiB;
static_assert(WS_Y + (size_t)NASG * DM * 2 <= WS_DPOOL, "Y overlay");
constexpr int CW_TMO = 0, CW_BAR = 1024, CW_CNT = 8192;

constexpr int RING_BYTES = 131072;
constexpr int TAB_OFF = RING_BYTES;
constexpr int TAB_UNITS = 14, TABRG_UNITS = 6;
constexpr int TABR_OFF = TAB_OFF + TAB_UNITS * 1024;
constexpr int TABG_OFF = TABR_OFF + TABRG_UNITS * 1024;
constexpr int EXPT_OFF = TABG_OFF + TABRG_UNITS * 1024;
constexpr int MISC_OFF = EXPT_OFF + 512;
constexpr int LDS_BYTES = 159744;
static_assert(MISC_OFF + 16 <= LDS_BYTES, "LDS map");

#define RLX_AGENT __ATOMIC_RELAXED, __HIP_MEMORY_SCOPE_AGENT
#define LDS_WAIT() asm volatile("s_waitcnt lgkmcnt(0)" ::: "memory")
#define VM_WAIT() asm volatile("s_waitcnt vmcnt(0)" ::: "memory")

__device__ __forceinline__ unsigned f2bf(float f) { unsigned u = __builtin_bit_cast(unsigned, f); return (u + 0x7fffu + ((u >> 16) & 1u)) >> 16; }

__device__ __forceinline__ float bflo(unsigned w) { return __builtin_bit_cast(float, w << 16); }
__device__ __forceinline__ float bfhi(unsigned w) { return __builtin_bit_cast(float, w & 0xffff0000u); }
typedef __bf16 bf16x2_t __attribute__((ext_vector_type(2)));
__device__ __forceinline__ unsigned cvt_pk_bf16(float lo, float hi) { f32x2 v = {lo, hi}; bf16x2_t b = __builtin_convertvector(v, bf16x2_t); return __builtin_bit_cast(unsigned, b); }
__device__ __forceinline__ unsigned pk2(float lo, float hi) { return cvt_pk_bf16(lo, hi); }
__device__ __forceinline__ float wave_sum(float v) {
#pragma unroll
    for (int o = 1; o < 64; o <<= 1) v += __shfl_xor(v, o);
    return v;
}

#define XB_TMO      128
#define XB_XCNT(j)  (256  + 64 * (j))
#define XB_XSUB(j)  (1280 + 64 * (j))
#define XB_XGEN(j)  (2304 + 64 * (j))
#define XB_TOP      3328
#define XB_TOPGEN   3392
#define XCD_BAR_WORDS 3456
#define XB_SPIN_CAP (1u << 18)
__device__ __forceinline__ unsigned xb_ld(unsigned* p)              { return __hip_atomic_load(p, __ATOMIC_RELAXED, __HIP_MEMORY_SCOPE_AGENT); }
__device__ __forceinline__ unsigned xb_add(unsigned* p, unsigned v) { return __hip_atomic_fetch_add(p, v, __ATOMIC_RELAXED, __HIP_MEMORY_SCOPE_AGENT); }
__device__ __forceinline__ unsigned xb_xcc_id() { return (unsigned)__builtin_amdgcn_s_getreg((3 << 11) | 20) & 0xFu; }
#define XB_SPIN(cond, bar) do { unsigned _sp = 0; while (cond) { __builtin_amdgcn_s_sleep(1); \
    if ((++_sp & 255u) == 0u) { if (xb_ld(&(bar)[XB_TMO])) break; if (_sp > XB_SPIN_CAP) { atomicAdd(&(bar)[XB_TMO], 1u); break; } } } } while (0)
struct XcdBarrier { unsigned* bar; unsigned x; volatile LAS unsigned* st; };
__device__ __forceinline__ XcdBarrier xcd_barrier_post(unsigned* bar, volatile LAS unsigned* st) {
    XcdBarrier b; b.bar = bar; b.x = xb_xcc_id(); b.st = st;
    if (threadIdx.x == 0) (void)xb_add(&bar[XB_XCNT(b.x)], 1u);
    return b;
}
__device__ __forceinline__ void xcd_barrier_complete(unsigned* bar, unsigned x, unsigned& nloc, unsigned& nx) {
    const unsigned G = gridDim.x * gridDim.y * gridDim.z;
    unsigned sum, cnt, mine, sp = 0u;
    for (;;) {
        sum = 0u; cnt = 0u; mine = 0u;
#pragma unroll
        for (unsigned j = 0; j < 16; ++j) { const unsigned c = xb_ld(&bar[XB_XCNT(j)]); sum += c; cnt += (c > 0u) ? 1u : 0u; mine = (j == x) ? c : mine; }
        if (sum == G) break;
        __builtin_amdgcn_s_sleep(1);
        if ((++sp & 255u) == 0u) { if (xb_ld(&bar[XB_TMO])) break; if (sp > XB_SPIN_CAP) { atomicAdd(&bar[XB_TMO], 1u); break; } }
    }
    nloc = mine > 0u ? mine : 1u; nx = cnt > 0u ? cnt : 1u;
}
__device__ __forceinline__ void xcd_barrier(const XcdBarrier& b) {
    asm volatile("s_waitcnt vmcnt(0)" ::: "memory");
    __syncthreads();
    if (threadIdx.x == 0) {
        unsigned* bar = b.bar;
        __builtin_amdgcn_s_waitcnt(0);
        unsigned nloc = b.st[0], nx = b.st[1];
        if (nloc == 0u) { xcd_barrier_complete(bar, b.x, nloc, nx); b.st[0] = nloc; b.st[1] = nx; }
        const unsigned old = xb_add(&bar[XB_XSUB(b.x)], 1u);
        const unsigned gen = old / nloc;
        if (old + 1u == (gen + 1u) * nloc) {
            __builtin_amdgcn_fence(__ATOMIC_RELEASE, "agent");
            asm volatile("s_waitcnt vmcnt(0)" ::: "memory");
            const unsigned og = xb_add(&bar[XB_TOP], 1u);
            const unsigned tg = og / nx;
            if (og + 1u == (tg + 1u) * nx) xb_add(&bar[XB_TOPGEN], 1u);
            else XB_SPIN(xb_ld(&bar[XB_TOPGEN]) == tg, bar);
            __builtin_amdgcn_fence(__ATOMIC_ACQUIRE, "agent");
            xb_add(&bar[XB_XGEN(b.x)], 1u);
            asm volatile("s_waitcnt vmcnt(0)" ::: "memory");
        } else {
            XB_SPIN(xb_ld(&bar[XB_XGEN(b.x)]) == gen, bar);
            __builtin_amdgcn_fence(__ATOMIC_ACQUIRE, "agent");
            asm volatile("s_waitcnt vmcnt(0)" ::: "memory");
        }
    }
    __syncthreads();
}

namespace pg8 {
constexpr int BM = 256, BK = 64, HALF = 128, HTB = HALF * BK * 2, STAGE_BYTES = 8 * HTB, NXCD = 8, WGM = 8;
static_assert(STAGE_BYTES == RING_BYTES, "stage region");
__host__ __device__ __forceinline__ int lds_byte(int r, int c) { const int st = (r >> 4) * 2 + (c >> 5), rr = r & 15, cc = c & 31, ob = rr * 64 + cc * 2; return st * 1024 + (ob ^ (((ob >> 9) & 1) << 5)); }
__host__ __device__ __forceinline__ void stage_rc(int b, int& R, int& C) { const int st = b / 1024, sb = b % 1024, swz = sb ^ (((sb >> 9) & 1) << 5); R = (st >> 1) * 16 + swz / 64; C = (st & 1) * 32 + (swz % 64) / 2; }
__host__ __device__ __forceinline__ int perm32(int rho) { const int n = rho >> 4, i = rho & 15; return 8 * (i >> 2) + 4 * n + (i & 3); }

struct Unit { int pm, pn, ord, e, cnt; };

struct StaticOrder {
    int nM, nN, nwg, G, c;
    __device__ void init(int M, int N, int G_, int c_) { nM = M / BM; nN = N / BM; nwg = nM * nN; G = G_; c = c_; }
    __device__ bool next(int i, int& pm, int& pn) const {
        const long L = (long)i * G + c; if (L >= nwg) return false;
        int wgid = (int)L; { const int q = nwg / NXCD, r = nwg % NXCD, xcd = wgid % NXCD, off = wgid / NXCD; wgid = (xcd < r ? xcd * (q + 1) : r * (q + 1) + (xcd - r) * q) + off; }
        const int nig = WGM * nN, gid = wgid / nig, fm = gid * WGM, gsz = (nM - fm) < WGM ? (nM - fm) : WGM;
        pm = fm + ((wgid % nig) % gsz); pn = (wgid % nig) / gsz; return true;
    }
};

template <class Epi, class Prob, int KREP = 1>
__device__ __forceinline__ void gemm_phase(LAS unsigned char* lds, const Prob& S, const Epi& E) {
    const int tid = threadIdx.x, wid = __builtin_amdgcn_readfirstlane(tid >> 6), lane = tid & 63, wr = wid >> 2, wc = wid & 3, fr = lane & 15, fq = lane >> 4;
    const int K = S.K, ntr = K / BK, nt = ntr * KREP, kmask = ntr - 1;
    int Rr[2], Cc[2]; unsigned voffB[2];
#pragma unroll
    for (int i = 0; i < 2; ++i) { stage_rc(tid * 16 + i * 8192, Rr[i], Cc[i]); const int Rb = Epi::PERM ? ((Rr[i] & ~31) + perm32(Rr[i] & 31)) : Rr[i]; voffB[i] = (unsigned)(Rb * K + Cc[i]) * 2u; }
    const size_t kstep = (size_t)(BK * 2);
    const size_t hstep = (size_t)HALF * K * 2;
    const unsigned ldsw = (unsigned)wid * 1024u;
    const int aoff = lds_byte(wr * 64 + fr, fq * 8), boff = lds_byte(wc * 32 + fr, fq * 8);
#define PG8_SA(b, h) (((b) * 2 + (h)) * HTB)
#define PG8_SB(b, h) ((4 + (b) * 2 + (h)) * HTB)
#define PG8_STAGE(bufoff, gbase, voff) do { _Pragma("unroll") for (int _i = 0; _i < 2; ++_i) \
        __builtin_amdgcn_global_load_lds((const unsigned*)((const char*)(gbase) + (voff)[_i]), (LAS unsigned*)(lds + (bufoff) + ldsw + _i * 8192), 16, 0, 0); } while (0)
#define PG8_LDA(dst, b, h) do { _Pragma("unroll") for (int m = 0; m < 4; ++m) _Pragma("unroll") for (int k = 0; k < 2; ++k) dst[m][k] = *(const LAS bf16x8*)(lds + PG8_SA(b, h) + aoff + m * 2048 + k * 1024); } while (0)
#define PG8_LDB(dst, b, h) do { _Pragma("unroll") for (int n = 0; n < 2; ++n) _Pragma("unroll") for (int k = 0; k < 2; ++k) dst[n][k] = *(const LAS bf16x8*)(lds + PG8_SB(b, h) + boff + n * 2048 + k * 1024); } while (0)
#define PG8_MMA(ai, bj, At, Bt) do { __builtin_amdgcn_s_setprio(1); _Pragma("unroll") for (int m = 0; m < 4; ++m) _Pragma("unroll") for (int n = 0; n < 2; ++n) _Pragma("unroll") for (int k = 0; k < 2; ++k) \
        acc[ai][bj][m][n] = __builtin_amdgcn_mfma_f32_16x16x32_bf16(Bt[n][k], At[m][k], acc[ai][bj][m][n], 0, 0, 0); __builtin_amdgcn_s_setprio(0); } while (0)
#define PG8_WAIT_V(n) asm volatile("s_waitcnt vmcnt(" #n ")" ::: "memory")
#define PG8_WAIT_L(n) asm volatile("s_waitcnt lgkmcnt(" #n ")" ::: "memory")
#define PG8_BAR __builtin_amdgcn_s_barrier()
#define PG8_SCHED __builtin_amdgcn_sched_barrier(0)
    Unit cur, nxt; int ui = 0;
    if (!S.next(0, cur)) return;
    f32x4 acc[2][2][4][2];
    E.init(acc, cur, wr, wc, fr, fq);
    bf16x8 At[4][2], B0[2][2], B1[2][2];
    unsigned vc[2][2], vn[2][2];
    S.a_voff(cur, Rr, Cc, vc);
    const char* cA = S.a_base(cur); const char* cB = S.b_base(cur);
    PG8_STAGE(PG8_SB(0, 0), cB, voffB); PG8_STAGE(PG8_SB(0, 1), cB + hstep, voffB); PG8_STAGE(PG8_SA(0, 0), cA, vc[0]); PG8_STAGE(PG8_SA(0, 1), cA, vc[1]);
    if (wr == 1) PG8_BAR;
    PG8_WAIT_V(2); PG8_BAR;
    PG8_STAGE(PG8_SB(1, 0), cB + kstep, voffB); PG8_STAGE(PG8_SA(1, 0), cA + kstep, vc[0]); PG8_STAGE(PG8_SB(1, 1), cB + hstep + kstep, voffB);
    PG8_WAIT_V(6); PG8_BAR;
    for (;;) {
        const bool has_next = S.next(ui + 1, nxt);
        const char* nA = has_next ? S.a_base(nxt) : cA; const char* nB = has_next ? S.b_base(nxt) : cB;
        if (has_next) S.a_voff(nxt, Rr, Cc, vn); else { vn[0][0] = vc[0][0]; vn[0][1] = vc[0][1]; vn[1][0] = vc[1][0]; vn[1][1] = vc[1][1]; }
        for (int t = 0; t < nt; t += 2) {
            const bool last = (t == nt - 2);
            const int t1 = (KREP == 1) ? t + 1 : ((t + 1) & kmask), t2 = (KREP == 1) ? t + 2 : ((t + 2) & kmask);
            const char* a1 = cA + (size_t)t1 * kstep;
            const char* a2 = last ? nA : cA + (size_t)t2 * kstep; const char* b2 = last ? nB : cB + (size_t)t2 * kstep;
            const char* a3 = a2 + kstep; const char* b3 = b2 + kstep;
            unsigned w0[2], w1[2]; w0[0] = last ? vn[0][0] : vc[0][0]; w0[1] = last ? vn[0][1] : vc[0][1]; w1[0] = last ? vn[1][0] : vc[1][0]; w1[1] = last ? vn[1][1] : vc[1][1];
            PG8_LDB(B0, 0, 0); PG8_LDB(B1, 0, 1); PG8_SCHED; PG8_LDA(At, 0, 0); PG8_STAGE(PG8_SA(1, 1), a1, vc[1]);
            PG8_WAIT_V(8); PG8_WAIT_L(0); PG8_BAR; PG8_MMA(0, 0, At, B0); PG8_MMA(0, 1, At, B1); PG8_BAR; PG8_SCHED;
            PG8_LDA(At, 0, 1); PG8_STAGE(PG8_SB(0, 0), b2, voffB); PG8_STAGE(PG8_SB(0, 1), b2 + hstep, voffB); PG8_STAGE(PG8_SA(0, 0), a2, w0);
            PG8_WAIT_V(8); PG8_WAIT_L(0); PG8_BAR; PG8_MMA(1, 0, At, B0); PG8_MMA(1, 1, At, B1); PG8_BAR; PG8_SCHED;
            PG8_LDB(B0, 1, 0); PG8_LDB(B1, 1, 1); PG8_SCHED; PG8_LDA(At, 1, 0); PG8_STAGE(PG8_SA(0, 1), a2, w1);
            PG8_WAIT_V(8); PG8_WAIT_L(0); PG8_BAR; PG8_MMA(0, 0, At, B0); PG8_MMA(0, 1, At, B1); PG8_BAR; PG8_SCHED;
            PG8_LDA(At, 1, 1); PG8_STAGE(PG8_SB(1, 0), b3, voffB); PG8_STAGE(PG8_SB(1, 1), b3 + hstep, voffB); PG8_STAGE(PG8_SA(1, 0), a3, w0);
            PG8_WAIT_V(8); PG8_WAIT_L(0); PG8_BAR; PG8_MMA(1, 0, At, B0); PG8_MMA(1, 1, At, B1); PG8_BAR; PG8_SCHED;
        }
        if (wr == 0) PG8_BAR;
        E(acc, cur, wr, wc, fr, fq);
        if (!has_next) break;
        E.init(acc, nxt, wr, wc, fr, fq);
        cur = nxt; cA = nA; cB = nB; ++ui;
        vc[0][0] = vn[0][0]; vc[0][1] = vn[0][1]; vc[1][0] = vn[1][0]; vc[1][1] = vn[1][1];
        if (wr == 1) PG8_BAR;
    }
    PG8_WAIT_V(0);
    PG8_BAR;
#undef PG8_SA
#undef PG8_SB
#undef PG8_STAGE
#undef PG8_LDA
#undef PG8_LDB
#undef PG8_MMA
#undef PG8_WAIT_V
#undef PG8_WAIT_L
#undef PG8_BAR
#undef PG8_SCHED
}

struct DenseProb {
    const bf16_t* A; const bf16_t* Bt; int lda, K, acol;
    StaticOrder so;
    __device__ __forceinline__ bool next(int i, Unit& u) const { u.ord = i; u.e = 0; u.cnt = 256; return so.next(i, u.pm, u.pn); }
    __device__ __forceinline__ const char* a_base(const Unit& u) const { return (const char*)(A + (size_t)u.pm * BM * lda + (size_t)u.pn * acol); }
    __device__ __forceinline__ const char* b_base(const Unit& u) const { return (const char*)(Bt + (size_t)u.pn * BM * K); }
    __device__ __forceinline__ void a_voff(const Unit&, const int (&R)[2], const int (&C)[2], unsigned (&vo)[2][2]) const {
#pragma unroll
        for (int h = 0; h < 2; ++h)
#pragma unroll
            for (int i = 0; i < 2; ++i) vo[h][i] = (unsigned)((h * HALF + R[i]) * lda + C[i]) * 2u;
    }
};

struct MoeProb {
    const bf16_t* A; const bf16_t* Bt; int lda, K, nN, shift;
    LAS const int* tab;
    LAS const int* expt;
    int G, c;
    __device__ __forceinline__ bool next(int i, Unit& u) const {
        const int per = G >> 3, xcd = c & 7, rank = c >> 3;
        const int L = (i * 8 + xcd) * per + rank;
        if (L >= expt[32] || i >= TAB_UNITS) return false;
        int e = 0;
#pragma unroll 1
        while (e < 31 && L >= expt[e + 1]) ++e;
        const int q = L - expt[e], cnt = expt[33 + e], T = (cnt + 255) >> 8;
        u.e = e; u.pn = q / T; u.pm = q % T; u.ord = i; u.cnt = cnt - u.pm * 256; return true;
    }
    __device__ __forceinline__ const char* a_base(const Unit&) const { return (const char*)A; }
    __device__ __forceinline__ const char* b_base(const Unit& u) const { return (const char*)(Bt + ((size_t)u.e * nN + u.pn) * BM * K); }
    __device__ __forceinline__ void a_voff(const Unit& u, const int (&R)[2], const int (&C)[2], unsigned (&vo)[2][2]) const {
#pragma unroll
        for (int h = 0; h < 2; ++h)
#pragma unroll
            for (int i = 0; i < 2; ++i) { const unsigned row = ((unsigned)tab[u.ord * 256 + h * HALF + R[i]] & 0x7fffffffu) >> shift; vo[h][i] = (row * (unsigned)lda + (unsigned)C[i]) * 2u; }
    }
};

struct EpiBf16 {
    static constexpr bool PERM = true;
    bf16_t* O; int ldc, cbase;
    __device__ __forceinline__ void init(f32x4 (&acc)[2][2][4][2], const Unit&, int, int, int, int) const {
#pragma unroll
        for (int a = 0; a < 2; ++a)
#pragma unroll
            for (int b = 0; b < 2; ++b)
#pragma unroll
                for (int m = 0; m < 4; ++m)
#pragma unroll
                    for (int n = 0; n < 2; ++n) acc[a][b][m][n] = (f32x4){0.f, 0.f, 0.f, 0.f};
    }
    __device__ __forceinline__ void operator()(const f32x4 (&acc)[2][2][4][2], const Unit& u, int wr, int wc, int fr, int fq) const {
        const int row0 = u.pm * BM + wr * 64 + fr, col0 = cbase + u.pn * BM + wc * 32 + 8 * fq;
#pragma unroll
        for (int ai = 0; ai < 2; ++ai)
#pragma unroll
            for (int m = 0; m < 4; ++m) { bf16_t* rowp = O + (size_t)(row0 + ai * HALF + m * 16) * ldc + col0;
#pragma unroll
                for (int bj = 0; bj < 2; ++bj) { const f32x4 v0 = acc[ai][bj][m][0], v1 = acc[ai][bj][m][1];
                    u32x4 w; w.x = cvt_pk_bf16(v0[0], v0[1]); w.y = cvt_pk_bf16(v0[2], v0[3]); w.z = cvt_pk_bf16(v1[0], v1[1]); w.w = cvt_pk_bf16(v1[2], v1[3]);
                    *(u32x4*)(rowp + bj * HALF) = w; } }
    }
};
struct EpiResBf16 {
    static constexpr bool PERM = true;
    const float* base; bf16_t* O; int ldc;
    __device__ __forceinline__ void init(f32x4 (&acc)[2][2][4][2], const Unit& u, int wr, int wc, int fr, int fq) const {
        const int row0 = u.pm * BM + wr * 64 + fr, col0 = u.pn * BM + wc * 32 + 8 * fq;
#pragma unroll
        for (int ai = 0; ai < 2; ++ai)
#pragma unroll
            for (int m = 0; m < 4; ++m) { const size_t off = (size_t)(row0 + ai * HALF + m * 16) * ldc + col0;
#pragma unroll
                for (int bj = 0; bj < 2; ++bj)
#pragma unroll
                    for (int n = 0; n < 2; ++n) acc[ai][bj][m][n] = *(const GAS f32x4*)(base + off + bj * HALF + n * 4); }
    }
    __device__ __forceinline__ void operator()(const f32x4 (&acc)[2][2][4][2], const Unit& u, int wr, int wc, int fr, int fq) const {
        const int row0 = u.pm * BM + wr * 64 + fr, col0 = u.pn * BM + wc * 32 + 8 * fq;
#pragma unroll
        for (int ai = 0; ai < 2; ++ai)
#pragma unroll
            for (int m = 0; m < 4; ++m) { bf16_t* rowp = O + (size_t)(row0 + ai * HALF + m * 16) * ldc + col0;
#pragma unroll
                for (int bj = 0; bj < 2; ++bj) { const f32x4 v0 = acc[ai][bj][m][0], v1 = acc[ai][bj][m][1];
                    u32x4 w; w.x = cvt_pk_bf16(v0[0], v0[1]); w.y = cvt_pk_bf16(v0[2], v0[3]); w.z = cvt_pk_bf16(v1[0], v1[1]); w.w = cvt_pk_bf16(v1[2], v1[3]);
                    *(u32x4*)(rowp + bj * HALF) = w; } }
    }
};
struct EpiSwiGLU {
    static constexpr bool PERM = true;
    bf16_t* act; LAS const int* tab; LAS const float* tabr; LAS const float* tabg;
    __device__ __forceinline__ void init(f32x4 (&acc)[2][2][4][2], const Unit&, int, int, int, int) const {
#pragma unroll
        for (int a = 0; a < 2; ++a)
#pragma unroll
            for (int b = 0; b < 2; ++b)
#pragma unroll
                for (int m = 0; m < 4; ++m)
#pragma unroll
                    for (int n = 0; n < 2; ++n) acc[a][b][m][n] = (f32x4){0.f, 0.f, 0.f, 0.f};
    }
    __device__ __forceinline__ void operator()(const f32x4 (&acc)[2][2][4][2], const Unit& u, int wr, int wc, int fr, int fq) const {
        const int col0 = u.pn * HALF + wc * 32 + 8 * fq;
#pragma unroll
        for (int ai = 0; ai < 2; ++ai)
#pragma unroll
            for (int m = 0; m < 4; ++m) { const int rl = ai * HALF + wr * 64 + m * 16 + fr; const int a = tab[u.ord * 256 + rl];
                const float r = tabr[u.ord * 256 + rl], rg = tabg[u.ord * 256 + rl];
                if (a >= 0) { float o[8];
#pragma unroll
                    for (int n = 0; n < 2; ++n)
#pragma unroll
                        for (int j = 0; j < 4; ++j) { const float g = acc[ai][0][m][n][j] * r; o[n * 4 + j] = g / (1.0f + __expf(-g)) * (acc[ai][1][m][n][j] * rg); }
                    u32x4 w; w.x = cvt_pk_bf16(o[0], o[1]); w.y = cvt_pk_bf16(o[2], o[3]); w.z = cvt_pk_bf16(o[4], o[5]); w.w = cvt_pk_bf16(o[6], o[7]);
                    *(u32x4*)(act + (size_t)a * DEXP + col0) = w; } }
    }
};
struct EpiScatterBf16 {
    static constexpr bool PERM = true;
    bf16_t* Y; int ldc; LAS const int* tab;
    __device__ __forceinline__ void init(f32x4 (&acc)[2][2][4][2], const Unit&, int, int, int, int) const {
#pragma unroll
        for (int a = 0; a < 2; ++a)
#pragma unroll
            for (int b = 0; b < 2; ++b)
#pragma unroll
                for (int m = 0; m < 4; ++m)
#pragma unroll
                    for (int n = 0; n < 2; ++n) acc[a][b][m][n] = (f32x4){0.f, 0.f, 0.f, 0.f};
    }
    __device__ __forceinline__ void operator()(const f32x4 (&acc)[2][2][4][2], const Unit& u, int wr, int wc, int fr, int fq) const {
        const int col0 = u.pn * BM + wc * 32 + 8 * fq;
#pragma unroll
        for (int ai = 0; ai < 2; ++ai)
#pragma unroll
            for (int m = 0; m < 4; ++m) { const int rl = ai * HALF + wr * 64 + m * 16 + fr; const int a = tab[u.ord * 256 + rl];
                if (a >= 0) { bf16_t* rowp = Y + (size_t)a * ldc + col0;
#pragma unroll
                    for (int bj = 0; bj < 2; ++bj) { const f32x4 v0 = acc[ai][bj][m][0], v1 = acc[ai][bj][m][1];
                        u32x4 w; w.x = cvt_pk_bf16(v0[0], v0[1]); w.y = cvt_pk_bf16(v0[2], v0[3]); w.z = cvt_pk_bf16(v1[0], v1[1]); w.w = cvt_pk_bf16(v1[2], v1[3]);
                        *(u32x4*)(rowp + bj * HALF) = w; } } }
    }
};
}

struct Frame {
    LAS unsigned char* lds;
    gu32* ctl;
    int tid, lane, wave, G, bx;
    const float *x, *norm_mix, *w_in, *q_norm, *k_norm, *sinks, *w_pool, *pool_scale, *w_out, *norm_ffn, *w_coarse, *b_coarse, *w_fine, *b_fine, *w_gate, *w_up, *w_down;
    float* out;
    float *rope, *rinv, *rtok, *gate;
    bf16_t *Wr, *Wpool, *Win, *Wout, *Wgu, *Wd, *XB, *PROJ, *MIXED, *DPOOL, *ACT, *Y;
    int* rowl;
};

__device__ __forceinline__ void tr_item(const float* W, int N, int k0, int n0, bf16_t* dst0, int Kd, const float* gk, const float* gn, LAS float* scr, int lane) {
    const int kk0 = lane >> 3, n4 = (lane & 7) * 4;
    f32x4 v[8];
#pragma unroll
    for (int i = 0; i < 8; ++i) v[i] = *(const GAS f32x4*)(W + (size_t)(k0 + 8 * i + kk0) * N + n0 + n4);
    f32x4 sn = (f32x4){1.f, 1.f, 1.f, 1.f}; if (gn) sn = *(const GAS f32x4*)(gn + n0 + n4);
#pragma unroll
    for (int i = 0; i < 8; ++i) { const float g = gk ? gk[k0 + 8 * i + kk0] : 1.0f; const f32x4 w = v[i] * sn * g; LAS float* d = scr + (8 * i + kk0) * 33 + n4; d[0] = w.x; d[1] = w.y; d[2] = w.z; d[3] = w.w; }
    LDS_WAIT(); asm volatile("" ::: "memory");
    const int c = lane & 7;
#pragma unroll
    for (int j = 0; j < 4; ++j) { const int n = (lane >> 3) + 8 * j; const LAS float* s = scr + (8 * c) * 33 + n;
        u32x4 o; o.x = pk2(s[0 * 33], s[1 * 33]); o.y = pk2(s[2 * 33], s[3 * 33]); o.z = pk2(s[4 * 33], s[5 * 33]); o.w = pk2(s[6 * 33], s[7 * 33]);
        *(GAS u32x4*)(dst0 + (size_t)n * Kd + k0 + 8 * c) = o; }
    LDS_WAIT(); asm volatile("" ::: "memory");
}

__device__ __forceinline__ void p0_prologue(Frame& F) {
    const int gw = F.bx * 8 + F.wave, NGW = F.G * 8, gt = F.bx * 512 + F.tid, NGT = F.G * 512;
    LAS float* scr = (LAS float*)(F.lds + F.wave * 16384);
    for (int i = gt; i < SEQ * 8; i += NGT) {
        const int pos = i >> 3, j = i & 7;
        const double invf[8] = {1.0, 0.19392274474868576, 0.03760603093086393, 0.007292664737217109, 0.001414213562373095, 0.0002742481756762073, 5.318295896944988e-05, 1.031338537721246e-05};
        double f = invf[0];
#pragma unroll
        for (int q = 1; q < 8; ++q) f = (j == q) ? invf[q] : f;
        double s, c; sincos((double)pos * f, &s, &c);
        F.rope[pos * 16 + j] = (float)c; F.rope[pos * 16 + 8 + j] = (float)s;
    }
    for (int i = gt; i < 64 * DM; i += NGT) {
        const int j = i / DM, k = i % DM; float v = 0.f;
        if (j < 4) v = F.w_coarse[k * 4 + j] * F.norm_ffn[k]; else if (j < 36) v = F.w_fine[k * 32 + (j - 4)] * F.norm_ffn[k];
        const unsigned hi = f2bf(v); const float lo = v - bflo(hi);
        F.Wr[i] = (bf16_t)hi; F.Wr[64 * DM + i] = (bf16_t)f2bf(lo);
    }
    constexpr int I_IN = (DM / 64) * (INW / 32), I_OUT = (DM / 64) * (DM / 32), I_POOL = 4 * (256 / 64) * (256 / 32), I_G = NEXP * (DM / 64) * (DEXP / 32), I_D = NEXP * (DEXP / 64) * (DM / 32);
    constexpr int NITEMS = I_IN + I_OUT + I_POOL + 2 * I_G + I_D;
    for (int it = gw; it < NITEMS; it += NGW) {
        int r = it;
        if (r < I_IN) { const int nb = INW / 32, kb = r / nb, nn = r % nb; tr_item(F.w_in, INW, 64 * kb, 32 * nn, F.Win + (size_t)(32 * nn) * DM, DM, F.norm_mix, nullptr, scr, F.lane); continue; } r -= I_IN;
        if (r < I_OUT) { const int nb = DM / 32, kb = r / nb, nn = r % nb; tr_item(F.w_out, DM, 64 * kb, 32 * nn, F.Wout + (size_t)(32 * nn) * DM, DM, nullptr, nullptr, scr, F.lane); continue; } r -= I_OUT;
        if (r < I_POOL) { const int g = r / 32, q = r % 32, kb = q / 8, nn = q % 8;
            tr_item(F.w_pool + (size_t)g * 65536, 256, 64 * kb, 32 * nn, F.Wpool + (size_t)g * 65536 + (size_t)(32 * nn) * 256, 256, nullptr, F.pool_scale + g * 256, scr, F.lane); continue; } r -= I_POOL;
        if (r < 2 * I_G) { const int up = r >= I_G; if (up) r -= I_G; const int per = (DM / 64) * (DEXP / 32), e = r / per, q = r % per, nb = DEXP / 32, kb = q / nb, nn = q % nb, n0 = 32 * nn;
            const float* W = (up ? F.w_up : F.w_gate) + (size_t)e * DM * DEXP;
            bf16_t* dst = F.Wgu + ((size_t)e * 1024 + (size_t)(n0 >> 7) * 256 + (up ? 128 : 0) + (n0 & 127)) * DM;
            tr_item(W, DEXP, 64 * kb, n0, dst, DM, F.norm_ffn, nullptr, scr, F.lane); continue; } r -= 2 * I_G;
        { const int per = (DEXP / 64) * (DM / 32), e = r / per, q = r % per, nb = DM / 32, kb = q / nb, nn = q % nb;
          tr_item(F.w_down + (size_t)e * DEXP * DM, DM, 64 * kb, 32 * nn, F.Wd + ((size_t)e * DM + 32 * nn) * DEXP, DEXP, nullptr, nullptr, scr, F.lane); }
    }
    for (int m = gw; m < NTOK; m += NGW) {
        const GAS f32x4* xr = (const GAS f32x4*)(F.x + (size_t)m * DM) + F.lane;
        f32x4 v[8]; float s = 0.f;
#pragma unroll
        for (int j = 0; j < 8; ++j) { v[j] = xr[64 * j]; s += (v[j].x * v[j].x + v[j].y * v[j].y) + (v[j].z * v[j].z + v[j].w * v[j].w); }
        s = wave_sum(s);
        const float rr = 1.0f / sqrtf(s * (1.0f / DM) + EPS);
        GAS u32x2* o8 = (GAS u32x2*)(F.XB + (size_t)m * DM) + F.lane;
#pragma unroll
        for (int j = 0; j < 8; ++j) { u32x2 w; w.x = pk2(v[j].x * rr, v[j].y * rr); w.y = pk2(v[j].z * rr, v[j].w * rr); o8[64 * j] = w; }
    }
}

constexpr int AT_K = 0, AT_V = 32768, AT_VSTR = 520;
__device__ __forceinline__ void attn_unit(Frame& F, int b, int n, int kvh) {
    LAS unsigned char* lds = F.lds;
    const int tid = F.tid, lane = F.lane, wid = F.wave;
    const size_t tok0 = (size_t)b * SEQ;
    const int g = wid & 3, head = kvh * 4 + g, ql = lane & 31, hi = lane >> 5;
    u32x4 qraw[2][4];
#pragma unroll
    for (int it = 0; it < 2; ++it) { const int s = (wid >> 2) + 2 * it; const bf16_t* qp = F.PROJ + (tok0 + n * 128 + 32 * s + ql) * INW + QOFF + head * HD + hi * 8;
#pragma unroll
        for (int d0 = 0; d0 < 4; ++d0) qraw[it][d0] = *(const GAS u32x4*)(qp + d0 * 16); }
    u32x4 kraw[4], vraw[2][2];
#pragma unroll
    for (int i = 0; i < 4; ++i) { const int idx = i * 512 + tid, row = idx >> 3, c = idx & 7, pos = n * 128 - 128 + row;
        kraw[i] = (u32x4){0u, 0u, 0u, 0u};
        if (pos >= 0) kraw[i] = *(const GAS u32x4*)(F.PROJ + (tok0 + pos) * INW + KOFF + kvh * HD + c * 8); }
#pragma unroll
    for (int i = 0; i < 2; ++i) { const int idx = i * 512 + tid, kp = idx >> 3, c = idx & 7, pos = n * 128 - 128 + 2 * kp;
        vraw[i][0] = (u32x4){0u, 0u, 0u, 0u}; vraw[i][1] = (u32x4){0u, 0u, 0u, 0u};
        if (pos >= 0) { const bf16_t* p = F.PROJ + (tok0 + pos) * INW + VOFF + kvh * HD + c * 8; vraw[i][0] = *(const GAS u32x4*)p; vraw[i][1] = *(const GAS u32x4*)(p + INW); } }
#pragma unroll
    for (int i = 0; i < 4; ++i) {
        const int idx = i * 512 + tid, row = idx >> 3, c = idx & 7, pos = n * 128 - 128 + row;
        const u32x4 raw = kraw[i];
        float xv[8] = {bflo(raw.x), bfhi(raw.x), bflo(raw.y), bfhi(raw.y), bflo(raw.z), bfhi(raw.z), bflo(raw.w), bfhi(raw.w)};
        float ss = 0.f;
#pragma unroll
        for (int j = 0; j < 8; ++j) ss += xv[j] * xv[j];
        ss += __shfl_xor(ss, 1); ss += __shfl_xor(ss, 2); ss += __shfl_xor(ss, 4);
        const float rn = 1.0f / sqrtf(ss * (1.0f / HD) + EPS);
#pragma unroll
        for (int j = 0; j < 8; ++j) xv[j] = xv[j] * rn * F.k_norm[c * 8 + j];
        const int pp = pos >= 0 ? pos : 0;
#pragma unroll
        for (int j = 0; j < 8; ++j) { const float pr = __shfl_xor(xv[j], 1); const float cs = F.rope[pp * 16 + j], sn = F.rope[pp * 16 + 8 + j];
            const float r0 = xv[j] * cs - pr * sn, r1 = xv[j] * cs + pr * sn; xv[j] = (c == 0) ? r0 : (c == 1) ? r1 : xv[j]; }
        u32x4 w; w.x = pk2(xv[0], xv[1]); w.y = pk2(xv[2], xv[3]); w.z = pk2(xv[4], xv[5]); w.w = pk2(xv[6], xv[7]);
        *(LAS u32x4*)(lds + AT_K + row * 128 + ((c ^ (row & 7)) * 16)) = w;
    }
#pragma unroll
    for (int i = 0; i < 2; ++i) {
        const int idx = i * 512 + tid, kp = idx >> 3, c = idx & 7;
        const u32x4 r0 = vraw[i][0], r1 = vraw[i][1];
        const unsigned a0[4] = {r0.x, r0.y, r0.z, r0.w}, a1[4] = {r1.x, r1.y, r1.z, r1.w};
#pragma unroll
        for (int q = 0; q < 4; ++q) {
            const unsigned lo = (a0[q] & 0xffffu) | (a1[q] << 16), hi2 = (a0[q] >> 16) | (a1[q] & 0xffff0000u);
            *(LAS unsigned*)(lds + AT_V + (c * 8 + 2 * q) * AT_VSTR + kp * 4) = lo;
            *(LAS unsigned*)(lds + AT_V + (c * 8 + 2 * q + 1) * AT_VSTR + kp * 4) = hi2;
        }
    }
    __syncthreads();
    const float sink2 = F.sinks[head] * 1.4426950408889634f;
    const float SC = 0.125f * 1.4426950408889634f;
#pragma unroll
    for (int it = 0; it < 2; ++it) {
        const int s = (wid >> 2) + 2 * it;
        const int qpos = n * 128 + 32 * s + ql;
        float qv[4][8];
        float ss = 0.f;
#pragma unroll
        for (int d0 = 0; d0 < 4; ++d0) { const u32x4 raw = qraw[it][d0];
            qv[d0][0] = bflo(raw.x); qv[d0][1] = bfhi(raw.x); qv[d0][2] = bflo(raw.y); qv[d0][3] = bfhi(raw.y); qv[d0][4] = bflo(raw.z); qv[d0][5] = bfhi(raw.z); qv[d0][6] = bflo(raw.w); qv[d0][7] = bfhi(raw.w);
#pragma unroll
            for (int j = 0; j < 8; ++j) ss += qv[d0][j] * qv[d0][j]; }
        ss += __shfl_xor(ss, 32);
        const float rn = SC / sqrtf(ss * (1.0f / HD) + EPS);
#pragma unroll
        for (int d0 = 0; d0 < 4; ++d0)
#pragma unroll
            for (int j = 0; j < 8; ++j) qv[d0][j] = qv[d0][j] * rn * F.q_norm[d0 * 16 + hi * 8 + j];
#pragma unroll
        for (int j = 0; j < 8; ++j) { const float pr = __shfl_xor(qv[0][j], 32); const float cs = F.rope[qpos * 16 + j], sn = F.rope[qpos * 16 + 8 + j];
            qv[0][j] = (hi == 0) ? (qv[0][j] * cs - pr * sn) : (qv[0][j] * cs + pr * sn); }
        bf16x8 qr[4];
#pragma unroll
        for (int d0 = 0; d0 < 4; ++d0) { u32x4 w; w.x = pk2(qv[d0][0], qv[d0][1]); w.y = pk2(qv[d0][2], qv[d0][3]); w.z = pk2(qv[d0][4], qv[d0][5]); w.w = pk2(qv[d0][6], qv[d0][7]);
            qr[d0] = __builtin_bit_cast(bf16x8, w); }
        f32x16 p[5];
#pragma unroll
        for (int jt = 0; jt < 5; ++jt) {
            const int krow = 32 * (s + jt) + ql;
            f32x16 a = {};
#pragma unroll
            for (int d0 = 0; d0 < 4; ++d0) { const int c = 2 * d0 + hi;
                const bf16x8 kf = *(const LAS bf16x8*)(lds + AT_K + krow * 128 + ((c ^ (krow & 7)) * 16));
                a = __builtin_amdgcn_mfma_f32_32x32x16_bf16(kf, qr[d0], a, 0, 0, 0); }
            p[jt] = a;
        }
        float mx = sink2;
#pragma unroll
        for (int jt = 0; jt < 5; ++jt) {
            const bool blk_dead = (n == 0) && (s + jt < 4);
#pragma unroll
            for (int r = 0; r < 16; ++r) { const int kl = (r & 3) + 8 * (r >> 2) + 4 * hi;
                bool ok = !blk_dead; if (jt == 0) ok = ok && (kl > ql); if (jt == 4) ok = ok && (kl <= ql);
                const float v = ok ? p[jt][r] : -1e30f; p[jt][r] = v; mx = fmaxf(mx, v); }
        }
        mx = fmaxf(mx, __shfl_xor(mx, 32));
        float sum = 0.f;
#pragma unroll
        for (int jt = 0; jt < 5; ++jt)
#pragma unroll
            for (int r = 0; r < 16; ++r) { const float e = __builtin_amdgcn_exp2f(p[jt][r] - mx); p[jt][r] = e; sum += e; }
        sum += __shfl_xor(sum, 32);
        sum += __builtin_amdgcn_exp2f(sink2 - mx);
        const float inv = 1.0f / sum;
        f32x16 o[2]; o[0] = f32x16{}; o[1] = f32x16{};
#pragma unroll
        for (int jt = 0; jt < 5; ++jt)
#pragma unroll
            for (int s2 = 0; s2 < 2; ++s2) {
                u32x4 pw; pw.x = cvt_pk_bf16(p[jt][8 * s2 + 0] * inv, p[jt][8 * s2 + 1] * inv); pw.y = cvt_pk_bf16(p[jt][8 * s2 + 2] * inv, p[jt][8 * s2 + 3] * inv);
                pw.z = cvt_pk_bf16(p[jt][8 * s2 + 4] * inv, p[jt][8 * s2 + 5] * inv); pw.w = cvt_pk_bf16(p[jt][8 * s2 + 6] * inv, p[jt][8 * s2 + 7] * inv);
                const bf16x8 pf = __builtin_bit_cast(bf16x8, pw);
                const int kb = 32 * (s + jt) + 16 * s2 + 4 * hi;
#pragma unroll
                for (int dt = 0; dt < 2; ++dt) {
                    const LAS unsigned char* vp = lds + AT_V + (dt * 32 + ql) * AT_VSTR + kb * 2;
                    const u32x2 v0 = *(const LAS u32x2*)vp, v1 = *(const LAS u32x2*)(vp + 16);
                    u32x4 vw; vw.x = v0.x; vw.y = v0.y; vw.z = v1.x; vw.w = v1.y;
                    o[dt] = __builtin_amdgcn_mfma_f32_32x32x16_bf16(__builtin_bit_cast(bf16x8, vw), pf, o[dt], 0, 0, 0);
                }
            }
        bf16_t* op = F.MIXED + (tok0 + qpos) * DM + head * HD + (hi ? 8 : 0);
#pragma unroll
        for (int dt = 0; dt < 2; ++dt)
#pragma unroll
            for (int gp = 0; gp < 2; ++gp) {
                const int r0 = 8 * gp;
                unsigned ax = cvt_pk_bf16(o[dt][r0 + 0], o[dt][r0 + 1]), ay = cvt_pk_bf16(o[dt][r0 + 2], o[dt][r0 + 3]);
                unsigned bx = cvt_pk_bf16(o[dt][r0 + 4], o[dt][r0 + 5]), by = cvt_pk_bf16(o[dt][r0 + 6], o[dt][r0 + 7]);
                { auto rr = __builtin_amdgcn_permlane32_swap(ax, bx, false, false); ax = rr[0]; bx = rr[1]; }
                { auto rr = __builtin_amdgcn_permlane32_swap(ay, by, false, false); ay = rr[0]; by = rr[1]; }
                u32x4 w; w.x = ax; w.y = ay; w.z = bx; w.w = by;
                *(GAS u32x4*)(op + dt * 32 + 16 * gp) = w;
            }
    }
    __syncthreads();
}

__device__ __forceinline__ void pool_diff(Frame& F) {
    const int NITEM = (NTOK / 32) * 128;
    for (int it = F.bx * 512 + F.tid; it < NITEM; it += F.G * 512) {
        const int ri = it >> 7, c8 = it & 127, w = 2 << (c8 >> 5), t0 = ri * 32, pos0 = t0 & (SEQ - 1);
        const bf16_t* up = F.PROJ + (size_t)t0 * INW + UOFF + c8 * 8;
        float S[8];
#pragma unroll
        for (int j = 0; j < 8; ++j) S[j] = 0.f;
        for (int i = 1; i < w; ++i) if (pos0 - i >= 0) { const u32x4 raw = *(const GAS u32x4*)(up - (size_t)i * INW);
            S[0] += bflo(raw.x); S[1] += bfhi(raw.x); S[2] += bflo(raw.y); S[3] += bfhi(raw.y); S[4] += bflo(raw.z); S[5] += bfhi(raw.z); S[6] += bflo(raw.w); S[7] += bfhi(raw.w); }
#pragma unroll 4
        for (int t = 0; t < 32; ++t) {
            const u32x4 raw = *(const GAS u32x4*)(up + (size_t)t * INW);
            const float xv[8] = {bflo(raw.x), bfhi(raw.x), bflo(raw.y), bfhi(raw.y), bflo(raw.z), bfhi(raw.z), bflo(raw.w), bfhi(raw.w)};
            const int pos = pos0 + t; const float ic = 1.0f / (float)((pos + 1 < w) ? (pos + 1) : w);
            float d[8];
#pragma unroll
            for (int j = 0; j < 8; ++j) { S[j] += xv[j]; d[j] = S[j] * ic - xv[j]; }
            u32x4 o; o.x = pk2(d[0], d[1]); o.y = pk2(d[2], d[3]); o.z = pk2(d[4], d[5]); o.w = pk2(d[6], d[7]);
            *(GAS u32x4*)(F.DPOOL + (size_t)(t0 + t) * PW + c8 * 8) = o;
            if (pos - w + 1 >= 0) { const u32x4 old = *(const GAS u32x4*)(up + (ptrdiff_t)(t - w + 1) * INW);
                S[0] -= bflo(old.x); S[1] -= bfhi(old.x); S[2] -= bflo(old.y); S[3] -= bfhi(old.y); S[4] -= bflo(old.z); S[5] -= bfhi(old.z); S[6] -= bflo(old.w); S[7] -= bfhi(old.w); }
        }
    }
}

constexpr int RT_WSTR = 528, RT_W = 0, RT_WLO = 64 * RT_WSTR, RT_L = 2 * 64 * RT_WSTR, RT_LSTR = 65;
__device__ __forceinline__ void route_phase(Frame& F, bool dry) {
    LAS unsigned char* lds = F.lds;
    const int tid = F.tid, lane = F.lane, wid = F.wave, row = lane & 15, kq = lane >> 4;
    for (int tile = F.bx; tile < NTOK / 128; tile += F.G) {
        const int t0 = tile * 128 + wid * 16;
        const bf16_t* hp = F.XB + (size_t)(t0 + row) * DM + kq * 8;
        f32x4 acc[4]; acc[0] = acc[1] = acc[2] = acc[3] = (f32x4){0.f, 0.f, 0.f, 0.f};
        float ssq = 0.f;
        u32x4 hv[8]; u32x4 wv[8];
#pragma unroll
        for (int ks = 0; ks < 8; ++ks) hv[ks] = *(const GAS u32x4*)(hp + ks * 32);
#pragma unroll
        for (int i = 0; i < 8; ++i) { const int p = i * 512 + tid, which = p >> 11, col = (p & 2047) >> 5, ch = p & 31;
            wv[i] = *(const GAS u32x4*)(F.Wr + (size_t)which * 64 * DM + (size_t)col * DM + ch * 8); }
#pragma unroll 1
        for (int kc = 0; kc < 8; ++kc) {
            __syncthreads();
#pragma unroll
            for (int i = 0; i < 8; ++i) { const int p = i * 512 + tid, which = p >> 11, col = (p & 2047) >> 5, ch = p & 31;
                *(LAS u32x4*)(lds + which * RT_WLO + col * RT_WSTR + ch * 16) = wv[i]; }
            __syncthreads();
            if (kc < 7) {
#pragma unroll
                for (int i = 0; i < 8; ++i) { const int p = i * 512 + tid, which = p >> 11, col = (p & 2047) >> 5, ch = p & 31;
                    wv[i] = *(const GAS u32x4*)(F.Wr + (size_t)which * 64 * DM + (size_t)col * DM + (kc + 1) * 256 + ch * 8); } }
#pragma unroll
            for (int ks = 0; ks < 8; ++ks) {
                const int k = kc * 256 + ks * 32;
                const u32x4 ah = hv[ks];
                if (kc < 7) hv[ks] = *(const GAS u32x4*)(hp + k + 256);
                { const float a0 = bflo(ah.x), a1 = bfhi(ah.x), a2 = bflo(ah.y), a3 = bfhi(ah.y), a4 = bflo(ah.z), a5 = bfhi(ah.z), a6 = bflo(ah.w), a7 = bfhi(ah.w);
                  ssq += (a0 * a0 + a1 * a1) + (a2 * a2 + a3 * a3) + (a4 * a4 + a5 * a5) + (a6 * a6 + a7 * a7); }
                const bf16x8 Ah = __builtin_bit_cast(bf16x8, ah);
#pragma unroll
                for (int tc = 0; tc < 4; ++tc) {
                    const LAS unsigned char* bp = lds + (tc * 16 + row) * RT_WSTR + (ks * 32 + kq * 8) * 2;
                    const bf16x8 Bh = *(const LAS bf16x8*)bp, Bl = *(const LAS bf16x8*)(bp + RT_WLO);
                    acc[tc] = __builtin_amdgcn_mfma_f32_16x16x32_bf16(Ah, Bh, acc[tc], 0, 0, 0);
                    acc[tc] = __builtin_amdgcn_mfma_f32_16x16x32_bf16(Ah, Bl, acc[tc], 0, 0, 0);
                }
            }
        }
        ssq += __shfl_xor(ssq, 16); ssq += __shfl_xor(ssq, 32);
        const float rt = 1.0f / sqrtf(ssq * (1.0f / DM) + EPS);
        LAS float* L = (LAS float*)(lds + RT_L) + wid * 16 * RT_LSTR;
#pragma unroll
        for (int tc = 0; tc < 4; ++tc)
#pragma unroll
            for (int r = 0; r < 4; ++r) L[(kq * 4 + r) * RT_LSTR + tc * 16 + row] = acc[tc][r];
        __syncthreads();
        if (lane < 16) {
            const int t = t0 + lane; const LAS float* Lt = L + lane * RT_LSTR;
            float c[4]; int grp = 0; float cm;
#pragma unroll
            for (int j = 0; j < 4; ++j) c[j] = Lt[j] * rt + F.b_coarse[j];
            cm = c[0];
#pragma unroll
            for (int j = 1; j < 4; ++j) if (c[j] > cm) { cm = c[j]; grp = j; }
            float den = 0.f;
#pragma unroll
            for (int j = 0; j < 4; ++j) den += __expf(c[j] - cm);
            const float pg = 1.0f / den;
            float f[8];
#pragma unroll
            for (int j = 0; j < 8; ++j) f[j] = Lt[4 + grp * 8 + j] * rt + F.b_fine[grp * 8 + j];
            int i1 = 0; float l1 = f[0];
#pragma unroll
            for (int j = 1; j < 8; ++j) if (f[j] > l1) { l1 = f[j]; i1 = j; }
            int i2 = -1; float l2 = -3.0e38f;
#pragma unroll
            for (int j = 0; j < 8; ++j) if (j != i1 && f[j] > l2) { l2 = f[j]; i2 = j; }
            const float e2 = __expf(l2 - l1), g1 = pg / (1.0f + e2), g2 = pg * e2 / (1.0f + e2);
            F.rtok[t] = rt; F.gate[2 * t] = g1; F.gate[2 * t + 1] = g2;
            const int e1 = grp * 8 + i1, ee2 = grp * 8 + i2;
            if (!dry) {
            const unsigned p1 = __hip_atomic_fetch_add((unsigned*)(F.ctl + CW_CNT + 64 * e1), 1u, RLX_AGENT);
            F.rowl[(size_t)e1 * RCAP + p1] = 2 * t;
            const unsigned p2 = __hip_atomic_fetch_add((unsigned*)(F.ctl + CW_CNT + 64 * ee2), 1u, RLX_AGENT);
            F.rowl[(size_t)ee2 * RCAP + p2] = 2 * t + 1; }
        }
    }
}

__device__ __forceinline__ void moe_setup(Frame& F, int nN, bool with_rg) {
    LAS int* expt = (LAS int*)(F.lds + EXPT_OFF); LAS int* tab = (LAS int*)(F.lds + TAB_OFF); LAS float* tabr = (LAS float*)(F.lds + TABR_OFF); LAS float* tabg = (LAS float*)(F.lds + TABG_OFF);
    __syncthreads();
    if (F.tid == 0) { int acc = 0;
        for (int e = 0; e < NEXP; ++e) { const int cnt = (int)__hip_atomic_load((unsigned*)(F.ctl + CW_CNT + 64 * e), RLX_AGENT); expt[e] = acc; expt[33 + e] = cnt; acc += ((cnt + 255) >> 8) * nN; }
        expt[32] = acc; }
    __syncthreads();
    pg8::MoeProb P; P.expt = expt; P.nN = nN; P.G = F.G; P.c = F.bx;
    pg8::Unit u;
    for (int i = 0; P.next(i, u); ++i) {
        if (F.tid < 256) { const int j = u.pm * 256 + F.tid; const int cnt = expt[33 + u.e];
            const int v = F.rowl[(size_t)u.e * RCAP + (j < cnt ? j : 0)];
            tab[i * 256 + F.tid] = (j < cnt) ? v : (v | (int)0x80000000);
            if (with_rg && i < TABRG_UNITS) { const float r = F.rtok[v >> 1]; tabr[i * 256 + F.tid] = r; tabg[i * 256 + F.tid] = r * F.gate[v]; } }
    }
    __syncthreads();
}

__device__ __forceinline__ void combine_phase(Frame& F, float* dst) {
    const size_t NIT = (size_t)NTOK * (DM / 8);
    for (size_t it = (size_t)F.bx * 512 + F.tid; it < NIT; it += (size_t)F.G * 512) {
        const size_t t = it >> 8; const int c = (int)(it & 255) * 8;
        float* wp = dst + t * DM + c;
        const u32x4 h = *(const GAS u32x4*)(F.XB + t * DM + c);
        const u32x4 y0 = *(const GAS u32x4*)(F.Y + (2 * t) * DM + c), y1 = *(const GAS u32x4*)(F.Y + (2 * t + 1) * DM + c);
        f32x4 o0, o1;
        o0.x = bflo(h.x) + bflo(y0.x) + bflo(y1.x); o0.y = bfhi(h.x) + bfhi(y0.x) + bfhi(y1.x); o0.z = bflo(h.y) + bflo(y0.y) + bflo(y1.y); o0.w = bfhi(h.y) + bfhi(y0.y) + bfhi(y1.y);
        o1.x = bflo(h.z) + bflo(y0.z) + bflo(y1.z); o1.y = bfhi(h.z) + bfhi(y0.z) + bfhi(y1.z); o1.z = bflo(h.w) + bflo(y0.w) + bflo(y1.w); o1.w = bfhi(h.w) + bfhi(y0.w) + bfhi(y1.w);
        *(GAS f32x4*)wp = o0; *(GAS f32x4*)(wp + 4) = o1;
    }
}

struct Args { const float* in[17]; float* out; unsigned char* ws; int ph_lo, ph_hi, use_bar, pad; };
__global__ void __launch_bounds__(512, 2) hymba_fwd(Args args) {
    extern __shared__ __attribute__((aligned(16))) unsigned char lds[];
    Frame F;
    F.lds = (LAS unsigned char*)lds;
    F.tid = threadIdx.x; F.lane = F.tid & 63; F.wave = __builtin_amdgcn_readfirstlane(F.tid >> 6);
    F.G = gridDim.x; F.bx = blockIdx.x;
    unsigned char* ws = args.ws;
    F.ctl = (gu32*)(ws + WS_CTL);
    F.x = args.in[0]; F.norm_mix = args.in[1]; F.w_in = args.in[2]; F.q_norm = args.in[3]; F.k_norm = args.in[4]; F.sinks = args.in[5]; F.w_pool = args.in[6]; F.pool_scale = args.in[7];
    F.w_out = args.in[8]; F.norm_ffn = args.in[9]; F.w_coarse = args.in[10]; F.b_coarse = args.in[11]; F.w_fine = args.in[12]; F.b_fine = args.in[13]; F.w_gate = args.in[14]; F.w_up = args.in[15]; F.w_down = args.in[16];
    F.out = args.out;
    F.rope = (float*)(ws + WS_ROPE); F.rinv = (float*)(ws + WS_RINV); F.rtok = (float*)(ws + WS_RTOK); F.gate = (float*)(ws + WS_GATE);
    F.Wr = (bf16_t*)(ws + WS_WR); F.Wpool = (bf16_t*)(ws + WS_WPOOL); F.Win = (bf16_t*)(ws + WS_WIN); F.Wout = (bf16_t*)(ws + WS_WOUT); F.Wgu = (bf16_t*)(ws + WS_WGU); F.Wd = (bf16_t*)(ws + WS_WD);
    F.XB = (bf16_t*)(ws + WS_XB); F.PROJ = (bf16_t*)(ws + WS_PROJ); F.MIXED = (bf16_t*)(ws + WS_MIXED); F.DPOOL = (bf16_t*)(ws + WS_DPOOL); F.ACT = (bf16_t*)(ws + WS_ACT); F.Y = (bf16_t*)(ws + WS_Y);
    F.rowl = (int*)(ws + WS_ROWL);
    if (F.tid < 4) ((LAS unsigned*)(F.lds + MISC_OFF))[F.tid] = 0u;
    __syncthreads();
    XcdBarrier bar; bar.bar = (unsigned*)(F.ctl + CW_BAR); bar.x = 0; bar.st = nullptr;
    if (args.use_bar) bar = xcd_barrier_post((unsigned*)(F.ctl + CW_BAR), (volatile LAS unsigned*)(F.lds + MISC_OFF));
    const int lo = args.ph_lo, hi = args.ph_hi;
#define IN(k) (lo <= (k) && (k) < hi)
#define SEAM(k) do { if (IN(k) && IN((k) + 1)) xcd_barrier(bar); } while (0)

#define REPS(k) ((PROBE_DUP == (k)) ? 2 : 1)
    if (IN(0)) { for (int rep = 0; rep < REPS(0); ++rep) { if (rep) xcd_barrier(bar); p0_prologue(F); } SEAM(0); }
    if (IN(1)) {
        for (int rep = 0; rep < REPS(1); ++rep) { if (rep) xcd_barrier(bar);
        pg8::DenseProb P; P.A = F.XB; P.Bt = F.Win; P.lda = DM; P.K = DM; P.acol = 0; P.so.init(NTOK, INW, F.G, F.bx);
        pg8::EpiBf16 E{F.PROJ, INW, 0};
        pg8::gemm_phase(F.lds, P, E); }
        SEAM(1);
    }
    if (IN(2)) {
        for (int rep = 0; rep < REPS(2); ++rep) { if (rep) xcd_barrier(bar);
        for (int u = F.bx; u < BATCH * (SEQ / 128) * NKV; u += F.G) { const int kvh = u & 3, n = (u >> 2) & 31, b = u >> 7; attn_unit(F, b, n, kvh); }
        pool_diff(F); }
        SEAM(2);
    }
    if (IN(3)) {
        for (int rep = 0; rep < REPS(3); ++rep) { if (rep) xcd_barrier(bar);
        pg8::DenseProb P; P.A = F.DPOOL; P.Bt = F.Wpool; P.lda = PW; P.K = 256; P.acol = 256; P.so.init(NTOK, PW, F.G, F.bx);
        pg8::EpiBf16 E{F.MIXED, DM, 1024};
        pg8::gemm_phase(F.lds, P, E); }
        SEAM(3);
    }
    if (IN(4)) {
        for (int rep = 0; rep < REPS(4); ++rep) { if (rep) xcd_barrier(bar);
        pg8::DenseProb P; P.A = F.MIXED; P.Bt = F.Wout; P.lda = DM; P.K = DM; P.acol = 0; P.so.init(NTOK, DM, F.G, F.bx);
        pg8::EpiResBf16 E{F.x, F.XB, DM};
        pg8::gemm_phase(F.lds, P, E); }
        SEAM(4);
    }
    if (IN(5)) { for (int rep = 0; rep < REPS(5); ++rep) { if (rep) xcd_barrier(bar); route_phase(F, rep + 1 < REPS(5)); } SEAM(5); }
    if (IN(6)) {
        for (int rep = 0; rep < REPS(6); ++rep) { if (rep) xcd_barrier(bar);
        moe_setup(F, 4, true);
        pg8::MoeProb P; P.A = F.XB; P.Bt = F.Wgu; P.lda = DM; P.K = DM; P.nN = 4; P.shift = 1; P.tab = (LAS const int*)(F.lds + TAB_OFF); P.expt = (LAS const int*)(F.lds + EXPT_OFF); P.G = F.G; P.c = F.bx;
        pg8::EpiSwiGLU E{F.ACT, (LAS const int*)(F.lds + TAB_OFF), (LAS const float*)(F.lds + TABR_OFF), (LAS const float*)(F.lds + TABG_OFF)};
        pg8::gemm_phase(F.lds, P, E); }
        SEAM(6);
    }
    if (IN(7)) {
        for (int rep = 0; rep < REPS(7); ++rep) { if (rep) xcd_barrier(bar);
        moe_setup(F, 8, false);
        pg8::MoeProb P; P.A = F.ACT; P.Bt = F.Wd; P.lda = DEXP; P.K = DEXP; P.nN = 8; P.shift = 0; P.tab = (LAS const int*)(F.lds + TAB_OFF); P.expt = (LAS const int*)(F.lds + EXPT_OFF); P.G = F.G; P.c = F.bx;
        pg8::EpiScatterBf16 E{F.Y, DM, (LAS const int*)(F.lds + TAB_OFF)};
        pg8::gemm_phase(F.lds, P, E); }
        SEAM(7);
    }
    if (IN(8)) { for (int rep = 0; rep < REPS(8); ++rep) { if (rep) xcd_barrier(bar); combine_phase(F, (rep + 1 < REPS(8)) ? (float*)(ws + WS_WGU) : F.out); } }
#undef REPS
#undef IN
#undef SEAM
}

extern "C" void kernel_launch(void* const* d_in, const int* in_sizes, int n_in, void* d_out, int out_size, void* d_ws, size_t ws_size, hipStream_t stream) {
    static int grid = 0;
    if (grid == 0) {
        if (n_in != 17 || out_size != NTOK * DM || ws_size < WS_END) { fprintf(stderr, "kernel_launch: unexpected problem (n_in %d, out %d, ws %zu)\n", n_in, out_size, ws_size); grid = -1; return; }
        int dev = 0, cus = 0;
        if (hipGetDevice(&dev) != hipSuccess || hipDeviceGetAttribute(&cus, hipDeviceAttributeMultiprocessorCount, dev) != hipSuccess) { grid = -1; return; }
        if (hipFuncSetAttribute((const void*)hymba_fwd, hipFuncAttributeMaxDynamicSharedMemorySize, LDS_BYTES) != hipSuccess) { fprintf(stderr, "kernel_launch: hipFuncSetAttribute failed\n"); grid = -1; return; }
        int per_cu = 0;
        if (hipOccupancyMaxActiveBlocksPerMultiprocessor(&per_cu, (const void*)hymba_fwd, 512, LDS_BYTES) != hipSuccess || per_cu < 1) { fprintf(stderr, "kernel_launch: occupancy query says %d\n", per_cu); }
        (void)hipGetLastError();
        grid = cus - (cus % 8);
        if (grid <= 0) grid = -1;
    }
    if (grid < 0) return;
    if (hipMemsetAsync((char*)d_ws + WS_CTL, 0, CTL_ZERO_BYTES, stream) != hipSuccess) return;
    Args a{};
    for (int i = 0; i < 17; ++i) a.in[i] = (const float*)d_in[i];
    a.out = (float*)d_out; a.ws = (unsigned char*)d_ws;
    if (MK_N_LAUNCHES == 1) { a.ph_lo = 0; a.ph_hi = NPHASE; a.use_bar = 1; hipLaunchKernelGGL(hymba_fwd, dim3(grid), dim3(512), LDS_BYTES, stream, a); }
    else for (int p = 0; p < NPHASE; ++p) { a.ph_lo = p; a.ph_hi = p + 1; a.use_bar = 0; hipLaunchKernelGGL(hymba_fwd, dim3(grid), dim3(512), LDS_BYTES, stream, a); }
}
```

```cpp
#include <hip/hip_runtime.h>
#include <cstdio>
#include <cstdint>

#ifndef MK_N_LAUNCHES
#define MK_N_LAUNCHES 1
#endif
#ifndef DENSE_A_NT
#define DENSE_A_NT false
#endif
#ifndef MOE_OWNER
#define MOE_OWNER 1
#endif
#ifndef STORE_AUX
#define STORE_AUX 0
#endif
#ifndef STAGGER_TICKS
#define STAGGER_TICKS 0
#endif
#ifndef PROBE_EPI2
#define PROBE_EPI2 0
#endif
#ifndef PROBE_K2
#define PROBE_K2 0
#endif
#ifndef PROBE_DUP
#define PROBE_DUP -1
#endif

#define GAS __attribute__((address_space(1)))
#define LAS __attribute__((address_space(3)))
typedef unsigned short bf16_t;
typedef short bf16x8 __attribute__((ext_vector_type(8)));
typedef short s16x4 __attribute__((ext_vector_type(4)));
typedef float f32x4 __attribute__((ext_vector_type(4)));
typedef float f32x2 __attribute__((ext_vector_type(2)));
typedef float f32x16 __attribute__((ext_vector_type(16)));
typedef unsigned u32x4 __attribute__((ext_vector_type(4)));
typedef unsigned u32x2 __attribute__((ext_vector_type(2)));
typedef GAS unsigned gu32;

constexpr int BATCH = 8, SEQ = 4096, NTOK = BATCH * SEQ, DM = 2048;
constexpr int NH = 16, NKV = 4, HD = 64, INW = 2560, QOFF = 0, KOFF = 1024, VOFF = 1280, UOFF = 1536, PW = 1024;
constexpr int NEXP = 32, DEXP = 512, NASG = NTOK * 2, RCAP = NASG;
constexpr float EPS = 1e-6f;
constexpr int NPHASE = 9;

constexpr size_t MiB = 1u << 20;
constexpr size_t WS_CTL = 0, CTL_ZERO_BYTES = 64 * 1024;
constexpr size_t WS_ROPE = 1 * MiB;
constexpr size_t WS_RINV = WS_ROPE + 256 * 1024;
constexpr size_t WS_RTOK = WS_RINV + 128 * 1024;
constexpr size_t WS_GATE = WS_RTOK + 128 * 1024;
constexpr size_t WS_WR = 2 * MiB;
constexpr size_t WS_WPOOL = WS_WR + 512 * 1024;
constexpr size_t WS_WIN = 3 * MiB;
constexpr size_t WS_WOUT = 13 * MiB;
constexpr size_t WS_ROWL = 21 * MiB;
constexpr size_t WS_WGU = 29 * MiB;
constexpr size_t WS_H8 = 93 * MiB;
constexpr size_t WS_WD = 157 * MiB;
constexpr size_t WS_ACT8 = 189 * MiB;
constexpr size_t WS_XB = 221 * MiB;
constexpr size_t WS_PROJ = 349 * MiB;
constexpr size_t WS_MIXED = 509 * MiB;
constexpr size_t WS_DPOOL = 637 * MiB;
constexpr size_t WS_ACT = WS_DPOOL;
constexpr size_t WS_Y = WS_PROJ;
constexpr size_t WS_END = 701 * MiB;
static_assert(WS_Y + (size_t)NASG * DM * 2 <= WS_DPOOL, "Y overlay");
constexpr int CW_TMO = 0, CW_BAR = 1024, CW_CNT = 8192;

constexpr int RING_BYTES = 131072;
constexpr int TAB_OFF = RING_BYTES;
constexpr int TAB_UNITS = 14, TABRG_UNITS = 6;
constexpr int TABR_OFF = TAB_OFF + TAB_UNITS * 1024;
constexpr int TABG_OFF = TABR_OFF + TABRG_UNITS * 1024;
constexpr int EXPT_OFF = TABG_OFF + TABRG_UNITS * 1024;
constexpr int MISC_OFF = EXPT_OFF + 512;
constexpr int LDS_BYTES = 159744;
static_assert(MISC_OFF + 16 <= LDS_BYTES, "LDS map");

#define RLX_AGENT __ATOMIC_RELAXED, __HIP_MEMORY_SCOPE_AGENT
#define LDS_WAIT() asm volatile("s_waitcnt lgkmcnt(0)" ::: "memory")
#define VM_WAIT() asm volatile("s_waitcnt vmcnt(0)" ::: "memory")

__device__ __forceinline__ unsigned f2bf(float f) { unsigned u = __builtin_bit_cast(unsigned, f); return (u + 0x7fffu + ((u >> 16) & 1u)) >> 16; }

__device__ __forceinline__ float bflo(unsigned w) { return __builtin_bit_cast(float, w << 16); }
__device__ __forceinline__ float bfhi(unsigned w) { return __builtin_bit_cast(float, w & 0xffff0000u); }
typedef __bf16 bf16x2_t __attribute__((ext_vector_type(2)));
__device__ __forceinline__ unsigned cvt_pk_bf16(float lo, float hi) { f32x2 v = {lo, hi}; bf16x2_t b = __builtin_convertvector(v, bf16x2_t); return __builtin_bit_cast(unsigned, b); }
__device__ __forceinline__ unsigned pk2(float lo, float hi) { return cvt_pk_bf16(lo, hi); }
__device__ __forceinline__ unsigned pk4_fp8(float a, float b, float c, float d) { int r = 0; r = __builtin_amdgcn_cvt_pk_fp8_f32(a, b, r, false); r = __builtin_amdgcn_cvt_pk_fp8_f32(c, d, r, true); return (unsigned)r; }
constexpr float W8_SCALE = 256.0f, ACT8_SCALE = 8.0f, Y8_SCALE = 32.0f;
__device__ __forceinline__ float wave_sum(float v) {
#pragma unroll
    for (int o = 1; o < 64; o <<= 1) v += __shfl_xor(v, o);
    return v;
}

#define XB_TMO      128
#define XB_XCNT(j)  (256  + 64 * (j))
#define XB_XSUB(j)  (1280 + 64 * (j))
#define XB_XGEN(j)  (2304 + 64 * (j))
#define XB_TOP      3328
#define XB_TOPGEN   3392
#define XCD_BAR_WORDS 3456
#define XB_SPIN_CAP (1u << 18)
__device__ __forceinline__ unsigned xb_ld(unsigned* p)              { return __hip_atomic_load(p, __ATOMIC_RELAXED, __HIP_MEMORY_SCOPE_AGENT); }
__device__ __forceinline__ unsigned xb_add(unsigned* p, unsigned v) { return __hip_atomic_fetch_add(p, v, __ATOMIC_RELAXED, __HIP_MEMORY_SCOPE_AGENT); }
__device__ __forceinline__ unsigned xb_xcc_id() { return (unsigned)__builtin_amdgcn_s_getreg((3 << 11) | 20) & 0xFu; }
#define XB_SPIN(cond, bar) do { unsigned _sp = 0; while (cond) { __builtin_amdgcn_s_sleep(1); \
    if ((++_sp & 255u) == 0u) { if (xb_ld(&(bar)[XB_TMO])) break; if (_sp > XB_SPIN_CAP) { atomicAdd(&(bar)[XB_TMO], 1u); break; } } } } while (0)
struct XcdBarrier { unsigned* bar; unsigned x; volatile LAS unsigned* st; };
__device__ __forceinline__ XcdBarrier xcd_barrier_post(unsigned* bar, volatile LAS unsigned* st) {
    XcdBarrier b; b.bar = bar; b.x = xb_xcc_id(); b.st = st;
    if (threadIdx.x == 0) (void)xb_add(&bar[XB_XCNT(b.x)], 1u);
    return b;
}
__device__ __forceinline__ void xcd_barrier_complete(unsigned* bar, unsigned x, unsigned& nloc, unsigned& nx) {
    const unsigned G = gridDim.x * gridDim.y * gridDim.z;
    unsigned sum, cnt, mine, sp = 0u;
    for (;;) {
        sum = 0u; cnt = 0u; mine = 0u;
#pragma unroll
        for (unsigned j = 0; j < 16; ++j) { const unsigned c = xb_ld(&bar[XB_XCNT(j)]); sum += c; cnt += (c > 0u) ? 1u : 0u; mine = (j == x) ? c : mine; }
        if (sum == G) break;
        __builtin_amdgcn_s_sleep(1);
        if ((++sp & 255u) == 0u) { if (xb_ld(&bar[XB_TMO])) break; if (sp > XB_SPIN_CAP) { atomicAdd(&bar[XB_TMO], 1u); break; } }
    }
    nloc = mine > 0u ? mine : 1u; nx = cnt > 0u ? cnt : 1u;
}
__device__ __forceinline__ void xcd_barrier(const XcdBarrier& b) {
    asm volatile("s_waitcnt vmcnt(0)" ::: "memory");
    __syncthreads();
    if (threadIdx.x == 0) {
        unsigned* bar = b.bar;
        __builtin_amdgcn_s_waitcnt(0);
        unsigned nloc = b.st[0], nx = b.st[1];
        if (nloc == 0u) { xcd_barrier_complete(bar, b.x, nloc, nx); b.st[0] = nloc; b.st[1] = nx; }
        const unsigned old = xb_add(&bar[XB_XSUB(b.x)], 1u);
        const unsigned gen = old / nloc;
        if (old + 1u == (gen + 1u) * nloc) {
            __builtin_amdgcn_fence(__ATOMIC_RELEASE, "agent");
            asm volatile("s_waitcnt vmcnt(0)" ::: "memory");
            const unsigned og = xb_add(&bar[XB_TOP], 1u);
            const unsigned tg = og / nx;
            if (og + 1u == (tg + 1u) * nx) xb_add(&bar[XB_TOPGEN], 1u);
            else XB_SPIN(xb_ld(&bar[XB_TOPGEN]) == tg, bar);
            __builtin_amdgcn_fence(__ATOMIC_ACQUIRE, "agent");
            xb_add(&bar[XB_XGEN(b.x)], 1u);
            asm volatile("s_waitcnt vmcnt(0)" ::: "memory");
        } else {
            XB_SPIN(xb_ld(&bar[XB_XGEN(b.x)]) == gen, bar);
            __builtin_amdgcn_fence(__ATOMIC_ACQUIRE, "agent");
            asm volatile("s_waitcnt vmcnt(0)" ::: "memory");
        }
    }
    __syncthreads();
}

namespace pg8 {
constexpr int BM = 256, BK = 64, HALF = 128, HTB = HALF * BK * 2, STAGE_BYTES = 8 * HTB, NXCD = 8, WGM = 2;
static_assert(STAGE_BYTES == RING_BYTES, "stage region");
__host__ __device__ __forceinline__ int lds_byte(int r, int c) { const int st = (r >> 4) * 2 + (c >> 5), rr = r & 15, cc = c & 31, ob = rr * 64 + cc * 2; return st * 1024 + (ob ^ (((ob >> 9) & 1) << 5)); }
__host__ __device__ __forceinline__ void stage_rc(int b, int& R, int& C) { const int st = b / 1024, sb = b % 1024, swz = sb ^ (((sb >> 9) & 1) << 5); R = (st >> 1) * 16 + swz / 64; C = (st & 1) * 32 + (swz % 64) / 2; }
__host__ __device__ __forceinline__ int perm32(int rho) { const int n = rho >> 4, i = rho & 15; return 8 * (i >> 2) + 4 * n + (i & 3); }

struct Unit { int pm, pn, ord, e, cnt; };

struct StaticOrder {
    int nM, nN, nwg, G, c;
    __device__ void init(int M, int N, int G_, int c_) { nM = M / BM; nN = N / BM; nwg = nM * nN; G = G_; c = c_; }
    __device__ bool next(int i, int& pm, int& pn) const {
        const long L = (long)i * G + c; if (L >= nwg) return false;
        int wgid = (int)L; { const int q = nwg / NXCD, r = nwg % NXCD, xcd = wgid % NXCD, off = wgid / NXCD; wgid = (xcd < r ? xcd * (q + 1) : r * (q + 1) + (xcd - r) * q) + off; }
        const int nig = WGM * nN, gid = wgid / nig, fm = gid * WGM, gsz = (nM - fm) < WGM ? (nM - fm) : WGM;
        pm = fm + ((wgid % nig) % gsz); pn = (wgid % nig) / gsz; return true;
    }
};

typedef int v8i32 __attribute__((ext_vector_type(8)));
template <class Epi, class Prob, bool F8 = false, int KREP = 1, int EPI_REP = 1>
__device__ __forceinline__ void gemm_phase(LAS unsigned char* lds, const Prob& S, const Epi& E) {
    const int tid = threadIdx.x, wid = __builtin_amdgcn_readfirstlane(tid >> 6), lane = tid & 63, wr = wid >> 2, wc = wid & 3, fr = lane & 15, fq = lane >> 4;
    const int KB = S.KB, ntr = KB / 128, nt = ntr * KREP, kmask = ntr - 1;
    int Rr[2], Cc[2]; unsigned voffB[2][2];
#pragma unroll
    for (int i = 0; i < 2; ++i) { stage_rc(tid * 16 + i * 8192, Rr[i], Cc[i]);
#pragma unroll
        for (int h = 0; h < 2; ++h) { const int R = Rr[i], ii = R & 15, Rb = 64 * (R >> 5) + 16 * (ii >> 2) + 8 * h + 4 * ((R >> 4) & 1) + (ii & 3); voffB[h][i] = (unsigned)(Rb * KB + Cc[i] * 2); } }
    const size_t kstep = (size_t)(BK * 2);
    const size_t hstep = (size_t)HALF * KB;
    const unsigned ldsw = (unsigned)wid * 1024u;
    const int aoff = lds_byte(wr * 64 + fr, fq * 8), boff = lds_byte(wc * 32 + fr, fq * 8);
    const int aoff8a = lds_byte(wr * 64 + fr, fq * 16), aoff8b = lds_byte(wr * 64 + fr, fq * 16 + 8), boff8a = lds_byte(wc * 32 + fr, fq * 16), boff8b = lds_byte(wc * 32 + fr, fq * 16 + 8);
#define PG8_SA(b, h) (((b) * 2 + (h)) * HTB)
#define PG8_SB(b, h) ((4 + (b) * 2 + (h)) * HTB)
#define PG8_STAGE_X(bufoff, gbase, voff, aux) do { _Pragma("unroll") for (int _i = 0; _i < 2; ++_i) \
        __builtin_amdgcn_global_load_lds((const unsigned*)((const char*)(gbase) + (voff)[_i]), (LAS unsigned*)(lds + (bufoff) + ldsw + _i * 8192), 16, 0, aux); } while (0)
#define PG8_STAGE(bufoff, gbase, voff) do { if constexpr (((bufoff) < 4 * HTB) && Prob::A_NT) PG8_STAGE_X(bufoff, gbase, voff, 2); else PG8_STAGE_X(bufoff, gbase, voff, 0); } while (0)
#define PG8_LDA_(dst, b, h) do { _Pragma("unroll") for (int m = 0; m < 4; ++m) _Pragma("unroll") for (int k = 0; k < 2; ++k) dst[m][k] = *(const LAS bf16x8*)(lds + PG8_SA(b, h) + aoff + m * 2048 + k * 1024); } while (0)
#define PG8_LDB_(dst, b, h) do { _Pragma("unroll") for (int n = 0; n < 2; ++n) _Pragma("unroll") for (int k = 0; k < 2; ++k) dst[n][k] = *(const LAS bf16x8*)(lds + PG8_SB(b, h) + boff + n * 2048 + k * 1024); } while (0)
#define PG8_LD8(dst, pa, pb) do { const u32x4 _lo = *(const LAS u32x4*)(pa), _hi = *(const LAS u32x4*)(pb); dst = __builtin_bit_cast(v8i32, __builtin_shufflevector(_lo, _hi, 0, 1, 2, 3, 4, 5, 6, 7)); } while (0)
#define PG8_LDA8(dst, b, h) do { _Pragma("unroll") for (int m = 0; m < 4; ++m) PG8_LD8(dst[m], lds + PG8_SA(b, h) + aoff8a + m * 2048, lds + PG8_SA(b, h) + aoff8b + m * 2048); } while (0)
#define PG8_LDB8(dst, b, h) do { _Pragma("unroll") for (int n = 0; n < 2; ++n) PG8_LD8(dst[n], lds + PG8_SB(b, h) + boff8a + n * 2048, lds + PG8_SB(b, h) + boff8b + n * 2048); } while (0)
#define PG8_LDA(dst, b, h) do { if constexpr (F8) PG8_LDA8(dst##8, b, h); else PG8_LDA_(dst, b, h); } while (0)
#define PG8_LDB(dst, b, h) do { if constexpr (F8) PG8_LDB8(dst##8, b, h); else PG8_LDB_(dst, b, h); } while (0)
#define PG8_MFMA8(c, b8, a8) asm volatile("s_nop 1\n\tv_mfma_f32_16x16x128_f8f6f4 %0, %1, %2, %0" : "+v"(c) : "v"(b8), "v"(a8))
#define PG8_MMA(ai, bj, At, Bt) do { __builtin_amdgcn_s_setprio(1); _Pragma("unroll") for (int m = 0; m < 4; ++m) _Pragma("unroll") for (int n = 0; n < 2; ++n) { \
        if constexpr (F8) PG8_MFMA8(acc[ai][bj][m][n], Bt##8[n], At##8[m]); \
        else { _Pragma("unroll") for (int k = 0; k < 2; ++k) acc[ai][bj][m][n] = __builtin_amdgcn_mfma_f32_16x16x32_bf16(Bt[n][k], At[m][k], acc[ai][bj][m][n], 0, 0, 0); } } __builtin_amdgcn_s_setprio(0); } while (0)
#define PG8_WAIT_V(n) asm volatile("s_waitcnt vmcnt(" #n ")" ::: "memory")
#define PG8_WAIT_L(n) asm volatile("s_waitcnt lgkmcnt(" #n ")" ::: "memory")
#define PG8_BAR __builtin_amdgcn_s_barrier()
#define PG8_SCHED __builtin_amdgcn_sched_barrier(0)
    Unit cur, nxt; int ui = 0;
    if (!S.next(0, cur)) return;
    if (STAGGER_TICKS > 0) {
        const unsigned long long t0 = __builtin_amdgcn_s_memrealtime(), dl = (unsigned long long)(((blockIdx.x >> 3) & 15) * STAGGER_TICKS);
        while (__builtin_amdgcn_s_memrealtime() - t0 < dl) __builtin_amdgcn_s_sleep(4);
    }
    f32x4 acc[2][2][4][2];
    E.init(acc, cur, wr, wc, fr, fq);
    bf16x8 At[4][2], B0[2][2], B1[2][2];
    v8i32 At8[4], B08[2], B18[2];
    unsigned vc[2][2], vn[2][2];
    S.a_voff(cur, Rr, Cc, vc);
    const char* cA = S.a_base(cur); const char* cB = S.b_base(cur);
    PG8_STAGE(PG8_SB(0, 0), cB, voffB[0]); PG8_STAGE(PG8_SB(0, 1), cB, voffB[1]); PG8_STAGE(PG8_SA(0, 0), cA, vc[0]); PG8_STAGE(PG8_SA(0, 1), cA, vc[1]);
    if (wr == 1) PG8_BAR;
    PG8_WAIT_V(2); PG8_BAR;
    PG8_STAGE(PG8_SB(1, 0), cB + kstep, voffB[0]); PG8_STAGE(PG8_SA(1, 0), cA + kstep, vc[0]); PG8_STAGE(PG8_SB(1, 1), cB + kstep, voffB[1]);
    PG8_WAIT_V(6); PG8_BAR;
    for (;;) {
        const bool has_next = S.next(ui + 1, nxt);
        const char* nA = has_next ? S.a_base(nxt) : cA; const char* nB = has_next ? S.b_base(nxt) : cB;
        if (has_next) S.a_voff(nxt, Rr, Cc, vn); else { vn[0][0] = vc[0][0]; vn[0][1] = vc[0][1]; vn[1][0] = vc[1][0]; vn[1][1] = vc[1][1]; }
        for (int t = 0; t < nt; t += 2) {
            const bool last = (t == nt - 2);
            const int t1 = (KREP == 1) ? t + 1 : ((t + 1) & kmask), t2 = (KREP == 1) ? t + 2 : ((t + 2) & kmask);
            const char* a1 = cA + (size_t)t1 * kstep;
            const char* a2 = last ? nA : cA + (size_t)t2 * kstep; const char* b2 = last ? nB : cB + (size_t)t2 * kstep;
            const char* a3 = a2 + kstep; const char* b3 = b2 + kstep;
            unsigned w0[2], w1[2]; w0[0] = last ? vn[0][0] : vc[0][0]; w0[1] = last ? vn[0][1] : vc[0][1]; w1[0] = last ? vn[1][0] : vc[1][0]; w1[1] = last ? vn[1][1] : vc[1][1];
            PG8_LDB(B0, 0, 0); PG8_LDB(B1, 0, 1); PG8_SCHED; PG8_LDA(At, 0, 0); PG8_STAGE(PG8_SA(1, 1), a1, vc[1]);
            PG8_WAIT_V(8); PG8_WAIT_L(0); PG8_BAR; PG8_MMA(0, 0, At, B0); PG8_MMA(0, 1, At, B1); PG8_BAR; PG8_SCHED;
            PG8_LDA(At, 0, 1); PG8_STAGE(PG8_SB(0, 0), b2, voffB[0]); PG8_STAGE(PG8_SB(0, 1), b2, voffB[1]); PG8_STAGE(PG8_SA(0, 0), a2, w0);
            PG8_WAIT_V(8); PG8_WAIT_L(0); PG8_BAR; PG8_MMA(1, 0, At, B0); PG8_MMA(1, 1, At, B1); PG8_BAR; PG8_SCHED;
            PG8_LDB(B0, 1, 0); PG8_LDB(B1, 1, 1); PG8_SCHED; PG8_LDA(At, 1, 0); PG8_STAGE(PG8_SA(0, 1), a2, w1);
            PG8_WAIT_V(8); PG8_WAIT_L(0); PG8_BAR; PG8_MMA(0, 0, At, B0); PG8_MMA(0, 1, At, B1); PG8_BAR; PG8_SCHED;
            PG8_LDA(At, 1, 1); PG8_STAGE(PG8_SB(1, 0), b3, voffB[0]); PG8_STAGE(PG8_SB(1, 1), b3, voffB[1]); PG8_STAGE(PG8_SA(1, 0), a3, w0);
            PG8_WAIT_V(8); PG8_WAIT_L(0); PG8_BAR; PG8_MMA(1, 0, At, B0); PG8_MMA(1, 1, At, B1); PG8_BAR; PG8_SCHED;
        }
        if (wr == 0) PG8_BAR;
        if constexpr (F8) asm volatile("s_nop 15\n\ts_nop 7" ::: "memory");
#pragma unroll
        for (int er = 0; er < EPI_REP; ++er) E(acc, cur, wr, wc, fr, fq);
        if (!has_next) break;
        E.init(acc, nxt, wr, wc, fr, fq);
        cur = nxt; cA = nA; cB = nB; ++ui;
        vc[0][0] = vn[0][0]; vc[0][1] = vn[0][1]; vc[1][0] = vn[1][0]; vc[1][1] = vn[1][1];
        if (wr == 1) PG8_BAR;
    }
    PG8_WAIT_V(0);
    PG8_BAR;
#undef PG8_SA
#undef PG8_SB
#undef PG8_STAGE
#undef PG8_STAGE_X
#undef PG8_LDA
#undef PG8_LDB
#undef PG8_MMA
#undef PG8_MFMA8
#undef PG8_LDA_
#undef PG8_LDB_
#undef PG8_LD8
#undef PG8_LDA8
#undef PG8_LDB8
#undef PG8_WAIT_V
#undef PG8_WAIT_L
#undef PG8_BAR
#undef PG8_SCHED
}

struct DenseProb {
    static constexpr bool A_NT = DENSE_A_NT;
    const char* A; const char* Bt; int ldaB, KB, acolB;
    StaticOrder so;
    __device__ __forceinline__ bool next(int i, Unit& u) const { u.ord = i; u.e = 0; u.cnt = 256; return so.next(i, u.pm, u.pn); }
    __device__ __forceinline__ const char* a_base(const Unit& u) const { return A + (size_t)u.pm * BM * ldaB + (size_t)u.pn * acolB; }
    __device__ __forceinline__ const char* b_base(const Unit& u) const { return Bt + (size_t)u.pn * BM * KB; }
    __device__ __forceinline__ void a_voff(const Unit&, const int (&R)[2], const int (&C)[2], unsigned (&vo)[2][2]) const {
#pragma unroll
        for (int h = 0; h < 2; ++h)
#pragma unroll
            for (int i = 0; i < 2; ++i) vo[h][i] = (unsigned)((h * HALF + R[i]) * ldaB + C[i] * 2);
    }
};

struct MoeProb {
    static constexpr bool A_NT = false;
    const char* A; const char* Bt; int ldaB, KB, nN, shift;
    LAS const int* tab;
    LAS const int* expt;
    int G, c;
    __device__ __forceinline__ bool next(int i, Unit& u) const {
        const int per = G >> 3, xcd = c & 7, rank = c >> 3;
        if (expt[70]) {
            const int e = xcd + 8 * (rank >> 3), sub = rank & 7, cnt = expt[33 + e], T = (cnt + 255) >> 8;
            const int pn = (nN == 8) ? sub : (sub & 3), pm = (nN == 8) ? i : 2 * i + (sub >> 2);
            if (pm >= T || i >= TAB_UNITS) return false;
            u.e = e; u.pn = pn; u.pm = pm; u.ord = i; u.cnt = cnt - pm * 256; return true;
        }
        const int L = (i * 8 + xcd) * per + rank;
        if (L >= expt[32] || i >= TAB_UNITS) return false;
        int e = 0;
#pragma unroll 1
        while (e < 31 && L >= expt[e + 1]) ++e;
        const int q = L - expt[e], cnt = expt[33 + e], T = (cnt + 255) >> 8;
        u.e = e; u.pn = q / T; u.pm = q % T; u.ord = i; u.cnt = cnt - u.pm * 256; return true;
    }
    __device__ __forceinline__ const char* a_base(const Unit&) const { return A; }
    __device__ __forceinline__ const char* b_base(const Unit& u) const { return Bt + ((size_t)u.e * nN + u.pn) * BM * KB; }
    __device__ __forceinline__ void a_voff(const Unit& u, const int (&R)[2], const int (&C)[2], unsigned (&vo)[2][2]) const {
#pragma unroll
        for (int h = 0; h < 2; ++h)
#pragma unroll
            for (int i = 0; i < 2; ++i) { const unsigned row = ((unsigned)tab[u.ord * 256 + h * HALF + R[i]] & 0x7fffffffu) >> shift; vo[h][i] = row * (unsigned)ldaB + (unsigned)C[i] * 2u; }
    }
};

struct EpiBf16 {
    bf16_t* O; int ldc, cbase; float scale;
    __device__ __forceinline__ void init(f32x4 (&acc)[2][2][4][2], const Unit&, int, int, int, int) const {
#pragma unroll
        for (int a = 0; a < 2; ++a)
#pragma unroll
            for (int b = 0; b < 2; ++b)
#pragma unroll
                for (int m = 0; m < 4; ++m)
#pragma unroll
                    for (int n = 0; n < 2; ++n) acc[a][b][m][n] = (f32x4){0.f, 0.f, 0.f, 0.f};
    }
    __device__ __forceinline__ void operator()(const f32x4 (&acc)[2][2][4][2], const Unit& u, int wr, int wc, int fr, int fq) const {
        const int row0 = u.pm * BM + wr * 64 + fr, col0 = cbase + u.pn * BM + wc * 64 + 16 * fq;
#pragma unroll
        for (int ai = 0; ai < 2; ++ai)
#pragma unroll
            for (int m = 0; m < 4; ++m) { bf16_t* rowp = O + (size_t)(row0 + ai * HALF + m * 16) * ldc + col0;
#pragma unroll
                for (int bj = 0; bj < 2; ++bj) { const f32x4 v0 = acc[ai][bj][m][0] * scale, v1 = acc[ai][bj][m][1] * scale;
                    u32x4 w; w.x = cvt_pk_bf16(v0[0], v0[1]); w.y = cvt_pk_bf16(v0[2], v0[3]); w.z = cvt_pk_bf16(v1[0], v1[1]); w.w = cvt_pk_bf16(v1[2], v1[3]);
                    *(u32x4*)(rowp + bj * 8) = w; } }
    }
};
struct EpiResBf16 {
    const float* rms; bf16_t* O; int ldc; unsigned char* O8;
    __device__ __forceinline__ void init(f32x4 (&acc)[2][2][4][2], const Unit& u, int wr, int wc, int fr, int fq) const {
        const int row0 = u.pm * BM + wr * 64 + fr, col0 = u.pn * BM + wc * 64 + 16 * fq;
        u32x4 raw[2][4][2]; float rs[2][4];
#pragma unroll
        for (int ai = 0; ai < 2; ++ai)
#pragma unroll
            for (int m = 0; m < 4; ++m) { const int row = row0 + ai * HALF + m * 16; rs[ai][m] = rms[row];
#pragma unroll
                for (int bj = 0; bj < 2; ++bj) raw[ai][m][bj] = *(const GAS u32x4*)(O + (size_t)row * ldc + col0 + bj * 8); }
#pragma unroll
        for (int ai = 0; ai < 2; ++ai)
#pragma unroll
            for (int m = 0; m < 4; ++m)
#pragma unroll
                for (int bj = 0; bj < 2; ++bj) { const u32x4 w = raw[ai][m][bj]; const float r = rs[ai][m];
                    acc[ai][bj][m][0] = (f32x4){bflo(w.x) * r, bfhi(w.x) * r, bflo(w.y) * r, bfhi(w.y) * r};
                    acc[ai][bj][m][1] = (f32x4){bflo(w.z) * r, bfhi(w.z) * r, bflo(w.w) * r, bfhi(w.w) * r}; }
    }
    __device__ __forceinline__ void operator()(const f32x4 (&acc)[2][2][4][2], const Unit& u, int wr, int wc, int fr, int fq) const {
        const int row0 = u.pm * BM + wr * 64 + fr, col0 = u.pn * BM + wc * 64 + 16 * fq;
#pragma unroll
        for (int ai = 0; ai < 2; ++ai)
#pragma unroll
            for (int m = 0; m < 4; ++m) { bf16_t* rowp = O + (size_t)(row0 + ai * HALF + m * 16) * ldc + col0;
#pragma unroll
                for (int bj = 0; bj < 2; ++bj) { const f32x4 v0 = acc[ai][bj][m][0], v1 = acc[ai][bj][m][1];
                    u32x4 w; w.x = cvt_pk_bf16(v0[0], v0[1]); w.y = cvt_pk_bf16(v0[2], v0[3]); w.z = cvt_pk_bf16(v1[0], v1[1]); w.w = cvt_pk_bf16(v1[2], v1[3]);
                    *(u32x4*)(rowp + bj * 8) = w; } }
    }
};
struct EpiSwiGLU {
    unsigned char* act; LAS const int* tab; LAS const float* tabr; LAS const float* tabg;
    __device__ __forceinline__ void init(f32x4 (&acc)[2][2][4][2], const Unit&, int, int, int, int) const {
#pragma unroll
        for (int a = 0; a < 2; ++a)
#pragma unroll
            for (int b = 0; b < 2; ++b)
#pragma unroll
                for (int m = 0; m < 4; ++m)
#pragma unroll
                    for (int n = 0; n < 2; ++n) acc[a][b][m][n] = (f32x4){0.f, 0.f, 0.f, 0.f};
    }
    __device__ __forceinline__ void operator()(const f32x4 (&acc)[2][2][4][2], const Unit& u, int wr, int wc, int fr, int fq) const {
        const int col0 = u.pn * HALF + wc * 32 + 8 * fq;
#pragma unroll
        for (int ai = 0; ai < 2; ++ai)
#pragma unroll
            for (int m = 0; m < 4; ++m) { const int rl = ai * HALF + wr * 64 + m * 16 + fr; const int a = tab[u.ord * 256 + rl];
                const float r = tabr[u.ord * 256 + rl], rg = tabg[u.ord * 256 + rl];
                if (a >= 0) { float o[8];
#pragma unroll
                    for (int n = 0; n < 2; ++n)
#pragma unroll
                        for (int j = 0; j < 4; ++j) { const float g = acc[ai][0][m][n][j] * r; o[n * 4 + j] = g * __builtin_amdgcn_rcpf(1.0f + __builtin_amdgcn_exp2f(g * -1.4426950408889634f)) * (acc[ai][1][m][n][j] * rg); }
                    u32x2 w; w.x = pk4_fp8(o[0], o[1], o[2], o[3]); w.y = pk4_fp8(o[4], o[5], o[6], o[7]);
                    *(u32x2*)(act + (size_t)a * DEXP + col0) = w; } }
    }
};
struct EpiScatterF8 {
    unsigned char* Y; int ldc; LAS const int* tab; float scale;
    __device__ __forceinline__ void init(f32x4 (&acc)[2][2][4][2], const Unit&, int, int, int, int) const {
#pragma unroll
        for (int a = 0; a < 2; ++a)
#pragma unroll
            for (int b = 0; b < 2; ++b)
#pragma unroll
                for (int m = 0; m < 4; ++m)
#pragma unroll
                    for (int n = 0; n < 2; ++n) acc[a][b][m][n] = (f32x4){0.f, 0.f, 0.f, 0.f};
    }
    __device__ __forceinline__ void operator()(const f32x4 (&acc)[2][2][4][2], const Unit& u, int wr, int wc, int fr, int fq) const {
        const int col0 = u.pn * BM + wc * 64 + 16 * fq;
#pragma unroll
        for (int ai = 0; ai < 2; ++ai)
#pragma unroll
            for (int m = 0; m < 4; ++m) { const int rl = ai * HALF + wr * 64 + m * 16 + fr; const int a = tab[u.ord * 256 + rl];
                if (a >= 0) { const f32x4 v0 = acc[ai][0][m][0] * scale, v1 = acc[ai][0][m][1] * scale, v2 = acc[ai][1][m][0] * scale, v3 = acc[ai][1][m][1] * scale;
                    u32x4 w; w.x = pk4_fp8(v0[0], v0[1], v0[2], v0[3]); w.y = pk4_fp8(v1[0], v1[1], v1[2], v1[3]); w.z = pk4_fp8(v2[0], v2[1], v2[2], v2[3]); w.w = pk4_fp8(v3[0], v3[1], v3[2], v3[3]);
                    *(u32x4*)(Y + (size_t)a * ldc + col0) = w; } }
    }
};
}

struct Frame {
    LAS unsigned char* lds;
    gu32* ctl;
    int tid, lane, wave, G, bx;
    const float *x, *norm_mix, *w_in, *q_norm, *k_norm, *sinks, *w_pool, *pool_scale, *w_out, *norm_ffn, *w_coarse, *b_coarse, *w_fine, *b_fine, *w_gate, *w_up, *w_down;
    float* out;
    float *rope, *rinv, *rtok, *gate;
    bf16_t *Wr, *Wpool, *Win, *Wout, *XB, *PROJ, *MIXED, *DPOOL, *Y;
    unsigned char *Wgu8, *Wd8, *H8, *ACT8;
    int* rowl;
};

__device__ __forceinline__ void tr_item(const float* W, int N, int k0, int n0, bf16_t* dst0, int Kd, const float* gk, const float* gn, LAS float* scr, int lane) {
    const int kk0 = lane >> 3, n4 = (lane & 7) * 4;
    f32x4 v[8];
#pragma unroll
    for (int i = 0; i < 8; ++i) v[i] = *(const GAS f32x4*)(W + (size_t)(k0 + 8 * i + kk0) * N + n0 + n4);
    f32x4 sn = (f32x4){1.f, 1.f, 1.f, 1.f}; if (gn) sn = *(const GAS f32x4*)(gn + n0 + n4);
#pragma unroll
    for (int i = 0; i < 8; ++i) { const float g = gk ? gk[k0 + 8 * i + kk0] : 1.0f; const f32x4 w = v[i] * sn * g; LAS float* d = scr + (8 * i + kk0) * 33 + n4; d[0] = w.x; d[1] = w.y; d[2] = w.z; d[3] = w.w; }
    LDS_WAIT(); asm volatile("" ::: "memory");
    const int c = lane & 7;
#pragma unroll
    for (int j = 0; j < 4; ++j) { const int n = (lane >> 3) + 8 * j; const LAS float* s = scr + (8 * c) * 33 + n;
        u32x4 o; o.x = pk2(s[0 * 33], s[1 * 33]); o.y = pk2(s[2 * 33], s[3 * 33]); o.z = pk2(s[4 * 33], s[5 * 33]); o.w = pk2(s[6 * 33], s[7 * 33]);
        *(GAS u32x4*)(dst0 + (size_t)n * Kd + k0 + 8 * c) = o; }
    LDS_WAIT(); asm volatile("" ::: "memory");
}

__device__ __forceinline__ void tr_item8(const float* W, int N, int k0, int n0, unsigned char* dst0, int Kd, const float* gk, LAS float* scr, int lane, int gu = 0) {
    const int kk0 = lane >> 3, n4 = (lane & 7) * 4;
    f32x4 v[8];
#pragma unroll
    for (int i = 0; i < 8; ++i) v[i] = *(const GAS f32x4*)(W + (size_t)(k0 + 8 * i + kk0) * N + n0 + n4);
#pragma unroll
    for (int i = 0; i < 8; ++i) { const float g = (gk ? gk[k0 + 8 * i + kk0] : 1.0f) * W8_SCALE; const f32x4 w = v[i] * g; LAS float* d = scr + (8 * i + kk0) * 33 + n4; d[0] = w.x; d[1] = w.y; d[2] = w.z; d[3] = w.w; }
    LDS_WAIT(); asm volatile("" ::: "memory");
    const int c = lane & 7;
#pragma unroll
    for (int j = 0; j < 4; ++j) { const int n = (lane >> 3) + 8 * j; const LAS float* s = scr + (8 * c) * 33 + n;
        u32x2 o; o.x = pk4_fp8(s[0 * 33], s[1 * 33], s[2 * 33], s[3 * 33]); o.y = pk4_fp8(s[4 * 33], s[5 * 33], s[6 * 33], s[7 * 33]);
        const int x = n0 + n, drow = gu ? (256 * (x >> 7) + 64 * ((x >> 5) & 3) + 16 * ((x >> 3) & 3) + 8 * (gu - 1) + (x & 7)) : n;
        *(GAS u32x2*)(dst0 + (size_t)drow * Kd + k0 + 8 * c) = o; }
    LDS_WAIT(); asm volatile("" ::: "memory");
}

__device__ __forceinline__ void wd_convert(Frame& F, int iw, int nwg) {
    LAS float* scr = (LAS float*)(F.lds + F.wave * 16384);
    constexpr int I_D = NEXP * (DEXP / 64) * (DM / 32);
    for (int r = iw * 8 + F.wave; r < I_D; r += nwg * 8) {
        const int per = (DEXP / 64) * (DM / 32), e = r / per, q = r % per, nb = DM / 32, kb = q / nb, nn = q % nb;
        tr_item8(F.w_down + (size_t)e * DEXP * DM, DM, 64 * kb, 32 * nn, F.Wd8 + ((size_t)e * DM + 32 * nn) * DEXP, DEXP, nullptr, scr, F.lane);
    }
}

__device__ __forceinline__ void p0_prologue(Frame& F) {
    const int gw = F.bx * 8 + F.wave, NGW = F.G * 8, gt = F.bx * 512 + F.tid, NGT = F.G * 512;
    LAS float* scr = (LAS float*)(F.lds + F.wave * 16384);
    for (int i = gt; i < SEQ * 8; i += NGT) {
        const int pos = i >> 3, j = i & 7;
        const double invf[8] = {1.0, 0.19392274474868576, 0.03760603093086393, 0.007292664737217109, 0.001414213562373095, 0.0002742481756762073, 5.318295896944988e-05, 1.031338537721246e-05};
        double f = invf[0];
#pragma unroll
        for (int q = 1; q < 8; ++q) f = (j == q) ? invf[q] : f;
        double s, c; sincos((double)pos * f, &s, &c);
        F.rope[pos * 16 + j] = (float)c; F.rope[pos * 16 + 8 + j] = (float)s;
    }
    for (int i = gt; i < 64 * DM; i += NGT) {
        const int j = i / DM, k = i % DM; float v = 0.f;
        if (j < 4) v = F.w_coarse[k * 4 + j] * F.norm_ffn[k]; else if (j < 36) v = F.w_fine[k * 32 + (j - 4)] * F.norm_ffn[k];
        const unsigned hi = f2bf(v); const float lo = v - bflo(hi);
        F.Wr[i] = (bf16_t)hi; F.Wr[64 * DM + i] = (bf16_t)f2bf(lo);
    }
    constexpr int I_IN = (DM / 64) * (INW / 32), I_OUT = (1024 / 64) * (DM / 32), I_POOL = 0, I_G = NEXP * (DM / 64) * (DEXP / 32);
    constexpr int NITEMS = I_IN + I_OUT + I_POOL + 2 * I_G;
    for (int it = gw; it < NITEMS; it += NGW) {
        int r = it;
        if (r < I_IN) { const int nb = INW / 32, kb = r / nb, nn = r % nb; tr_item(F.w_in, INW, 64 * kb, 32 * nn, F.Win + (size_t)(32 * nn) * DM, DM, F.norm_mix, nullptr, scr, F.lane); continue; } r -= I_IN;
        if (r < I_OUT) { const int nb = DM / 32, kb = r / nb, nn = r % nb; tr_item(F.w_out, DM, 64 * kb, 32 * nn, F.Wout + (size_t)(32 * nn) * DM, DM, nullptr, nullptr, scr, F.lane); continue; } r -= I_OUT;
        if (r < 2 * I_G) { const int up = r >= I_G; if (up) r -= I_G; const int per = (DM / 64) * (DEXP / 32), e = r / per, q = r % per, nb = DEXP / 32, kb = q / nb, nn = q % nb, n0 = 32 * nn;
            const float* W = (up ? F.w_up : F.w_gate) + (size_t)e * DM * DEXP;
            unsigned char* dst = F.Wgu8 + (size_t)e * 1024 * DM;
            tr_item8(W, DEXP, 64 * kb, n0, dst, DM, F.norm_ffn, scr, F.lane, up ? 2 : 1); continue; }
    }
    for (int wt = F.bx; wt < 256; wt += F.G) {
        const int pr = wt >> 3, g = pr >> 3, c0 = (pr & 7) * 32, n0 = ((wt & 7) * 8 + F.wave) * 32, i = F.lane & 31, kk = F.lane >> 5;
        LAS float* wp = (LAS float*)F.lds;
        __syncthreads();
        for (int e = F.tid; e < 32 * 256; e += 512) { const int c = e >> 8, j = e & 255; wp[c * 257 + j] = F.w_pool[(size_t)g * 65536 + (size_t)(c0 + c) * 256 + j] * F.pool_scale[g * 256 + j]; }
        __syncthreads();
        const float* ap = F.w_out + (size_t)(1024 + g * 256 + kk) * DM + n0 + i;
        const LAS float* bp = wp + i * 257 + kk;
        f32x16 acc = {};
#pragma unroll 16
        for (int j0 = 0; j0 < 256; j0 += 2) acc = __builtin_amdgcn_mfma_f32_32x32x2f32(ap[(size_t)j0 * DM], bp[j0], acc, 0, 0, 0);
        bf16_t* op = F.Wout + (size_t)n0 * DM + 1024 + g * 256 + c0 + i;
#pragma unroll
        for (int r = 0; r < 16; ++r) { const int nr = (r & 3) + 8 * (r >> 2) + 4 * kk; op[(size_t)nr * DM] = (bf16_t)f2bf(acc[r]); }
    }
    __syncthreads();
    for (int m = gw; m < NTOK; m += NGW) {
        const GAS f32x4* xr = (const GAS f32x4*)(F.x + (size_t)m * DM) + F.lane;
        f32x4 v[8]; float s = 0.f;
#pragma unroll
        for (int j = 0; j < 8; ++j) { v[j] = xr[64 * j]; s += (v[j].x * v[j].x + v[j].y * v[j].y) + (v[j].z * v[j].z + v[j].w * v[j].w); }
        s = wave_sum(s);
        const float rms = sqrtf(s * (1.0f / DM) + EPS), rr = 1.0f / rms;
        if (F.lane == 0) F.rinv[m] = rms;
        GAS u32x2* o8 = (GAS u32x2*)(F.XB + (size_t)m * DM) + F.lane;
#pragma unroll
        for (int j = 0; j < 8; ++j) { u32x2 w; w.x = pk2(v[j].x * rr, v[j].y * rr); w.y = pk2(v[j].z * rr, v[j].w * rr); o8[64 * j] = w; }
    }
}

struct PoolSt { int it; float S[8]; bool active; };
struct PoolGeo { const bf16_t* up; bf16_t* dp; int w, pos0; };
__device__ __forceinline__ PoolGeo pool_geo(const Frame& F, int it) {
    const int ri = it >> 7, c8 = it & 127, t0 = ri * 32; PoolGeo g;
    g.w = 2 << (c8 >> 5); g.pos0 = t0 & (SEQ - 1); g.up = F.PROJ + (size_t)t0 * INW + UOFF + c8 * 8; g.dp = F.MIXED + (size_t)t0 * DM + 1024 + c8 * 8; return g;
}
__device__ __forceinline__ void pool_begin(Frame& F, int it, PoolSt& ps) {
    const int NITEM = (NTOK / 32) * 128;
    ps.active = it < NITEM; ps.it = ps.active ? it : 0;
    const PoolGeo g = pool_geo(F, ps.it);
#pragma unroll
    for (int j = 0; j < 8; ++j) ps.S[j] = 0.f;
    for (int i0 = 1; i0 < g.w; i0 += 5) { u32x4 pr[5];
#pragma unroll
        for (int q = 0; q < 5; ++q) { const int i = i0 + q; pr[q] = (u32x4){0u, 0u, 0u, 0u}; if (i < g.w && g.pos0 - i >= 0) pr[q] = *(const GAS u32x4*)(g.up - (ptrdiff_t)i * INW); }
#pragma unroll
        for (int q = 0; q < 5; ++q) { const u32x4 raw = pr[q];
            ps.S[0] += bflo(raw.x); ps.S[1] += bfhi(raw.x); ps.S[2] += bflo(raw.y); ps.S[3] += bfhi(raw.y); ps.S[4] += bflo(raw.z); ps.S[5] += bfhi(raw.z); ps.S[6] += bflo(raw.w); ps.S[7] += bfhi(raw.w); } }
}
__device__ __forceinline__ void pool_issue(const Frame& F, const PoolSt& ps, int k, u32x4 (&nw)[4]) {
    const PoolGeo g = pool_geo(F, ps.it);
#pragma unroll
    for (int q = 0; q < 4; ++q) nw[q] = *(const GAS u32x4*)(g.up + (ptrdiff_t)(4 * k + q) * INW);
}
__device__ __forceinline__ void pool_finish(const Frame& F, PoolSt& ps, int k, const u32x4 (&nw)[4]) {
    const PoolGeo g = pool_geo(F, ps.it);
    u32x4 od[4];
#pragma unroll
    for (int q = 0; q < 4; ++q) { const int t = 4 * k + q; const int to = t - g.w + 1, toc = (g.pos0 + to >= 0) ? to : t;
        od[q] = *(const GAS u32x4*)(g.up + (ptrdiff_t)toc * INW); }
#pragma unroll
    for (int q = 0; q < 4; ++q) { const int t = 4 * k + q; const u32x4 raw = nw[q]; const bool has_old = g.pos0 + t - g.w + 1 >= 0;
        const u32x4 old = has_old ? od[q] : (u32x4){0u, 0u, 0u, 0u};
        const float xv[8] = {bflo(raw.x), bfhi(raw.x), bflo(raw.y), bfhi(raw.y), bflo(raw.z), bfhi(raw.z), bflo(raw.w), bfhi(raw.w)};
        const int pos = g.pos0 + t; const float ic = __builtin_amdgcn_rcpf((float)((pos + 1 < g.w) ? (pos + 1) : g.w));
        float d[8];
#pragma unroll
        for (int j = 0; j < 8; ++j) { ps.S[j] += xv[j]; d[j] = ps.S[j] * ic - xv[j]; }
        u32x4 o; o.x = pk2(d[0], d[1]); o.y = pk2(d[2], d[3]); o.z = pk2(d[4], d[5]); o.w = pk2(d[6], d[7]);
        *(GAS u32x4*)(g.dp + (size_t)t * DM) = o;
        ps.S[0] -= bflo(old.x); ps.S[1] -= bfhi(old.x); ps.S[2] -= bflo(old.y); ps.S[3] -= bfhi(old.y); ps.S[4] -= bflo(old.z); ps.S[5] -= bfhi(old.z); ps.S[6] -= bflo(old.w); ps.S[7] -= bfhi(old.w); }
}

constexpr int AT_K = 0, AT_V = 32768, AT_VSTR = 520, AT_UNIT = 32768 + 64 * 520;
static_assert(2 * AT_UNIT <= EXPT_OFF, "attention LDS");
__device__ __forceinline__ void attn_super(Frame& F, int b, int n, int kp, PoolSt& ps, int step0) {
    LAS unsigned char* lds = F.lds;
    const int tid = F.tid, lane = F.lane, wid = F.wave;
    const size_t tok0 = (size_t)b * SEQ;
    const int g = wid & 3, ql = lane & 31, hi = lane >> 5;
    u32x4 qc[4], qn[4];
    { const int head = (2 * kp) * 4 + g, s0 = wid >> 2; const bf16_t* qp = F.PROJ + (tok0 + n * 128 + 32 * s0 + ql) * INW + QOFF + head * HD + hi * 8;
#pragma unroll
      for (int d0 = 0; d0 < 4; ++d0) qc[d0] = *(const GAS u32x4*)(qp + d0 * 16); }
    u32x4 kraw[2][4], vraw[2][2][2];
#pragma unroll
    for (int j = 0; j < 2; ++j) { const int kvh = 2 * kp + j;
#pragma unroll
        for (int i = 0; i < 4; ++i) { const int idx = i * 512 + tid, row = idx >> 3, c = idx & 7, pos = n * 128 - 128 + row, pc = pos < 0 ? 0 : pos;
            kraw[j][i] = *(const GAS u32x4*)(F.PROJ + (tok0 + pc) * INW + KOFF + kvh * HD + c * 8); }
#pragma unroll
        for (int i = 0; i < 2; ++i) { const int idx = i * 512 + tid, kpr = idx >> 3, c = idx & 7, pos = n * 128 - 128 + 2 * kpr, pc = pos < 0 ? 0 : pos;
            const bf16_t* p = F.PROJ + (tok0 + pc) * INW + VOFF + kvh * HD + c * 8; vraw[j][i][0] = *(const GAS u32x4*)p; vraw[j][i][1] = *(const GAS u32x4*)(p + INW); } }
    float kn[8];
#pragma unroll
    for (int q = 0; q < 8; ++q) kn[q] = F.k_norm[(tid & 7) * 8 + q];
#pragma unroll
    for (int j = 0; j < 2; ++j) {
#pragma unroll
        for (int i = 0; i < 4; ++i) {
            const int idx = i * 512 + tid, row = idx >> 3, c = idx & 7, pos = n * 128 - 128 + row;
            const u32x4 raw = kraw[j][i];
            float xv[8] = {bflo(raw.x), bfhi(raw.x), bflo(raw.y), bfhi(raw.y), bflo(raw.z), bfhi(raw.z), bflo(raw.w), bfhi(raw.w)};
            float ss = 0.f;
#pragma unroll
            for (int q = 0; q < 8; ++q) ss += xv[q] * xv[q];
            ss += __shfl_xor(ss, 1); ss += __shfl_xor(ss, 2); ss += __shfl_xor(ss, 4);
            const float rn = __builtin_amdgcn_rsqf(ss * (1.0f / HD) + EPS);
#pragma unroll
            for (int q = 0; q < 8; ++q) xv[q] = xv[q] * rn * kn[q];
            const int pp = pos >= 0 ? pos : 0;
            f32x4 cs4[2] = {(f32x4){1.f, 1.f, 1.f, 1.f}, (f32x4){1.f, 1.f, 1.f, 1.f}}, sn4[2] = {(f32x4){0.f, 0.f, 0.f, 0.f}, (f32x4){0.f, 0.f, 0.f, 0.f}};
            if (c < 2) { const GAS f32x4* rp = (const GAS f32x4*)(F.rope + pp * 16); cs4[0] = rp[0]; cs4[1] = rp[1]; sn4[0] = rp[2]; sn4[1] = rp[3]; }
#pragma unroll
            for (int q = 0; q < 8; ++q) { const float pr = __shfl_xor(xv[q], 1); const float cs = cs4[q >> 2][q & 3], sn = sn4[q >> 2][q & 3];
                const float r0 = xv[q] * cs - pr * sn, r1 = xv[q] * cs + pr * sn; xv[q] = (c == 0) ? r0 : (c == 1) ? r1 : xv[q]; }
            u32x4 w; w.x = pk2(xv[0], xv[1]); w.y = pk2(xv[2], xv[3]); w.z = pk2(xv[4], xv[5]); w.w = pk2(xv[6], xv[7]);
            *(LAS u32x4*)(lds + j * AT_UNIT + AT_K + row * 128 + ((c ^ (row & 7)) * 16)) = w;
        }
#pragma unroll
        for (int i = 0; i < 2; ++i) {
            const int idx = i * 512 + tid, kpr = idx >> 3, c = idx & 7;
            const u32x4 r0 = vraw[j][i][0], r1 = vraw[j][i][1];
            const unsigned a0[4] = {r0.x, r0.y, r0.z, r0.w}, a1[4] = {r1.x, r1.y, r1.z, r1.w};
#pragma unroll
            for (int q = 0; q < 4; ++q) {
                const unsigned lo = (a0[q] & 0xffffu) | (a1[q] << 16), hi2 = (a0[q] >> 16) | (a1[q] & 0xffff0000u);
                *(LAS unsigned*)(lds + j * AT_UNIT + AT_V + (c * 8 + 2 * q) * AT_VSTR + kpr * 4) = lo;
                *(LAS unsigned*)(lds + j * AT_UNIT + AT_V + (c * 8 + 2 * q + 1) * AT_VSTR + kpr * 4) = hi2;
            }
        }
    }
    __syncthreads();
    const float SC = 0.125f * 1.4426950408889634f;
    float cbound;
    { float gq = fabsf(F.q_norm[lane]), gk = fabsf(F.k_norm[lane]);
#pragma unroll
      for (int o = 1; o < 64; o <<= 1) { gq = fmaxf(gq, __shfl_xor(gq, o)); gk = fmaxf(gk, __shfl_xor(gk, o)); }
      cbound = 64.0f * SC * gq * gk * 1.02f; }
    const bf16x8 ones8 = {(short)0x3F80, (short)0x3F80, (short)0x3F80, (short)0x3F80, (short)0x3F80, (short)0x3F80, (short)0x3F80, (short)0x3F80};
#pragma unroll 1
    for (int item = 0; item < 4; ++item) {
        const int j = item >> 1, s = (wid >> 2) + 2 * (item & 1), head = (2 * kp + j) * 4 + g;
        const int qpos = n * 128 + 32 * s + ql;
        const int kbase = j * AT_UNIT + AT_K, vbase = j * AT_UNIT + AT_V;
        if (item < 3) {
            const int jn = (item + 1) >> 1, sn = (wid >> 2) + 2 * ((item + 1) & 1), hn = (2 * kp + jn) * 4 + g;
            const bf16_t* qp = F.PROJ + (tok0 + n * 128 + 32 * sn + ql) * INW + QOFF + hn * HD + hi * 8;
#pragma unroll
            for (int d0 = 0; d0 < 4; ++d0) qn[d0] = *(const GAS u32x4*)(qp + d0 * 16);
        }
        const float sink2 = F.sinks[head] * 1.4426950408889634f;
        float qv[4][8];
        float ss = 0.f;
#pragma unroll
        for (int d0 = 0; d0 < 4; ++d0) { const u32x4 raw = qc[d0];
            qv[d0][0] = bflo(raw.x); qv[d0][1] = bfhi(raw.x); qv[d0][2] = bflo(raw.y); qv[d0][3] = bfhi(raw.y); qv[d0][4] = bflo(raw.z); qv[d0][5] = bfhi(raw.z); qv[d0][6] = bflo(raw.w); qv[d0][7] = bfhi(raw.w);
#pragma unroll
            for (int q = 0; q < 8; ++q) ss += qv[d0][q] * qv[d0][q]; }
        ss += __shfl_xor(ss, 32);
        const float rn = SC * __builtin_amdgcn_rsqf(ss * (1.0f / HD) + EPS);
#pragma unroll
        for (int d0 = 0; d0 < 4; ++d0) { const GAS f32x4* gp = (const GAS f32x4*)(F.q_norm + d0 * 16 + hi * 8); const f32x4 g0 = gp[0], g1 = gp[1];
            const float gq[8] = {g0.x, g0.y, g0.z, g0.w, g1.x, g1.y, g1.z, g1.w};
#pragma unroll
            for (int q = 0; q < 8; ++q) qv[d0][q] = qv[d0][q] * rn * gq[q]; }
        { const GAS f32x4* rp = (const GAS f32x4*)(F.rope + qpos * 16); const f32x4 c0 = rp[0], c1 = rp[1], s0 = rp[2], s1 = rp[3];
          const float cs8[8] = {c0.x, c0.y, c0.z, c0.w, c1.x, c1.y, c1.z, c1.w}, sn8[8] = {s0.x, s0.y, s0.z, s0.w, s1.x, s1.y, s1.z, s1.w};
#pragma unroll
          for (int q = 0; q < 8; ++q) { const float pr = __shfl_xor(qv[0][q], 32);
              qv[0][q] = (hi == 0) ? (qv[0][q] * cs8[q] - pr * sn8[q]) : (qv[0][q] * cs8[q] + pr * sn8[q]); } }
        bf16x8 qr[4];
#pragma unroll
        for (int d0 = 0; d0 < 4; ++d0) { u32x4 w; w.x = pk2(qv[d0][0], qv[d0][1]); w.y = pk2(qv[d0][2], qv[d0][3]); w.z = pk2(qv[d0][4], qv[d0][5]); w.w = pk2(qv[d0][6], qv[d0][7]);
            qr[d0] = __builtin_bit_cast(bf16x8, w); }
        const float mref = fmaxf(cbound, sink2);
        f32x16 p[5];
#pragma unroll
        for (int jt = 0; jt < 5; ++jt) {
            const int krow = 32 * (s + jt) + ql;
            f32x16 a;
#pragma unroll
            for (int r = 0; r < 16; ++r) a[r] = -mref;
#pragma unroll
            for (int d0 = 0; d0 < 4; ++d0) { const int c = 2 * d0 + hi;
                const bf16x8 kf = *(const LAS bf16x8*)(lds + kbase + krow * 128 + ((c ^ (krow & 7)) * 16));
                a = __builtin_amdgcn_mfma_f32_32x32x16_bf16(kf, qr[d0], a, 0, 0, 0); }
            p[jt] = a;
        }
#pragma unroll
        for (int jt = 0; jt < 5; ++jt)
#pragma unroll
            for (int r = 0; r < 16; ++r) p[jt][r] = __builtin_amdgcn_exp2f(p[jt][r]);
#pragma unroll
        for (int r = 0; r < 16; ++r) { const int kl = (r & 3) + 8 * (r >> 2) + 4 * hi;
            p[0][r] = (kl > ql) ? p[0][r] : 0.f; p[4][r] = (kl <= ql) ? p[4][r] : 0.f; }
        if (n == 0) {
#pragma unroll
            for (int jt = 0; jt < 4; ++jt) if (s + jt < 4) {
#pragma unroll
                for (int r = 0; r < 16; ++r) p[jt][r] = 0.f; }
        }
        u32x4 pnw[4]; const int pstep = step0 + item; const bool pdo = ps.active && pstep < 8;
        __builtin_amdgcn_sched_barrier(0); if (pdo) pool_issue(F, ps, pstep, pnw); __builtin_amdgcn_sched_barrier(0);
        f32x16 o[2]; o[0] = f32x16{}; o[1] = f32x16{}; f32x16 sacc = f32x16{};
#pragma unroll
        for (int jt = 0; jt < 5; ++jt)
#pragma unroll
            for (int s2 = 0; s2 < 2; ++s2) {
                u32x4 pw; pw.x = cvt_pk_bf16(p[jt][8 * s2 + 0], p[jt][8 * s2 + 1]); pw.y = cvt_pk_bf16(p[jt][8 * s2 + 2], p[jt][8 * s2 + 3]);
                pw.z = cvt_pk_bf16(p[jt][8 * s2 + 4], p[jt][8 * s2 + 5]); pw.w = cvt_pk_bf16(p[jt][8 * s2 + 6], p[jt][8 * s2 + 7]);
                const bf16x8 pf = __builtin_bit_cast(bf16x8, pw);
                const int kb = 32 * (s + jt) + 16 * s2 + 4 * hi;
#pragma unroll
                for (int dt = 0; dt < 2; ++dt) {
                    const LAS unsigned char* vp = lds + vbase + (dt * 32 + ql) * AT_VSTR + kb * 2;
                    const u32x2 v0 = *(const LAS u32x2*)vp, v1 = *(const LAS u32x2*)(vp + 16);
                    u32x4 vw; vw.x = v0.x; vw.y = v0.y; vw.z = v1.x; vw.w = v1.y;
                    o[dt] = __builtin_amdgcn_mfma_f32_32x32x16_bf16(__builtin_bit_cast(bf16x8, vw), pf, o[dt], 0, 0, 0);
                }
                sacc = __builtin_amdgcn_mfma_f32_32x32x16_bf16(ones8, pf, sacc, 0, 0, 0);
            }
        const float inv = __builtin_amdgcn_rcpf(sacc[0] + __builtin_amdgcn_exp2f(sink2 - mref));
        bf16_t* op = F.MIXED + (tok0 + qpos) * DM + head * HD + (hi ? 8 : 0);
#pragma unroll
        for (int dt = 0; dt < 2; ++dt)
#pragma unroll
            for (int gp = 0; gp < 2; ++gp) {
                const int r0 = 8 * gp;
                unsigned ax = cvt_pk_bf16(o[dt][r0 + 0] * inv, o[dt][r0 + 1] * inv), ay = cvt_pk_bf16(o[dt][r0 + 2] * inv, o[dt][r0 + 3] * inv);
                unsigned bx = cvt_pk_bf16(o[dt][r0 + 4] * inv, o[dt][r0 + 5] * inv), by = cvt_pk_bf16(o[dt][r0 + 6] * inv, o[dt][r0 + 7] * inv);
                { auto rr = __builtin_amdgcn_permlane32_swap(ax, bx, false, false); ax = rr[0]; bx = rr[1]; }
                { auto rr = __builtin_amdgcn_permlane32_swap(ay, by, false, false); ay = rr[0]; by = rr[1]; }
                u32x4 w; w.x = ax; w.y = ay; w.z = bx; w.w = by;
                *(GAS u32x4*)(op + dt * 32 + 16 * gp) = w;
            }
        if (pdo) pool_finish(F, ps, pstep, pnw);
#pragma unroll
        for (int d0 = 0; d0 < 4; ++d0) qc[d0] = qn[d0];
    }
    __syncthreads();
}

__device__ __forceinline__ void pool_diff(Frame& F, int first_it) {
    const int NITEM = (NTOK / 32) * 128;
    for (int it = first_it; it < NITEM; it += F.G * 512) {
        const int ri = it >> 7, c8 = it & 127, w = 2 << (c8 >> 5), t0 = ri * 32, pos0 = t0 & (SEQ - 1);
        const bf16_t* up = F.PROJ + (size_t)t0 * INW + UOFF + c8 * 8;
        float S[8];
#pragma unroll
        for (int j = 0; j < 8; ++j) S[j] = 0.f;
        for (int i0 = 1; i0 < w; i0 += 5) { u32x4 pr[5];
#pragma unroll
            for (int q = 0; q < 5; ++q) { const int i = i0 + q; pr[q] = (u32x4){0u, 0u, 0u, 0u}; if (i < w && pos0 - i >= 0) pr[q] = *(const GAS u32x4*)(up - (ptrdiff_t)i * INW); }
#pragma unroll
            for (int q = 0; q < 5; ++q) { const u32x4 raw = pr[q];
                S[0] += bflo(raw.x); S[1] += bfhi(raw.x); S[2] += bflo(raw.y); S[3] += bfhi(raw.y); S[4] += bflo(raw.z); S[5] += bfhi(raw.z); S[6] += bflo(raw.w); S[7] += bfhi(raw.w); } }
#pragma unroll 1
        for (int tc = 0; tc < 32; tc += 8) {
            u32x4 nw[8], od[8];
#pragma unroll
            for (int q = 0; q < 8; ++q) { const int t = tc + q; nw[q] = *(const GAS u32x4*)(up + (ptrdiff_t)t * INW);
                od[q] = (u32x4){0u, 0u, 0u, 0u}; if (pos0 + t - w + 1 >= 0) od[q] = *(const GAS u32x4*)(up + (ptrdiff_t)(t - w + 1) * INW); }
#pragma unroll
            for (int q = 0; q < 8; ++q) { const int t = tc + q; const u32x4 raw = nw[q], old = od[q];
                const float xv[8] = {bflo(raw.x), bfhi(raw.x), bflo(raw.y), bfhi(raw.y), bflo(raw.z), bfhi(raw.z), bflo(raw.w), bfhi(raw.w)};
                const int pos = pos0 + t; const float ic = 1.0f / (float)((pos + 1 < w) ? (pos + 1) : w);
                float d[8];
#pragma unroll
                for (int j = 0; j < 8; ++j) { S[j] += xv[j]; d[j] = S[j] * ic - xv[j]; }
                u32x4 o; o.x = pk2(d[0], d[1]); o.y = pk2(d[2], d[3]); o.z = pk2(d[4], d[5]); o.w = pk2(d[6], d[7]);
                *(GAS u32x4*)(F.MIXED + (size_t)(t0 + t) * DM + 1024 + c8 * 8) = o;
                S[0] -= bflo(old.x); S[1] -= bfhi(old.x); S[2] -= bflo(old.y); S[3] -= bfhi(old.y); S[4] -= bflo(old.z); S[5] -= bfhi(old.z); S[6] -= bflo(old.w); S[7] -= bfhi(old.w); }
        }
    }
}

constexpr int RT_WSTR = 528, RT_W = 0, RT_WLO = 64 * RT_WSTR, RT_L = 2 * 64 * RT_WSTR, RT_LSTR = 65;
__device__ __forceinline__ void route_phase(Frame& F, bool dry) {
    LAS unsigned char* lds = F.lds;
    const int tid = F.tid, lane = F.lane, wid = F.wave, row = lane & 15, kq = lane >> 4;
    for (int tile = F.bx; tile < NTOK / 128; tile += F.G) {
        const int t0 = tile * 128 + wid * 16;
        const bf16_t* hp = F.XB + (size_t)(t0 + row) * DM + kq * 8;
        unsigned char* h8 = F.H8 + (size_t)(t0 + row) * DM + kq * 8;
        f32x4 acc[4]; acc[0] = acc[1] = acc[2] = acc[3] = (f32x4){0.f, 0.f, 0.f, 0.f};
        float ssq = 0.f;
        u32x4 hv[8]; u32x4 wv[8];
#pragma unroll
        for (int ks = 0; ks < 8; ++ks) hv[ks] = *(const GAS u32x4*)(hp + ks * 32);
#pragma unroll
        for (int i = 0; i < 8; ++i) { const int p = i * 512 + tid, which = p >> 11, col = (p & 2047) >> 5, ch = p & 31;
            wv[i] = *(const GAS u32x4*)(F.Wr + (size_t)which * 64 * DM + (size_t)col * DM + ch * 8); }
#pragma unroll 1
        for (int kc = 0; kc < 8; ++kc) {
            __syncthreads();
#pragma unroll
            for (int i = 0; i < 8; ++i) { const int p = i * 512 + tid, which = p >> 11, col = (p & 2047) >> 5, ch = p & 31;
                *(LAS u32x4*)(lds + which * RT_WLO + col * RT_WSTR + ch * 16) = wv[i]; }
            __syncthreads();
            if (kc < 7) {
#pragma unroll
                for (int i = 0; i < 8; ++i) { const int p = i * 512 + tid, which = p >> 11, col = (p & 2047) >> 5, ch = p & 31;
                    wv[i] = *(const GAS u32x4*)(F.Wr + (size_t)which * 64 * DM + (size_t)col * DM + (kc + 1) * 256 + ch * 8); } }
#pragma unroll
            for (int ks = 0; ks < 8; ++ks) {
                const int k = kc * 256 + ks * 32;
                const u32x4 ah = hv[ks];
                if (kc < 7) hv[ks] = *(const GAS u32x4*)(hp + k + 256);
                { const float a0 = bflo(ah.x), a1 = bfhi(ah.x), a2 = bflo(ah.y), a3 = bfhi(ah.y), a4 = bflo(ah.z), a5 = bfhi(ah.z), a6 = bflo(ah.w), a7 = bfhi(ah.w);
                  ssq += (a0 * a0 + a1 * a1) + (a2 * a2 + a3 * a3) + (a4 * a4 + a5 * a5) + (a6 * a6 + a7 * a7);
                  u32x2 w8; w8.x = pk4_fp8(a0, a1, a2, a3); w8.y = pk4_fp8(a4, a5, a6, a7); *(GAS u32x2*)(h8 + k) = w8; }
                const bf16x8 Ah = __builtin_bit_cast(bf16x8, ah);
#pragma unroll
                for (int tc = 0; tc < 4; ++tc) {
                    const LAS unsigned char* bp = lds + (tc * 16 + row) * RT_WSTR + (ks * 32 + kq * 8) * 2;
                    const bf16x8 Bh = *(const LAS bf16x8*)bp, Bl = *(const LAS bf16x8*)(bp + RT_WLO);
                    acc[tc] = __builtin_amdgcn_mfma_f32_16x16x32_bf16(Ah, Bh, acc[tc], 0, 0, 0);
                    acc[tc] = __builtin_amdgcn_mfma_f32_16x16x32_bf16(Ah, Bl, acc[tc], 0, 0, 0);
                }
            }
        }
        ssq += __shfl_xor(ssq, 16); ssq += __shfl_xor(ssq, 32);
        const float rt = 1.0f / sqrtf(ssq * (1.0f / DM) + EPS);
        LAS float* L = (LAS float*)(lds + RT_L) + wid * 16 * RT_LSTR;
#pragma unroll
        for (int tc = 0; tc < 4; ++tc)
#pragma unroll
            for (int r = 0; r < 4; ++r) L[(kq * 4 + r) * RT_LSTR + tc * 16 + row] = acc[tc][r];
        LAS unsigned* lcnt = (LAS unsigned*)(lds + RT_L + 8 * 16 * RT_LSTR * 4); LAS unsigned* lbase = lcnt + NEXP;
        if (tid < NEXP) lcnt[tid] = 0u;
        __syncthreads();
        int me1 = 0, me2 = 0; unsigned r1 = 0u, r2 = 0u;
        if (lane < 16) {
            const int t = t0 + lane; const LAS float* Lt = L + lane * RT_LSTR;
            float c[4]; int grp = 0; float cm;
#pragma unroll
            for (int j = 0; j < 4; ++j) c[j] = Lt[j] * rt + F.b_coarse[j];
            cm = c[0];
#pragma unroll
            for (int j = 1; j < 4; ++j) if (c[j] > cm) { cm = c[j]; grp = j; }
            float den = 0.f;
#pragma unroll
            for (int j = 0; j < 4; ++j) den += __expf(c[j] - cm);
            const float pg = 1.0f / den;
            float f[8];
#pragma unroll
            for (int j = 0; j < 8; ++j) f[j] = Lt[4 + grp * 8 + j] * rt + F.b_fine[grp * 8 + j];
            int i1 = 0; float l1 = f[0];
#pragma unroll
            for (int j = 1; j < 8; ++j) if (f[j] > l1) { l1 = f[j]; i1 = j; }
            int i2 = -1; float l2 = -3.0e38f;
#pragma unroll
            for (int j = 0; j < 8; ++j) if (j != i1 && f[j] > l2) { l2 = f[j]; i2 = j; }
            const float e2 = __expf(l2 - l1), g1 = pg / (1.0f + e2), g2 = pg * e2 / (1.0f + e2);
            F.rtok[t] = rt; F.gate[2 * t] = g1; F.gate[2 * t + 1] = g2;
            me1 = grp * 8 + i1; me2 = grp * 8 + i2;
            r1 = __hip_atomic_fetch_add(&lcnt[me1], 1u, __ATOMIC_RELAXED, __HIP_MEMORY_SCOPE_WORKGROUP);
            r2 = __hip_atomic_fetch_add(&lcnt[me2], 1u, __ATOMIC_RELAXED, __HIP_MEMORY_SCOPE_WORKGROUP);
        }
        __syncthreads();
        if (tid < NEXP) { const unsigned c = lcnt[tid]; unsigned base = 0u;
            if (c && !dry) base = __hip_atomic_fetch_add((unsigned*)(F.ctl + CW_CNT + 64 * tid), c, RLX_AGENT);
            lbase[tid] = base; }
        __syncthreads();
        if (lane < 16 && !dry) { const int t = t0 + lane;
            F.rowl[(size_t)me1 * RCAP + lbase[me1] + r1] = 2 * t;
            F.rowl[(size_t)me2 * RCAP + lbase[me2] + r2] = 2 * t + 1; }
    }
}

__device__ __forceinline__ void moe_setup(Frame& F, int nN, bool with_rg) {
    LAS int* expt = (LAS int*)(F.lds + EXPT_OFF); LAS int* tab = (LAS int*)(F.lds + TAB_OFF); LAS float* tabr = (LAS float*)(F.lds + TABR_OFF); LAS float* tabg = (LAS float*)(F.lds + TABG_OFF);
    __syncthreads();
    if (F.tid < NEXP) expt[33 + F.tid] = (int)__hip_atomic_load((unsigned*)(F.ctl + CW_CNT + 64 * F.tid), RLX_AGENT);
    __syncthreads();
    if (F.tid == 0) { int acc = 0, maxT = 0;
        for (int e = 0; e < NEXP; ++e) { const int T = (expt[33 + e] + 255) >> 8; expt[e] = acc; acc += T * nN; maxT = T > maxT ? T : maxT; }
        expt[32] = acc; expt[70] = (MOE_OWNER && F.G == 256 && maxT <= 12) ? 1 : 0; expt[71] = maxT; }
    __syncthreads();
    pg8::MoeProb P; P.expt = expt; P.nN = nN; P.G = F.G; P.c = F.bx;
    pg8::Unit u;
    int nu = 0; while (P.next(nu, u)) ++nu;
    constexpr int KMAX = (TAB_UNITS * 256 + 511) / 512;
    int v[KMAX]; bool ok[KMAX];
#pragma unroll
    for (int k = 0; k < KMAX; ++k) { const int idx = F.tid + k * 512, i = idx >> 8, r = idx & 255; v[k] = 0; ok[k] = false;
        if (i < nu) { P.next(i, u); const int j = u.pm * 256 + r, cnt = expt[33 + u.e]; ok[k] = j < cnt; v[k] = F.rowl[(size_t)u.e * RCAP + (ok[k] ? j : 0)]; } }
#pragma unroll
    for (int k = 0; k < KMAX; ++k) { const int idx = F.tid + k * 512, i = idx >> 8; if (i < nu) tab[idx] = ok[k] ? v[k] : (v[k] | (int)0x80000000); }
    if (with_rg) {
        float rr[KMAX], gg[KMAX];
#pragma unroll
        for (int k = 0; k < KMAX; ++k) { const int idx = F.tid + k * 512, i = idx >> 8; rr[k] = 0.f; gg[k] = 0.f; if (i < nu && i < TABRG_UNITS) { rr[k] = F.rtok[v[k] >> 1]; gg[k] = F.gate[v[k]]; } }
#pragma unroll
        for (int k = 0; k < KMAX; ++k) { const int idx = F.tid + k * 512, i = idx >> 8; if (i < nu && i < TABRG_UNITS) { const float r = rr[k] * (1.0f / W8_SCALE); tabr[idx] = r; tabg[idx] = r * gg[k] * ACT8_SCALE; } }
    }
    __syncthreads();
}

__device__ __forceinline__ void combine_phase(Frame& F, float* dst) {
    const size_t NIT = (size_t)NTOK * (DM / 8), stride = (size_t)F.G * 512;
    const unsigned char* Y8 = (const unsigned char*)F.Y;
    constexpr float IS = 1.0f / Y8_SCALE;
    for (size_t it0 = (size_t)F.bx * 512 + F.tid; it0 < NIT; it0 += 4 * stride) {
        u32x4 h[4]; u32x2 y0[4], y1[4];
#pragma unroll
        for (int q = 0; q < 4; ++q) { const size_t it = it0 + q * stride; if (it < NIT) { const size_t t = it >> 8; const int c = (int)(it & 255) * 8;
            h[q] = *(const GAS u32x4*)(F.XB + t * DM + c); y0[q] = *(const GAS u32x2*)(Y8 + (2 * t) * DM + c); y1[q] = *(const GAS u32x2*)(Y8 + (2 * t + 1) * DM + c); } }
#pragma unroll
        for (int q = 0; q < 4; ++q) { const size_t it = it0 + q * stride; if (it < NIT) { const size_t t = it >> 8; const int c = (int)(it & 255) * 8;
            float* wp = dst + t * DM + c; f32x4 o0, o1;
            const f32x2 a0 = __builtin_amdgcn_cvt_pk_f32_fp8((int)y0[q].x, false), a1 = __builtin_amdgcn_cvt_pk_f32_fp8((int)y0[q].x, true), a2 = __builtin_amdgcn_cvt_pk_f32_fp8((int)y0[q].y, false), a3 = __builtin_amdgcn_cvt_pk_f32_fp8((int)y0[q].y, true);
            const f32x2 b0 = __builtin_amdgcn_cvt_pk_f32_fp8((int)y1[q].x, false), b1 = __builtin_amdgcn_cvt_pk_f32_fp8((int)y1[q].x, true), b2 = __builtin_amdgcn_cvt_pk_f32_fp8((int)y1[q].y, false), b3 = __builtin_amdgcn_cvt_pk_f32_fp8((int)y1[q].y, true);
            o0.x = bflo(h[q].x) + (a0.x + b0.x) * IS; o0.y = bfhi(h[q].x) + (a0.y + b0.y) * IS; o0.z = bflo(h[q].y) + (a1.x + b1.x) * IS; o0.w = bfhi(h[q].y) + (a1.y + b1.y) * IS;
            o1.x = bflo(h[q].z) + (a2.x + b2.x) * IS; o1.y = bfhi(h[q].z) + (a2.y + b2.y) * IS; o1.z = bflo(h[q].w) + (a3.x + b3.x) * IS; o1.w = bfhi(h[q].w) + (a3.y + b3.y) * IS;
            *(GAS f32x4*)wp = o0; *(GAS f32x4*)(wp + 4) = o1; } }
    }
}

struct Args { const float* in[17]; float* out; unsigned char* ws; int ph_lo, ph_hi, use_bar, pad; };
__global__ void __launch_bounds__(512, 2) hymba_fwd(Args args) {
    extern __shared__ __attribute__((aligned(16))) unsigned char lds[];
    Frame F;
    F.lds = (LAS unsigned char*)lds;
    F.tid = threadIdx.x; F.lane = F.tid & 63; F.wave = __builtin_amdgcn_readfirstlane(F.tid >> 6);
    F.G = gridDim.x; F.bx = blockIdx.x;
    unsigned char* ws = args.ws;
    F.ctl = (gu32*)(ws + WS_CTL);
    F.x = args.in[0]; F.norm_mix = args.in[1]; F.w_in = args.in[2]; F.q_norm = args.in[3]; F.k_norm = args.in[4]; F.sinks = args.in[5]; F.w_pool = args.in[6]; F.pool_scale = args.in[7];
    F.w_out = args.in[8]; F.norm_ffn = args.in[9]; F.w_coarse = args.in[10]; F.b_coarse = args.in[11]; F.w_fine = args.in[12]; F.b_fine = args.in[13]; F.w_gate = args.in[14]; F.w_up = args.in[15]; F.w_down = args.in[16];
    F.out = args.out;
    F.rope = (float*)(ws + WS_ROPE); F.rinv = (float*)(ws + WS_RINV); F.rtok = (float*)(ws + WS_RTOK); F.gate = (float*)(ws + WS_GATE);
    F.Wr = (bf16_t*)(ws + WS_WR); F.Wpool = (bf16_t*)(ws + WS_WPOOL); F.Win = (bf16_t*)(ws + WS_WIN); F.Wout = (bf16_t*)(ws + WS_WOUT); F.Wgu8 = ws + WS_WGU; F.Wd8 = ws + WS_WD; F.H8 = ws + WS_H8; F.ACT8 = ws + WS_ACT8;
    F.XB = (bf16_t*)(ws + WS_XB); F.PROJ = (bf16_t*)(ws + WS_PROJ); F.MIXED = (bf16_t*)(ws + WS_MIXED); F.DPOOL = (bf16_t*)(ws + WS_DPOOL); F.Y = (bf16_t*)(ws + WS_Y);
    F.rowl = (int*)(ws + WS_ROWL);
    if (F.tid < 4) ((LAS unsigned*)(F.lds + MISC_OFF))[F.tid] = 0u;
    __syncthreads();
    XcdBarrier bar; bar.bar = (unsigned*)(F.ctl + CW_BAR); bar.x = 0; bar.st = nullptr;
    if (args.use_bar) bar = xcd_barrier_post((unsigned*)(F.ctl + CW_BAR), (volatile LAS unsigned*)(F.lds + MISC_OFF));
    const int lo = args.ph_lo, hi = args.ph_hi;
#ifndef PHASE_MASK
#define PHASE_MASK 0x1ff
#endif
#define IN(k) (((PHASE_MASK >> (k)) & 1) && lo <= (k) && (k) < hi)
#define SEAM(k) do { if (IN(k) && IN((k) + 1)) xcd_barrier(bar); } while (0)

#define REPS(k) ((PROBE_DUP == (k)) ? 2 : 1)
    if (IN(0)) { for (int rep = 0; rep < REPS(0); ++rep) { if (rep) xcd_barrier(bar); p0_prologue(F); } SEAM(0); }
    if (IN(1)) {
        for (int rep = 0; rep < REPS(1); ++rep) { if (rep) xcd_barrier(bar);
        pg8::DenseProb P; P.A = (const char*)F.XB; P.Bt = (const char*)F.Win; P.ldaB = DM * 2; P.KB = DM * 2; P.acolB = 0; P.so.init(NTOK, INW, F.G, F.bx);
        pg8::EpiBf16 E{F.PROJ, INW, 0, 1.0f};
        pg8::gemm_phase(F.lds, P, E); }
        SEAM(1);
    }
    if (IN(2)) {
#if PROBE_DUP == 2
        { PoolSt ps; pool_begin(F, F.bx * 512 + F.tid, ps); int pstep = 0;
#pragma unroll 1
          for (int u = F.bx; u < BATCH * (SEQ / 128) * (NKV / 2); u += F.G) { const int kp = u & 1, n = (u >> 1) & 31, b = u >> 6; attn_super(F, b, n, kp, ps, pstep); pstep += 4; }
          if (ps.active) for (; pstep < 8; ++pstep) { u32x4 a4[4]; pool_issue(F, ps, pstep, a4); pool_finish(F, ps, pstep, a4); } }
        xcd_barrier(bar);
#elif PROBE_DUP == 22
        pool_diff(F, F.bx * 512 + F.tid + F.G * 512);
        xcd_barrier(bar);
#endif
        { PoolSt ps; pool_begin(F, F.bx * 512 + F.tid, ps); int pstep = 0;
#pragma unroll 1
          for (int u = F.bx; u < BATCH * (SEQ / 128) * (NKV / 2); u += F.G) { const int kp = u & 1, n = (u >> 1) & 31, b = u >> 6; attn_super(F, b, n, kp, ps, pstep); pstep += 4; }
          if (ps.active) for (; pstep < 8; ++pstep) { u32x4 a4[4]; pool_issue(F, ps, pstep, a4); pool_finish(F, ps, pstep, a4); } }
        pool_diff(F, F.bx * 512 + F.tid + F.G * 512);
        SEAM(2);
    }
    if (IN(4)) {
        for (int rep = 0; rep < REPS(4); ++rep) { if (rep) xcd_barrier(bar);
        pg8::DenseProb P; P.A = (const char*)F.MIXED; P.Bt = (const char*)F.Wout; P.ldaB = DM * 2; P.KB = DM * 2; P.acolB = 0; P.so.init(NTOK, DM, F.G, F.bx);
        pg8::EpiResBf16 E{F.rinv, F.XB, DM, F.H8};
        pg8::gemm_phase(F.lds, P, E); }
        SEAM(4);
    }
    if (IN(5)) { for (int rep = 0; rep < REPS(5); ++rep) { if (rep) xcd_barrier(bar); route_phase(F, rep + 1 < REPS(5)); } SEAM(5); }
    if (IN(6)) {
        for (int rep = 0; rep < REPS(6); ++rep) { if (rep) xcd_barrier(bar);
        moe_setup(F, 4, true);
        pg8::MoeProb P; P.A = (const char*)F.H8; P.Bt = (const char*)F.Wgu8; P.ldaB = DM; P.KB = DM; P.nN = 4; P.shift = 1; P.tab = (LAS const int*)(F.lds + TAB_OFF); P.expt = (LAS const int*)(F.lds + EXPT_OFF); P.G = F.G; P.c = F.bx;
        pg8::EpiSwiGLU E{F.ACT8, (LAS const int*)(F.lds + TAB_OFF), (LAS const float*)(F.lds + TABR_OFF), (LAS const float*)(F.lds + TABG_OFF)};
        pg8::gemm_phase<pg8::EpiSwiGLU, pg8::MoeProb, true>(F.lds, P, E);
        if (rep == 0) {
            LAS int* ex = (LAS int*)(F.lds + EXPT_OFF);
            const int U = ex[32], per = F.G >> 3, q = (F.bx & 7) * per + (F.bx >> 3);
            if (ex[70]) {
                if (F.tid == 0) { const int maxnu = (ex[71] + 1) >> 1; int idx = -1, nidle = 0;
                    for (int c2 = 0; c2 < 256; ++c2) { const int e2 = (c2 & 7) + 8 * ((c2 >> 3) >> 3), par = ((c2 >> 3) & 7) >> 2, T2 = (ex[33 + e2] + 255) >> 8, nu2 = (T2 - par + 1) >> 1;
                        if (nu2 < maxnu) { if (c2 == F.bx) idx = nidle; ++nidle; } }
                    ex[72] = idx; ex[73] = nidle; }
                __syncthreads();
                const int idx = ex[72], nidle = ex[73];
                if (nidle == 0) wd_convert(F, q, F.G); else if (idx >= 0) wd_convert(F, idx, nidle);
            } else {
                const int rounds = (U + F.G - 1) / F.G, nb = U - (rounds - 1) * F.G;
                if (U <= 0 || nb >= F.G) wd_convert(F, q, F.G); else if (q >= nb) wd_convert(F, q - nb, F.G - nb);
            }
        } }
        SEAM(6);
    }
    if (IN(7)) {
        for (int rep = 0; rep < REPS(7); ++rep) { if (rep) xcd_barrier(bar);
        moe_setup(F, 8, false);
        pg8::MoeProb P; P.A = (const char*)F.ACT8; P.Bt = (const char*)F.Wd8; P.ldaB = DEXP; P.KB = DEXP; P.nN = 8; P.shift = 0; P.tab = (LAS const int*)(F.lds + TAB_OFF); P.expt = (LAS const int*)(F.lds + EXPT_OFF); P.G = F.G; P.c = F.bx;
        pg8::EpiScatterF8 E{(unsigned char*)F.Y, DM, (LAS const int*)(F.lds + TAB_OFF), Y8_SCALE / (W8_SCALE * ACT8_SCALE)};
        pg8::gemm_phase<pg8::EpiScatterF8, pg8::MoeProb, true, 1, PROBE_EPI2 ? 2 : 1>(F.lds, P, E); }
        SEAM(7);
    }
    if (IN(8)) { for (int rep = 0; rep < REPS(8); ++rep) { if (rep) xcd_barrier(bar); combine_phase(F, (rep + 1 < REPS(8)) ? (float*)(ws + WS_END) : F.out); } }
#undef REPS
#undef IN
#undef SEAM
}

extern "C" void kernel_launch(void* const* d_in, const int* in_sizes, int n_in, void* d_out, int out_size, void* d_ws, size_t ws_size, hipStream_t stream) {
    static int grid = 0;
    if (grid == 0) {
        if (n_in != 17 || out_size != NTOK * DM || ws_size < WS_END) { fprintf(stderr, "kernel_launch: unexpected problem (n_in %d, out %d, ws %zu)\n", n_in, out_size, ws_size); grid = -1; return; }
        int dev = 0, cus = 0;
        if (hipGetDevice(&dev) != hipSuccess || hipDeviceGetAttribute(&cus, hipDeviceAttributeMultiprocessorCount, dev) != hipSuccess) { grid = -1; return; }
        if (hipFuncSetAttribute((const void*)hymba_fwd, hipFuncAttributeMaxDynamicSharedMemorySize, LDS_BYTES) != hipSuccess) { fprintf(stderr, "kernel_launch: hipFuncSetAttribute failed\n"); grid = -1; return; }
        int per_cu = 0;
        if (hipOccupancyMaxActiveBlocksPerMultiprocessor(&per_cu, (const void*)hymba_fwd, 512, LDS_BYTES) != hipSuccess || per_cu < 1) { fprintf(stderr, "kernel_launch: occupancy query says %d\n", per_cu); }
        (void)hipGetLastError();
        grid = cus - (cus % 8);
        if (grid <= 0) grid = -1;
    }
    if (grid < 0) return;
    if (hipMemsetAsync((char*)d_ws + WS_CTL, 0, CTL_ZERO_BYTES, stream) != hipSuccess) return;
    Args a{};
    for (int i = 0; i < 17; ++i) a.in[i] = (const float*)d_in[i];
    a.out = (float*)d_out; a.ws = (unsigned char*)d_ws;
    if (MK_N_LAUNCHES == 1) { a.ph_lo = 0; a.ph_hi = NPHASE; a.use_bar = 1; hipLaunchKernelGGL(hymba_fwd, dim3(grid), dim3(512), LDS_BYTES, stream, a); }
    else for (int p = 0; p < NPHASE; ++p) { a.ph_lo = p; a.ph_hi = p + 1; a.use_bar = 0; hipLaunchKernelGGL(hymba_fwd, dim3(grid), dim3(512), LDS_BYTES, stream, a); }
}
```

```cpp
#include <hip/hip_runtime.h>
#include <cstdio>
#include <cstdint>

#ifndef MK_N_LAUNCHES
#define MK_N_LAUNCHES 1
#endif
#ifndef DENSE_A_NT
#define DENSE_A_NT false
#endif
#ifndef MOE_OWNER
#define MOE_OWNER 1
#endif
#ifndef STORE_AUX
#define STORE_AUX 0
#endif
#ifndef STAGGER_TICKS
#define STAGGER_TICKS 0
#endif
#ifndef PROBE_EPI2
#define PROBE_EPI2 0
#endif
#ifndef PROBE_K2
#define PROBE_K2 0
#endif
#ifndef PROBE_DUP
#define PROBE_DUP -1
#endif

#define GAS __attribute__((address_space(1)))
#define LAS __attribute__((address_space(3)))
typedef unsigned short bf16_t;
typedef short bf16x8 __attribute__((ext_vector_type(8)));
typedef short s16x4 __attribute__((ext_vector_type(4)));
typedef float f32x4 __attribute__((ext_vector_type(4)));
typedef float f32x2 __attribute__((ext_vector_type(2)));
typedef float f32x16 __attribute__((ext_vector_type(16)));
typedef unsigned u32x4 __attribute__((ext_vector_type(4)));
typedef unsigned u32x2 __attribute__((ext_vector_type(2)));
typedef GAS unsigned gu32;

constexpr int BATCH = 8, SEQ = 4096, NTOK = BATCH * SEQ, DM = 2048;
constexpr int NH = 16, NKV = 4, HD = 64, INW = 2560, QOFF = 0, KOFF = 1024, VOFF = 1280, UOFF = 1536, PW = 1024;
constexpr int NEXP = 32, DEXP = 512, NASG = NTOK * 2, RCAP = NASG;
constexpr float EPS = 1e-6f;
constexpr int NPHASE = 9;

constexpr size_t MiB = 1u << 20;
constexpr size_t WS_CTL = 0, CTL_ZERO_BYTES = 64 * 1024;
constexpr size_t WS_ROPE = 1 * MiB;
constexpr size_t WS_RINV = WS_ROPE + 256 * 1024;
constexpr size_t WS_RTOK = WS_RINV + 128 * 1024;
constexpr size_t WS_GATE = WS_RTOK + 128 * 1024;
constexpr size_t WS_WR = 2 * MiB;
constexpr size_t WS_WPOOL = WS_WR + 512 * 1024;
constexpr size_t WS_WIN = 3 * MiB;
constexpr size_t WS_WOUT = 13 * MiB;
constexpr size_t WS_ROWL = 21 * MiB;
constexpr size_t WS_WGU = 29 * MiB;
constexpr size_t WS_H8 = 93 * MiB;
constexpr size_t WS_WD = 157 * MiB;
constexpr size_t WS_ACT8 = 189 * MiB;
constexpr size_t WS_XB = 221 * MiB;
constexpr size_t WS_PROJ = 349 * MiB;
constexpr size_t WS_MIXED = 509 * MiB;
constexpr size_t WS_DPOOL = 637 * MiB;
constexpr size_t WS_ACT = WS_DPOOL;
constexpr size_t WS_Y = WS_PROJ;
constexpr size_t WS_END = 701 * MiB;
static_assert(WS_Y + (size_t)NASG * DM * 2 <= WS_DPOOL, "Y overlay");
constexpr int CW_TMO = 0, CW_BAR = 1024, CW_CNT = 8192;

constexpr int RING_BYTES = 131072;
constexpr int TAB_OFF = RING_BYTES;
constexpr int TAB_UNITS = 14, TABRG_UNITS = 6;
constexpr int TABR_OFF = TAB_OFF + TAB_UNITS * 1024;
constexpr int TABG_OFF = TABR_OFF + TABRG_UNITS * 1024;
constexpr int EXPT_OFF = TABG_OFF + TABRG_UNITS * 1024;
constexpr int MISC_OFF = EXPT_OFF + 512;
constexpr int LDS_BYTES = 159744;
static_assert(MISC_OFF + 16 <= LDS_BYTES, "LDS map");

#define RLX_AGENT __ATOMIC_RELAXED, __HIP_MEMORY_SCOPE_AGENT
#define LDS_WAIT() asm volatile("s_waitcnt lgkmcnt(0)" ::: "memory")
#define VM_WAIT() asm volatile("s_waitcnt vmcnt(0)" ::: "memory")

__device__ __forceinline__ unsigned f2bf(float f) { unsigned u = __builtin_bit_cast(unsigned, f); return (u + 0x7fffu + ((u >> 16) & 1u)) >> 16; }

__device__ __forceinline__ float bflo(unsigned w) { return __builtin_bit_cast(float, w << 16); }
__device__ __forceinline__ float bfhi(unsigned w) { return __builtin_bit_cast(float, w & 0xffff0000u); }
typedef __bf16 bf16x2_t __attribute__((ext_vector_type(2)));
__device__ __forceinline__ unsigned cvt_pk_bf16(float lo, float hi) { f32x2 v = {lo, hi}; bf16x2_t b = __builtin_convertvector(v, bf16x2_t); return __builtin_bit_cast(unsigned, b); }
__device__ __forceinline__ unsigned pk2(float lo, float hi) { return cvt_pk_bf16(lo, hi); }
__device__ __forceinline__ unsigned pk4_fp8(float a, float b, float c, float d) { int r = 0; r = __builtin_amdgcn_cvt_pk_fp8_f32(a, b, r, false); r = __builtin_amdgcn_cvt_pk_fp8_f32(c, d, r, true); return (unsigned)r; }
constexpr float W8_SCALE = 256.0f, ACT8_SCALE = 8.0f, Y8_SCALE = 32.0f;
__device__ __forceinline__ float wave_sum(float v) {
#pragma unroll
    for (int o = 1; o < 64; o <<= 1) v += __shfl_xor(v, o);
    return v;
}

#define XB_TMO      128
#define XB_XCNT(j)  (256  + 64 * (j))
#define XB_XSUB(j)  (1280 + 64 * (j))
#define XB_XGEN(j)  (2304 + 64 * (j))
#define XB_TOP      3328
#define XB_TOPGEN   3392
#define XCD_BAR_WORDS 3456
#define XB_SPIN_CAP (1u << 18)
__device__ __forceinline__ unsigned xb_ld(unsigned* p)              { return __hip_atomic_load(p, __ATOMIC_RELAXED, __HIP_MEMORY_SCOPE_AGENT); }
__device__ __forceinline__ unsigned xb_add(unsigned* p, unsigned v) { return __hip_atomic_fetch_add(p, v, __ATOMIC_RELAXED, __HIP_MEMORY_SCOPE_AGENT); }
__device__ __forceinline__ unsigned xb_xcc_id() { return (unsigned)__builtin_amdgcn_s_getreg((3 << 11) | 20) & 0xFu; }
#define XB_SPIN(cond, bar) do { unsigned _sp = 0; while (cond) { __builtin_amdgcn_s_sleep(1); \
    if ((++_sp & 255u) == 0u) { if (xb_ld(&(bar)[XB_TMO])) break; if (_sp > XB_SPIN_CAP) { atomicAdd(&(bar)[XB_TMO], 1u); break; } } } } while (0)
struct XcdBarrier { unsigned* bar; unsigned x; volatile LAS unsigned* st; };
__device__ __forceinline__ XcdBarrier xcd_barrier_post(unsigned* bar, volatile LAS unsigned* st) {
    XcdBarrier b; b.bar = bar; b.x = xb_xcc_id(); b.st = st;
    if (threadIdx.x == 0) (void)xb_add(&bar[XB_XCNT(b.x)], 1u);
    return b;
}
__device__ __forceinline__ void xcd_barrier_complete(unsigned* bar, unsigned x, unsigned& nloc, unsigned& nx) {
    const unsigned G = gridDim.x * gridDim.y * gridDim.z;
    unsigned sum, cnt, mine, sp = 0u;
    for (;;) {
        sum = 0u; cnt = 0u; mine = 0u;
#pragma unroll
        for (unsigned j = 0; j < 16; ++j) { const unsigned c = xb_ld(&bar[XB_XCNT(j)]); sum += c; cnt += (c > 0u) ? 1u : 0u; mine = (j == x) ? c : mine; }
        if (sum == G) break;
        __builtin_amdgcn_s_sleep(1);
        if ((++sp & 255u) == 0u) { if (xb_ld(&bar[XB_TMO])) break; if (sp > XB_SPIN_CAP) { atomicAdd(&bar[XB_TMO], 1u); break; } }
    }
    nloc = mine > 0u ? mine : 1u; nx = cnt > 0u ? cnt : 1u;
}
__device__ __forceinline__ void xcd_barrier(const XcdBarrier& b) {
    asm volatile("s_waitcnt vmcnt(0)" ::: "memory");
    __syncthreads();
    if (threadIdx.x == 0) {
        unsigned* bar = b.bar;
        __builtin_amdgcn_s_waitcnt(0);
        unsigned nloc = b.st[0], nx = b.st[1];
        if (nloc == 0u) { xcd_barrier_complete(bar, b.x, nloc, nx); b.st[0] = nloc; b.st[1] = nx; }
        const unsigned old = xb_add(&bar[XB_XSUB(b.x)], 1u);
        const unsigned gen = old / nloc;
        if (old + 1u == (gen + 1u) * nloc) {
            __builtin_amdgcn_fence(__ATOMIC_RELEASE, "agent");
            asm volatile("s_waitcnt vmcnt(0)" ::: "memory");
            const unsigned og = xb_add(&bar[XB_TOP], 1u);
            const unsigned tg = og / nx;
            if (og + 1u == (tg + 1u) * nx) xb_add(&bar[XB_TOPGEN], 1u);
            else XB_SPIN(xb_ld(&bar[XB_TOPGEN]) == tg, bar);
            __builtin_amdgcn_fence(__ATOMIC_ACQUIRE, "agent");
            xb_add(&bar[XB_XGEN(b.x)], 1u);
            asm volatile("s_waitcnt vmcnt(0)" ::: "memory");
        } else {
            XB_SPIN(xb_ld(&bar[XB_XGEN(b.x)]) == gen, bar);
            __builtin_amdgcn_fence(__ATOMIC_ACQUIRE, "agent");
            asm volatile("s_waitcnt vmcnt(0)" ::: "memory");
        }
    }
    __syncthreads();
}

namespace pg8 {
constexpr int BM = 256, BK = 64, HALF = 128, HTB = HALF * BK * 2, STAGE_BYTES = 8 * HTB, NXCD = 8, WGM = 2;
static_assert(STAGE_BYTES == RING_BYTES, "stage region");
__host__ __device__ __forceinline__ int lds_byte(int r, int c) { const int st = (r >> 4) * 2 + (c >> 5), rr = r & 15, cc = c & 31, ob = rr * 64 + cc * 2; return st * 1024 + (ob ^ (((ob >> 9) & 1) << 5)); }
__host__ __device__ __forceinline__ void stage_rc(int b, int& R, int& C) { const int st = b / 1024, sb = b % 1024, swz = sb ^ (((sb >> 9) & 1) << 5); R = (st >> 1) * 16 + swz / 64; C = (st & 1) * 32 + (swz % 64) / 2; }
__host__ __device__ __forceinline__ int perm32(int rho) { const int n = rho >> 4, i = rho & 15; return 8 * (i >> 2) + 4 * n + (i & 3); }

struct Unit { int pm, pn, ord, e, cnt; };

struct StaticOrder {
    int nM, nN, nwg, G, c;
    __device__ void init(int M, int N, int G_, int c_) { nM = M / BM; nN = N / BM; nwg = nM * nN; G = G_; c = c_; }
    __device__ bool next(int i, int& pm, int& pn) const {
        const long L = (long)i * G + c; if (L >= nwg) return false;
        int wgid = (int)L; { const int q = nwg / NXCD, r = nwg % NXCD, xcd = wgid % NXCD, off = wgid / NXCD; wgid = (xcd < r ? xcd * (q + 1) : r * (q + 1) + (xcd - r) * q) + off; }
        const int nig = WGM * nN, gid = wgid / nig, fm = gid * WGM, gsz = (nM - fm) < WGM ? (nM - fm) : WGM;
        pm = fm + ((wgid % nig) % gsz); pn = (wgid % nig) / gsz; return true;
    }
};

typedef int v8i32 __attribute__((ext_vector_type(8)));
template <class Epi, class Prob, bool F8 = false, int KREP = 1, int EPI_REP = 1>
__device__ __forceinline__ void gemm_phase(LAS unsigned char* lds, const Prob& S, const Epi& E) {
    const int tid = threadIdx.x, wid = __builtin_amdgcn_readfirstlane(tid >> 6), lane = tid & 63, wr = wid >> 2, wc = wid & 3, fr = lane & 15, fq = lane >> 4;
    const int KB = S.KB, ntr = KB / 128, nt = ntr * KREP, kmask = ntr - 1;
    int Rr[2], Cc[2]; unsigned voffB[2][2];
#pragma unroll
    for (int i = 0; i < 2; ++i) { stage_rc(tid * 16 + i * 8192, Rr[i], Cc[i]);
#pragma unroll
        for (int h = 0; h < 2; ++h) { const int R = Rr[i], ii = R & 15, Rb = 64 * (R >> 5) + 16 * (ii >> 2) + 8 * h + 4 * ((R >> 4) & 1) + (ii & 3); voffB[h][i] = (unsigned)(Rb * KB + Cc[i] * 2); } }
    const size_t kstep = (size_t)(BK * 2);
    const size_t hstep = (size_t)HALF * KB;
    const unsigned ldsw = (unsigned)wid * 1024u;
    const int aoff = lds_byte(wr * 64 + fr, fq * 8), boff = lds_byte(wc * 32 + fr, fq * 8);
    const int aoff8a = lds_byte(wr * 64 + fr, fq * 16), aoff8b = lds_byte(wr * 64 + fr, fq * 16 + 8), boff8a = lds_byte(wc * 32 + fr, fq * 16), boff8b = lds_byte(wc * 32 + fr, fq * 16 + 8);
#define PG8_SA(b, h) (((b) * 2 + (h)) * HTB)
#define PG8_SB(b, h) ((4 + (b) * 2 + (h)) * HTB)
#define PG8_STAGE_X(bufoff, gbase, voff, aux) do { _Pragma("unroll") for (int _i = 0; _i < 2; ++_i) \
        __builtin_amdgcn_global_load_lds((const unsigned*)((const char*)(gbase) + (voff)[_i]), (LAS unsigned*)(lds + (bufoff) + ldsw + _i * 8192), 16, 0, aux); } while (0)
#define PG8_STAGE(bufoff, gbase, voff) do { if constexpr (((bufoff) < 4 * HTB) && Prob::A_NT) PG8_STAGE_X(bufoff, gbase, voff, 2); else PG8_STAGE_X(bufoff, gbase, voff, 0); } while (0)
#define PG8_LDA_(dst, b, h) do { _Pragma("unroll") for (int m = 0; m < 4; ++m) _Pragma("unroll") for (int k = 0; k < 2; ++k) dst[m][k] = *(const LAS bf16x8*)(lds + PG8_SA(b, h) + aoff + m * 2048 + k * 1024); } while (0)
#define PG8_LDB_(dst, b, h) do { _Pragma("unroll") for (int n = 0; n < 2; ++n) _Pragma("unroll") for (int k = 0; k < 2; ++k) dst[n][k] = *(const LAS bf16x8*)(lds + PG8_SB(b, h) + boff + n * 2048 + k * 1024); } while (0)
#define PG8_LD8(dst, pa, pb) do { const u32x4 _lo = *(const LAS u32x4*)(pa), _hi = *(const LAS u32x4*)(pb); dst = __builtin_bit_cast(v8i32, __builtin_shufflevector(_lo, _hi, 0, 1, 2, 3, 4, 5, 6, 7)); } while (0)
#define PG8_LDA8(dst, b, h) do { _Pragma("unroll") for (int m = 0; m < 4; ++m) PG8_LD8(dst[m], lds + PG8_SA(b, h) + aoff8a + m * 2048, lds + PG8_SA(b, h) + aoff8b + m * 2048); } while (0)
#define PG8_LDB8(dst, b, h) do { _Pragma("unroll") for (int n = 0; n < 2; ++n) PG8_LD8(dst[n], lds + PG8_SB(b, h) + boff8a + n * 2048, lds + PG8_SB(b, h) + boff8b + n * 2048); } while (0)
#define PG8_LDA(dst, b, h) do { if constexpr (F8) PG8_LDA8(dst##8, b, h); else PG8_LDA_(dst, b, h); } while (0)
#define PG8_LDB(dst, b, h) do { if constexpr (F8) PG8_LDB8(dst##8, b, h); else PG8_LDB_(dst, b, h); } while (0)
#define PG8_MFMA8(c, b8, a8) asm volatile("s_nop 1\n\tv_mfma_f32_16x16x128_f8f6f4 %0, %1, %2, %0" : "+v"(c) : "v"(b8), "v"(a8))
#define PG8_MMA(ai, bj, At, Bt) do { __builtin_amdgcn_s_setprio(1); _Pragma("unroll") for (int m = 0; m < 4; ++m) _Pragma("unroll") for (int n = 0; n < 2; ++n) { \
        if constexpr (F8) PG8_MFMA8(acc[ai][bj][m][n], Bt##8[n], At##8[m]); \
        else { _Pragma("unroll") for (int k = 0; k < 2; ++k) acc[ai][bj][m][n] = __builtin_amdgcn_mfma_f32_16x16x32_bf16(Bt[n][k], At[m][k], acc[ai][bj][m][n], 0, 0, 0); } } __builtin_amdgcn_s_setprio(0); } while (0)
#define PG8_WAIT_V(n) asm volatile("s_waitcnt vmcnt(" #n ")" ::: "memory")
#define PG8_WAIT_L(n) asm volatile("s_waitcnt lgkmcnt(" #n ")" ::: "memory")
#define PG8_BAR __builtin_amdgcn_s_barrier()
#define PG8_SCHED __builtin_amdgcn_sched_barrier(0)
    Unit cur, nxt; int ui = 0;
    if (!S.next(0, cur)) return;
    if (STAGGER_TICKS > 0) {
        const unsigned long long t0 = __builtin_amdgcn_s_memrealtime(), dl = (unsigned long long)(((blockIdx.x >> 3) & 15) * STAGGER_TICKS);
        while (__builtin_amdgcn_s_memrealtime() - t0 < dl) __builtin_amdgcn_s_sleep(4);
    }
    f32x4 acc[2][2][4][2];
    E.init(acc, cur, wr, wc, fr, fq);
    bf16x8 At[4][2], B0[2][2], B1[2][2];
    v8i32 At8[4], B08[2], B18[2];
    unsigned vc[2][2], vn[2][2];
    S.a_voff(cur, Rr, Cc, vc);
    const char* cA = S.a_base(cur); const char* cB = S.b_base(cur);
    PG8_STAGE(PG8_SB(0, 0), cB, voffB[0]); PG8_STAGE(PG8_SB(0, 1), cB, voffB[1]); PG8_STAGE(PG8_SA(0, 0), cA, vc[0]); PG8_STAGE(PG8_SA(0, 1), cA, vc[1]);
    if (wr == 1) PG8_BAR;
    PG8_WAIT_V(2); PG8_BAR;
    PG8_STAGE(PG8_SB(1, 0), cB + kstep, voffB[0]); PG8_STAGE(PG8_SA(1, 0), cA + kstep, vc[0]); PG8_STAGE(PG8_SB(1, 1), cB + kstep, voffB[1]);
    PG8_WAIT_V(6); PG8_BAR;
    for (;;) {
        const bool has_next = S.next(ui + 1, nxt);
        const char* nA = has_next ? S.a_base(nxt) : cA; const char* nB = has_next ? S.b_base(nxt) : cB;
        if (has_next) S.a_voff(nxt, Rr, Cc, vn); else { vn[0][0] = vc[0][0]; vn[0][1] = vc[0][1]; vn[1][0] = vc[1][0]; vn[1][1] = vc[1][1]; }
        for (int t = 0; t < nt; t += 2) {
            const bool last = (t == nt - 2);
            const int t1 = (KREP == 1) ? t + 1 : ((t + 1) & kmask), t2 = (KREP == 1) ? t + 2 : ((t + 2) & kmask);
            const char* a1 = cA + (size_t)t1 * kstep;
            const char* a2 = last ? nA : cA + (size_t)t2 * kstep; const char* b2 = last ? nB : cB + (size_t)t2 * kstep;
            const char* a3 = a2 + kstep; const char* b3 = b2 + kstep;
            unsigned w0[2], w1[2]; w0[0] = last ? vn[0][0] : vc[0][0]; w0[1] = last ? vn[0][1] : vc[0][1]; w1[0] = last ? vn[1][0] : vc[1][0]; w1[1] = last ? vn[1][1] : vc[1][1];
            PG8_LDB(B0, 0, 0); PG8_LDB(B1, 0, 1); PG8_SCHED; PG8_LDA(At, 0, 0); PG8_STAGE(PG8_SA(1, 1), a1, vc[1]);
            PG8_WAIT_V(8); PG8_WAIT_L(0); PG8_BAR; PG8_MMA(0, 0, At, B0); PG8_MMA(0, 1, At, B1); PG8_BAR; PG8_SCHED;
            PG8_LDA(At, 0, 1); PG8_STAGE(PG8_SB(0, 0), b2, voffB[0]); PG8_STAGE(PG8_SB(0, 1), b2, voffB[1]); PG8_STAGE(PG8_SA(0, 0), a2, w0);
            PG8_WAIT_V(8); PG8_WAIT_L(0); PG8_BAR; PG8_MMA(1, 0, At, B0); PG8_MMA(1, 1, At, B1); PG8_BAR; PG8_SCHED;
            PG8_LDB(B0, 1, 0); PG8_LDB(B1, 1, 1); PG8_SCHED; PG8_LDA(At, 1, 0); PG8_STAGE(PG8_SA(0, 1), a2, w1);
            PG8_WAIT_V(8); PG8_WAIT_L(0); PG8_BAR; PG8_MMA(0, 0, At, B0); PG8_MMA(0, 1, At, B1); PG8_BAR; PG8_SCHED;
            PG8_LDA(At, 1, 1); PG8_STAGE(PG8_SB(1, 0), b3, voffB[0]); PG8_STAGE(PG8_SB(1, 1), b3, voffB[1]); PG8_STAGE(PG8_SA(1, 0), a3, w0);
            PG8_WAIT_V(8); PG8_WAIT_L(0); PG8_BAR; PG8_MMA(1, 0, At, B0); PG8_MMA(1, 1, At, B1); PG8_BAR; PG8_SCHED;
        }
        if (wr == 0) PG8_BAR;
        if constexpr (F8) asm volatile("s_nop 15\n\ts_nop 7" ::: "memory");
#pragma unroll
        for (int er = 0; er < EPI_REP; ++er) E(acc, cur, wr, wc, fr, fq);
        if (!has_next) break;
        E.init(acc, nxt, wr, wc, fr, fq);
        cur = nxt; cA = nA; cB = nB; ++ui;
        vc[0][0] = vn[0][0]; vc[0][1] = vn[0][1]; vc[1][0] = vn[1][0]; vc[1][1] = vn[1][1];
        if (wr == 1) PG8_BAR;
    }
    PG8_WAIT_V(0);
    PG8_BAR;
#undef PG8_SA
#undef PG8_SB
#undef PG8_STAGE
#undef PG8_STAGE_X
#undef PG8_LDA
#undef PG8_LDB
#undef PG8_MMA
#undef PG8_MFMA8
#undef PG8_LDA_
#undef PG8_LDB_
#undef PG8_LD8
#undef PG8_LDA8
#undef PG8_LDB8
#undef PG8_WAIT_V
#undef PG8_WAIT_L
#undef PG8_BAR
#undef PG8_SCHED
}

struct DenseProb {
    static constexpr bool A_NT = DENSE_A_NT;
    const char* A; const char* Bt; int ldaB, KB, acolB;
    StaticOrder so;
    __device__ __forceinline__ bool next(int i, Unit& u) const { u.ord = i; u.e = 0; u.cnt = 256; return so.next(i, u.pm, u.pn); }
    __device__ __forceinline__ const char* a_base(const Unit& u) const { return A + (size_t)u.pm * BM * ldaB + (size_t)u.pn * acolB; }
    __device__ __forceinline__ const char* b_base(const Unit& u) const { return Bt + (size_t)u.pn * BM * KB; }
    __device__ __forceinline__ void a_voff(const Unit&, const int (&R)[2], const int (&C)[2], unsigned (&vo)[2][2]) const {
#pragma unroll
        for (int h = 0; h < 2; ++h)
#pragma unroll
            for (int i = 0; i < 2; ++i) vo[h][i] = (unsigned)((h * HALF + R[i]) * ldaB + C[i] * 2);
    }
};

struct MoeProb {
    static constexpr bool A_NT = false;
    const char* A; const char* Bt; int ldaB, KB, nN, shift;
    LAS const int* tab;
    LAS const int* expt;
    int G, c;
    __device__ __forceinline__ bool next(int i, Unit& u) const {
        const int per = G >> 3, xcd = c & 7, rank = c >> 3;
        if (expt[70]) {
            const int e = xcd + 8 * (rank >> 3), sub = rank & 7, cnt = expt[33 + e], T = (cnt + 255) >> 8;
            const int pn = (nN == 8) ? sub : (sub & 3), pm = (nN == 8) ? i : 2 * i + (sub >> 2);
            if (pm >= T || i >= TAB_UNITS) return false;
            u.e = e; u.pn = pn; u.pm = pm; u.ord = i; u.cnt = cnt - pm * 256; return true;
        }
        const int L = (i * 8 + xcd) * per + rank;
        if (L >= expt[32] || i >= TAB_UNITS) return false;
        int e = 0;
#pragma unroll 1
        while (e < 31 && L >= expt[e + 1]) ++e;
        const int q = L - expt[e], cnt = expt[33 + e], T = (cnt + 255) >> 8;
        u.e = e; u.pn = q / T; u.pm = q % T; u.ord = i; u.cnt = cnt - u.pm * 256; return true;
    }
    __device__ __forceinline__ const char* a_base(const Unit&) const { return A; }
    __device__ __forceinline__ const char* b_base(const Unit& u) const { return Bt + ((size_t)u.e * nN + u.pn) * BM * KB; }
    __device__ __forceinline__ void a_voff(const Unit& u, const int (&R)[2], const int (&C)[2], unsigned (&vo)[2][2]) const {
#pragma unroll
        for (int h = 0; h < 2; ++h)
#pragma unroll
            for (int i = 0; i < 2; ++i) { const unsigned row = ((unsigned)tab[u.ord * 256 + h * HALF + R[i]] & 0x7fffffffu) >> shift; vo[h][i] = row * (unsigned)ldaB + (unsigned)C[i] * 2u; }
    }
};

struct EpiBf16 {
    bf16_t* O; int ldc, cbase; float scale;
    __device__ __forceinline__ void init(f32x4 (&acc)[2][2][4][2], const Unit&, int, int, int, int) const {
#pragma unroll
        for (int a = 0; a < 2; ++a)
#pragma unroll
            for (int b = 0; b < 2; ++b)
#pragma unroll
                for (int m = 0; m < 4; ++m)
#pragma unroll
                    for (int n = 0; n < 2; ++n) acc[a][b][m][n] = (f32x4){0.f, 0.f, 0.f, 0.f};
    }
    __device__ __forceinline__ void operator()(const f32x4 (&acc)[2][2][4][2], const Unit& u, int wr, int wc, int fr, int fq) const {
        const int row0 = u.pm * BM + wr * 64 + fr, col0 = cbase + u.pn * BM + wc * 64 + 16 * fq;
#pragma unroll
        for (int ai = 0; ai < 2; ++ai)
#pragma unroll
            for (int m = 0; m < 4; ++m) { bf16_t* rowp = O + (size_t)(row0 + ai * HALF + m * 16) * ldc + col0;
#pragma unroll
                for (int bj = 0; bj < 2; ++bj) { const f32x4 v0 = acc[ai][bj][m][0] * scale, v1 = acc[ai][bj][m][1] * scale;
                    u32x4 w; w.x = cvt_pk_bf16(v0[0], v0[1]); w.y = cvt_pk_bf16(v0[2], v0[3]); w.z = cvt_pk_bf16(v1[0], v1[1]); w.w = cvt_pk_bf16(v1[2], v1[3]);
                    *(u32x4*)(rowp + bj * 8) = w; } }
    }
};
struct EpiResBf16 {
    const float* rms; bf16_t* O; int ldc; unsigned char* O8;
    __device__ __forceinline__ void init(f32x4 (&acc)[2][2][4][2], const Unit& u, int wr, int wc, int fr, int fq) const {
        const int row0 = u.pm * BM + wr * 64 + fr, col0 = u.pn * BM + wc * 64 + 16 * fq;
        u32x4 raw[2][4][2]; float rs[2][4];
#pragma unroll
        for (int ai = 0; ai < 2; ++ai)
#pragma unroll
            for (int m = 0; m < 4; ++m) { const int row = row0 + ai * HALF + m * 16; rs[ai][m] = rms[row];
#pragma unroll
                for (int bj = 0; bj < 2; ++bj) raw[ai][m][bj] = *(const GAS u32x4*)(O + (size_t)row * ldc + col0 + bj * 8); }
#pragma unroll
        for (int ai = 0; ai < 2; ++ai)
#pragma unroll
            for (int m = 0; m < 4; ++m)
#pragma unroll
                for (int bj = 0; bj < 2; ++bj) { const u32x4 w = raw[ai][m][bj]; const float r = rs[ai][m];
                    acc[ai][bj][m][0] = (f32x4){bflo(w.x) * r, bfhi(w.x) * r, bflo(w.y) * r, bfhi(w.y) * r};
                    acc[ai][bj][m][1] = (f32x4){bflo(w.z) * r, bfhi(w.z) * r, bflo(w.w) * r, bfhi(w.w) * r}; }
    }
    __device__ __forceinline__ void operator()(const f32x4 (&acc)[2][2][4][2], const Unit& u, int wr, int wc, int fr, int fq) const {
        const int row0 = u.pm * BM + wr * 64 + fr, col0 = u.pn * BM + wc * 64 + 16 * fq;
#pragma unroll
        for (int ai = 0; ai < 2; ++ai)
#pragma unroll
            for (int m = 0; m < 4; ++m) { bf16_t* rowp = O + (size_t)(row0 + ai * HALF + m * 16) * ldc + col0;
#pragma unroll
                for (int bj = 0; bj < 2; ++bj) { const f32x4 v0 = acc[ai][bj][m][0], v1 = acc[ai][bj][m][1];
                    u32x4 w; w.x = cvt_pk_bf16(v0[0], v0[1]); w.y = cvt_pk_bf16(v0[2], v0[3]); w.z = cvt_pk_bf16(v1[0], v1[1]); w.w = cvt_pk_bf16(v1[2], v1[3]);
                    *(u32x4*)(rowp + bj * 8) = w; } }
    }
};
struct EpiSwiGLU {
    unsigned char* act; LAS const int* tab; LAS const float* tabr; LAS const float* tabg;
    __device__ __forceinline__ void init(f32x4 (&acc)[2][2][4][2], const Unit&, int, int, int, int) const {
#pragma unroll
        for (int a = 0; a < 2; ++a)
#pragma unroll
            for (int b = 0; b < 2; ++b)
#pragma unroll
                for (int m = 0; m < 4; ++m)
#pragma unroll
                    for (int n = 0; n < 2; ++n) acc[a][b][m][n] = (f32x4){0.f, 0.f, 0.f, 0.f};
    }
    __device__ __forceinline__ void operator()(const f32x4 (&acc)[2][2][4][2], const Unit& u, int wr, int wc, int fr, int fq) const {
        const int col0 = u.pn * HALF + wc * 32 + 8 * fq;
#pragma unroll
        for (int ai = 0; ai < 2; ++ai)
#pragma unroll
            for (int m = 0; m < 4; ++m) { const int rl = ai * HALF + wr * 64 + m * 16 + fr; const int a = tab[u.ord * 256 + rl];
                const float r = tabr[u.ord * 256 + rl], rg = tabg[u.ord * 256 + rl];
                if (a >= 0) { float o[8];
#pragma unroll
                    for (int n = 0; n < 2; ++n)
#pragma unroll
                        for (int j = 0; j < 4; ++j) { const float g = acc[ai][0][m][n][j] * r; o[n * 4 + j] = g * __builtin_amdgcn_rcpf(1.0f + __builtin_amdgcn_exp2f(g * -1.4426950408889634f)) * (acc[ai][1][m][n][j] * rg); }
                    u32x2 w; w.x = pk4_fp8(o[0], o[1], o[2], o[3]); w.y = pk4_fp8(o[4], o[5], o[6], o[7]);
                    *(u32x2*)(act + (size_t)a * DEXP + col0) = w; } }
    }
};
struct EpiScatterF8 {
    unsigned char* Y; int ldc; LAS const int* tab; float scale;
    __device__ __forceinline__ void init(f32x4 (&acc)[2][2][4][2], const Unit&, int, int, int, int) const {
#pragma unroll
        for (int a = 0; a < 2; ++a)
#pragma unroll
            for (int b = 0; b < 2; ++b)
#pragma unroll
                for (int m = 0; m < 4; ++m)
#pragma unroll
                    for (int n = 0; n < 2; ++n) acc[a][b][m][n] = (f32x4){0.f, 0.f, 0.f, 0.f};
    }
    __device__ __forceinline__ void operator()(const f32x4 (&acc)[2][2][4][2], const Unit& u, int wr, int wc, int fr, int fq) const {
        const int col0 = u.pn * BM + wc * 64 + 16 * fq;
#pragma unroll
        for (int ai = 0; ai < 2; ++ai)
#pragma unroll
            for (int m = 0; m < 4; ++m) { const int rl = ai * HALF + wr * 64 + m * 16 + fr; const int a = tab[u.ord * 256 + rl];
                if (a >= 0) { const f32x4 v0 = acc[ai][0][m][0] * scale, v1 = acc[ai][0][m][1] * scale, v2 = acc[ai][1][m][0] * scale, v3 = acc[ai][1][m][1] * scale;
                    u32x4 w; w.x = pk4_fp8(v0[0], v0[1], v0[2], v0[3]); w.y = pk4_fp8(v1[0], v1[1], v1[2], v1[3]); w.z = pk4_fp8(v2[0], v2[1], v2[2], v2[3]); w.w = pk4_fp8(v3[0], v3[1], v3[2], v3[3]);
                    *(u32x4*)(Y + (size_t)a * ldc + col0) = w; } }
    }
};
}

struct Frame {
    LAS unsigned char* lds;
    gu32* ctl;
    int tid, lane, wave, G, bx;
    const float *x, *norm_mix, *w_in, *q_norm, *k_norm, *sinks, *w_pool, *pool_scale, *w_out, *norm_ffn, *w_coarse, *b_coarse, *w_fine, *b_fine, *w_gate, *w_up, *w_down;
    float* out;
    float *rope, *rinv, *rtok, *gate;
    bf16_t *Wr, *Wpool, *Win, *Wout, *XB, *PROJ, *MIXED, *DPOOL, *Y;
    unsigned char *Wgu8, *Wd8, *H8, *ACT8;
    int* rowl;
};

__device__ __forceinline__ void tr_item(const float* W, int N, int k0, int n0, bf16_t* dst0, int Kd, const float* gk, const float* gn, LAS float* scr, int lane) {
    const int kk0 = lane >> 3, n4 = (lane & 7) * 4;
    f32x4 v[8];
#pragma unroll
    for (int i = 0; i < 8; ++i) v[i] = __builtin_nontemporal_load((const GAS f32x4*)(W + (size_t)(k0 + 8 * i + kk0) * N + n0 + n4));
    f32x4 sn = (f32x4){1.f, 1.f, 1.f, 1.f}; if (gn) sn = *(const GAS f32x4*)(gn + n0 + n4);
#pragma unroll
    for (int i = 0; i < 8; ++i) { const float g = gk ? gk[k0 + 8 * i + kk0] : 1.0f; const f32x4 w = v[i] * sn * g; LAS float* d = scr + (8 * i + kk0) * 33 + n4; d[0] = w.x; d[1] = w.y; d[2] = w.z; d[3] = w.w; }
    LDS_WAIT(); asm volatile("" ::: "memory");
    const int c = lane & 7;
#pragma unroll
    for (int j = 0; j < 4; ++j) { const int n = (lane >> 3) + 8 * j; const LAS float* s = scr + (8 * c) * 33 + n;
        u32x4 o; o.x = pk2(s[0 * 33], s[1 * 33]); o.y = pk2(s[2 * 33], s[3 * 33]); o.z = pk2(s[4 * 33], s[5 * 33]); o.w = pk2(s[6 * 33], s[7 * 33]);
        *(GAS u32x4*)(dst0 + (size_t)n * Kd + k0 + 8 * c) = o; }
    LDS_WAIT(); asm volatile("" ::: "memory");
}

__device__ __forceinline__ void tr_item8(const float* W, int N, int k0, int n0, unsigned char* dst0, int Kd, const float* gk, LAS float* scr, int lane, int gu = 0) {
    const int kk0 = lane >> 3, n4 = (lane & 7) * 4;
    f32x4 v[8];
#pragma unroll
    for (int i = 0; i < 8; ++i) v[i] = __builtin_nontemporal_load((const GAS f32x4*)(W + (size_t)(k0 + 8 * i + kk0) * N + n0 + n4));
#pragma unroll
    for (int i = 0; i < 8; ++i) { const float g = (gk ? gk[k0 + 8 * i + kk0] : 1.0f) * W8_SCALE; const f32x4 w = v[i] * g; LAS float* d = scr + (8 * i + kk0) * 33 + n4; d[0] = w.x; d[1] = w.y; d[2] = w.z; d[3] = w.w; }
    LDS_WAIT(); asm volatile("" ::: "memory");
    const int c = lane & 7;
#pragma unroll
    for (int j = 0; j < 4; ++j) { const int n = (lane >> 3) + 8 * j; const LAS float* s = scr + (8 * c) * 33 + n;
        u32x2 o; o.x = pk4_fp8(s[0 * 33], s[1 * 33], s[2 * 33], s[3 * 33]); o.y = pk4_fp8(s[4 * 33], s[5 * 33], s[6 * 33], s[7 * 33]);
        const int x = n0 + n, drow = gu ? (256 * (x >> 7) + 64 * ((x >> 5) & 3) + 16 * ((x >> 3) & 3) + 8 * (gu - 1) + (x & 7)) : n;
        if (gu) __builtin_nontemporal_store(o, (GAS u32x2*)(dst0 + (size_t)drow * Kd + k0 + 8 * c)); else *(GAS u32x2*)(dst0 + (size_t)drow * Kd + k0 + 8 * c) = o; }
    LDS_WAIT(); asm volatile("" ::: "memory");
}

__device__ __forceinline__ void wd_convert(Frame& F, int iw, int nwg) {
    LAS float* scr = (LAS float*)(F.lds + F.wave * 16384);
    constexpr int I_D = NEXP * (DEXP / 64) * (DM / 32);
    for (int r = iw * 8 + F.wave; r < I_D; r += nwg * 8) {
        const int per = (DEXP / 64) * (DM / 32), e = r / per, q = r % per, nb = DM / 32, kb = q / nb, nn = q % nb;
        tr_item8(F.w_down + (size_t)e * DEXP * DM, DM, 64 * kb, 32 * nn, F.Wd8 + ((size_t)e * DM + 32 * nn) * DEXP, DEXP, nullptr, scr, F.lane);
    }
}

__device__ __forceinline__ void p0_prologue(Frame& F) {
    const int gw = F.bx * 8 + F.wave, NGW = F.G * 8, gt = F.bx * 512 + F.tid, NGT = F.G * 512;
    LAS float* scr = (LAS float*)(F.lds + F.wave * 16384);
    for (int i = gt; i < SEQ * 8; i += NGT) {
        const int pos = i >> 3, j = i & 7;
        const double invf[8] = {1.0, 0.19392274474868576, 0.03760603093086393, 0.007292664737217109, 0.001414213562373095, 0.0002742481756762073, 5.318295896944988e-05, 1.031338537721246e-05};
        double f = invf[0];
#pragma unroll
        for (int q = 1; q < 8; ++q) f = (j == q) ? invf[q] : f;
        double s, c; sincos((double)pos * f, &s, &c);
        F.rope[pos * 16 + j] = (float)c; F.rope[pos * 16 + 8 + j] = (float)s;
    }
    for (int i = gt; i < 64 * DM; i += NGT) {
        const int j = i / DM, k = i % DM; float v = 0.f;
        if (j < 4) v = F.w_coarse[k * 4 + j] * F.norm_ffn[k]; else if (j < 36) v = F.w_fine[k * 32 + (j - 4)] * F.norm_ffn[k];
        const unsigned hi = f2bf(v); const float lo = v - bflo(hi);
        F.Wr[i] = (bf16_t)hi; F.Wr[64 * DM + i] = (bf16_t)f2bf(lo);
    }
    constexpr int I_IN = (DM / 64) * (INW / 32), I_OUT = (1024 / 64) * (DM / 32), I_POOL = 0, I_G = NEXP * (DM / 64) * (DEXP / 32);
    constexpr int NITEMS = I_IN + I_OUT + I_POOL + 2 * I_G;
    for (int it = gw; it < NITEMS; it += NGW) {
        int r = it;
        if (r < I_IN) { const int nb = INW / 32, kb = r / nb, nn = r % nb; tr_item(F.w_in, INW, 64 * kb, 32 * nn, F.Win + (size_t)(32 * nn) * DM, DM, F.norm_mix, nullptr, scr, F.lane); continue; } r -= I_IN;
        if (r < I_OUT) { const int nb = DM / 32, kb = r / nb, nn = r % nb; tr_item(F.w_out, DM, 64 * kb, 32 * nn, F.Wout + (size_t)(32 * nn) * DM, DM, nullptr, nullptr, scr, F.lane); continue; } r -= I_OUT;
        if (r < 2 * I_G) { const int up = r >= I_G; if (up) r -= I_G; const int per = (DM / 64) * (DEXP / 32), e = r / per, q = r % per, nb = DEXP / 32, kb = q / nb, nn = q % nb, n0 = 32 * nn;
            const float* W = (up ? F.w_up : F.w_gate) + (size_t)e * DM * DEXP;
            unsigned char* dst = F.Wgu8 + (size_t)e * 1024 * DM;
            tr_item8(W, DEXP, 64 * kb, n0, dst, DM, F.norm_ffn, scr, F.lane, up ? 2 : 1); continue; }
    }
    for (int wt = F.bx; wt < 256; wt += F.G) {
        const int pr = wt >> 3, g = pr >> 3, c0 = (pr & 7) * 32, n0 = ((wt & 7) * 8 + F.wave) * 32, i = F.lane & 31, kk = F.lane >> 5;
        LAS float* wp = (LAS float*)F.lds;
        __syncthreads();
        for (int e = F.tid; e < 32 * 256; e += 512) { const int c = e >> 8, j = e & 255; wp[c * 257 + j] = F.w_pool[(size_t)g * 65536 + (size_t)(c0 + c) * 256 + j] * F.pool_scale[g * 256 + j]; }
        __syncthreads();
        const float* ap = F.w_out + (size_t)(1024 + g * 256 + kk) * DM + n0 + i;
        const LAS float* bp = wp + i * 257 + kk;
        f32x16 acc = {};
#pragma unroll 16
        for (int j0 = 0; j0 < 256; j0 += 2) acc = __builtin_amdgcn_mfma_f32_32x32x2f32(ap[(size_t)j0 * DM], bp[j0], acc, 0, 0, 0);
        bf16_t* op = F.Wout + (size_t)n0 * DM + 1024 + g * 256 + c0 + i;
#pragma unroll
        for (int r = 0; r < 16; ++r) { const int nr = (r & 3) + 8 * (r >> 2) + 4 * kk; op[(size_t)nr * DM] = (bf16_t)f2bf(acc[r]); }
    }
    __syncthreads();
    for (int m = gw; m < NTOK; m += NGW) {
        const GAS f32x4* xr = (const GAS f32x4*)(F.x + (size_t)m * DM) + F.lane;
        f32x4 v[8]; float s = 0.f;
#pragma unroll
        for (int j = 0; j < 8; ++j) { v[j] = __builtin_nontemporal_load(xr + 64 * j); s += (v[j].x * v[j].x + v[j].y * v[j].y) + (v[j].z * v[j].z + v[j].w * v[j].w); }
        s = wave_sum(s);
        const float rms = sqrtf(s * (1.0f / DM) + EPS), rr = 1.0f / rms;
        if (F.lane == 0) F.rinv[m] = rms;
        GAS u32x2* o8 = (GAS u32x2*)(F.XB + (size_t)m * DM) + F.lane;
#pragma unroll
        for (int j = 0; j < 8; ++j) { u32x2 w; w.x = pk2(v[j].x * rr, v[j].y * rr); w.y = pk2(v[j].z * rr, v[j].w * rr); o8[64 * j] = w; }
    }
}

struct PoolSt { int it; float S[8]; bool active; };
struct PoolGeo { const bf16_t* up; bf16_t* dp; int w, pos0; };
__device__ __forceinline__ PoolGeo pool_geo(const Frame& F, int it) {
    const int ri = it >> 7, c8 = it & 127, t0 = ri * 32; PoolGeo g;
    g.w = 2 << (c8 >> 5); g.pos0 = t0 & (SEQ - 1); g.up = F.PROJ + (size_t)t0 * INW + UOFF + c8 * 8; g.dp = F.MIXED + (size_t)t0 * DM + 1024 + c8 * 8; return g;
}
__device__ __forceinline__ void pool_begin(Frame& F, int it, PoolSt& ps) {
    const int NITEM = (NTOK / 32) * 128;
    ps.active = it < NITEM; ps.it = ps.active ? it : 0;
    const PoolGeo g = pool_geo(F, ps.it);
#pragma unroll
    for (int j = 0; j < 8; ++j) ps.S[j] = 0.f;
    for (int i0 = 1; i0 < g.w; i0 += 5) { u32x4 pr[5];
#pragma unroll
        for (int q = 0; q < 5; ++q) { const int i = i0 + q; pr[q] = (u32x4){0u, 0u, 0u, 0u}; if (i < g.w && g.pos0 - i >= 0) pr[q] = *(const GAS u32x4*)(g.up - (ptrdiff_t)i * INW); }
#pragma unroll
        for (int q = 0; q < 5; ++q) { const u32x4 raw = pr[q];
            ps.S[0] += bflo(raw.x); ps.S[1] += bfhi(raw.x); ps.S[2] += bflo(raw.y); ps.S[3] += bfhi(raw.y); ps.S[4] += bflo(raw.z); ps.S[5] += bfhi(raw.z); ps.S[6] += bflo(raw.w); ps.S[7] += bfhi(raw.w); } }
}
__device__ __forceinline__ void pool_issue(const Frame& F, const PoolSt& ps, int k, u32x4 (&nw)[4]) {
    const PoolGeo g = pool_geo(F, ps.it);
#pragma unroll
    for (int q = 0; q < 4; ++q) nw[q] = *(const GAS u32x4*)(g.up + (ptrdiff_t)(4 * k + q) * INW);
}
__device__ __forceinline__ void pool_finish(const Frame& F, PoolSt& ps, int k, const u32x4 (&nw)[4]) {
    const PoolGeo g = pool_geo(F, ps.it);
    u32x4 od[4];
#pragma unroll
    for (int q = 0; q < 4; ++q) { const int t = 4 * k + q; const int to = t - g.w + 1, toc = (g.pos0 + to >= 0) ? to : t;
        od[q] = *(const GAS u32x4*)(g.up + (ptrdiff_t)toc * INW); }
#pragma unroll
    for (int q = 0; q < 4; ++q) { const int t = 4 * k + q; const u32x4 raw = nw[q]; const bool has_old = g.pos0 + t - g.w + 1 >= 0;
        const u32x4 old = has_old ? od[q] : (u32x4){0u, 0u, 0u, 0u};
        const float xv[8] = {bflo(raw.x), bfhi(raw.x), bflo(raw.y), bfhi(raw.y), bflo(raw.z), bfhi(raw.z), bflo(raw.w), bfhi(raw.w)};
        const int pos = g.pos0 + t; const float ic = __builtin_amdgcn_rcpf((float)((pos + 1 < g.w) ? (pos + 1) : g.w));
        float d[8];
#pragma unroll
        for (int j = 0; j < 8; ++j) { ps.S[j] += xv[j]; d[j] = ps.S[j] * ic - xv[j]; }
        u32x4 o; o.x = pk2(d[0], d[1]); o.y = pk2(d[2], d[3]); o.z = pk2(d[4], d[5]); o.w = pk2(d[6], d[7]);
        *(GAS u32x4*)(g.dp + (size_t)t * DM) = o;
        ps.S[0] -= bflo(old.x); ps.S[1] -= bfhi(old.x); ps.S[2] -= bflo(old.y); ps.S[3] -= bfhi(old.y); ps.S[4] -= bflo(old.z); ps.S[5] -= bfhi(old.z); ps.S[6] -= bflo(old.w); ps.S[7] -= bfhi(old.w); }
}

constexpr int AT_K = 0, AT_V = 32768, AT_VSTR = 520, AT_UNIT = 32768 + 64 * 520;
static_assert(2 * AT_UNIT <= EXPT_OFF, "attention LDS");
__device__ __forceinline__ void attn_super(Frame& F, int b, int n, int kp, PoolSt& ps, int step0) {
    LAS unsigned char* lds = F.lds;
    const int tid = F.tid, lane = F.lane, wid = F.wave;
    const size_t tok0 = (size_t)b * SEQ;
    const int g = wid & 3, ql = lane & 31, hi = lane >> 5;
    u32x4 qc[4], qn[4];
    { const int head = (2 * kp) * 4 + g, s0 = wid >> 2; const bf16_t* qp = F.PROJ + (tok0 + n * 128 + 32 * s0 + ql) * INW + QOFF + head * HD + hi * 8;
#pragma unroll
      for (int d0 = 0; d0 < 4; ++d0) qc[d0] = *(const GAS u32x4*)(qp + d0 * 16); }
    u32x4 kraw[2][4], vraw[2][2][2];
#pragma unroll
    for (int j = 0; j < 2; ++j) { const int kvh = 2 * kp + j;
#pragma unroll
        for (int i = 0; i < 4; ++i) { const int idx = i * 512 + tid, row = idx >> 3, c = idx & 7, pos = n * 128 - 128 + row, pc = pos < 0 ? 0 : pos;
            kraw[j][i] = *(const GAS u32x4*)(F.PROJ + (tok0 + pc) * INW + KOFF + kvh * HD + c * 8); }
#pragma unroll
        for (int i = 0; i < 2; ++i) { const int idx = i * 512 + tid, kpr = idx >> 3, c = idx & 7, pos = n * 128 - 128 + 2 * kpr, pc = pos < 0 ? 0 : pos;
            const bf16_t* p = F.PROJ + (tok0 + pc) * INW + VOFF + kvh * HD + c * 8; vraw[j][i][0] = *(const GAS u32x4*)p; vraw[j][i][1] = *(const GAS u32x4*)(p + INW); } }
    float kn[8];
#pragma unroll
    for (int q = 0; q < 8; ++q) kn[q] = F.k_norm[(tid & 7) * 8 + q];
#pragma unroll
    for (int j = 0; j < 2; ++j) {
#pragma unroll
        for (int i = 0; i < 4; ++i) {
            const int idx = i * 512 + tid, row = idx >> 3, c = idx & 7, pos = n * 128 - 128 + row;
            const u32x4 raw = kraw[j][i];
            float xv[8] = {bflo(raw.x), bfhi(raw.x), bflo(raw.y), bfhi(raw.y), bflo(raw.z), bfhi(raw.z), bflo(raw.w), bfhi(raw.w)};
            float ss = 0.f;
#pragma unroll
            for (int q = 0; q < 8; ++q) ss += xv[q] * xv[q];
            ss += __shfl_xor(ss, 1); ss += __shfl_xor(ss, 2); ss += __shfl_xor(ss, 4);
            const float rn = __builtin_amdgcn_rsqf(ss * (1.0f / HD) + EPS);
#pragma unroll
            for (int q = 0; q < 8; ++q) xv[q] = xv[q] * rn * kn[q];
            const int pp = pos >= 0 ? pos : 0;
            f32x4 cs4[2] = {(f32x4){1.f, 1.f, 1.f, 1.f}, (f32x4){1.f, 1.f, 1.f, 1.f}}, sn4[2] = {(f32x4){0.f, 0.f, 0.f, 0.f}, (f32x4){0.f, 0.f, 0.f, 0.f}};
            if (c < 2) { const GAS f32x4* rp = (const GAS f32x4*)(F.rope + pp * 16); cs4[0] = rp[0]; cs4[1] = rp[1]; sn4[0] = rp[2]; sn4[1] = rp[3]; }
#pragma unroll
            for (int q = 0; q < 8; ++q) { const float pr = __shfl_xor(xv[q], 1); const float cs = cs4[q >> 2][q & 3], sn = sn4[q >> 2][q & 3];
                const float r0 = xv[q] * cs - pr * sn, r1 = xv[q] * cs + pr * sn; xv[q] = (c == 0) ? r0 : (c == 1) ? r1 : xv[q]; }
            u32x4 w; w.x = pk2(xv[0], xv[1]); w.y = pk2(xv[2], xv[3]); w.z = pk2(xv[4], xv[5]); w.w = pk2(xv[6], xv[7]);
            *(LAS u32x4*)(lds + j * AT_UNIT + AT_K + row * 128 + ((c ^ (row & 7)) * 16)) = w;
        }
#pragma unroll
        for (int i = 0; i < 2; ++i) {
            const int idx = i * 512 + tid, kpr = idx >> 3, c = idx & 7;
            const u32x4 r0 = vraw[j][i][0], r1 = vraw[j][i][1];
            const unsigned a0[4] = {r0.x, r0.y, r0.z, r0.w}, a1[4] = {r1.x, r1.y, r1.z, r1.w};
#pragma unroll
            for (int q = 0; q < 4; ++q) {
                const unsigned lo = (a0[q] & 0xffffu) | (a1[q] << 16), hi2 = (a0[q] >> 16) | (a1[q] & 0xffff0000u);
                *(LAS unsigned*)(lds + j * AT_UNIT + AT_V + (c * 8 + 2 * q) * AT_VSTR + kpr * 4) = lo;
                *(LAS unsigned*)(lds + j * AT_UNIT + AT_V + (c * 8 + 2 * q + 1) * AT_VSTR + kpr * 4) = hi2;
            }
        }
    }
    __syncthreads();
    const float SC = 0.125f * 1.4426950408889634f;
    float cbound;
    { float gq = fabsf(F.q_norm[lane]), gk = fabsf(F.k_norm[lane]);
#pragma unroll
      for (int o = 1; o < 64; o <<= 1) { gq = fmaxf(gq, __shfl_xor(gq, o)); gk = fmaxf(gk, __shfl_xor(gk, o)); }
      cbound = 64.0f * SC * gq * gk * 1.02f; }
    const bf16x8 ones8 = {(short)0x3F80, (short)0x3F80, (short)0x3F80, (short)0x3F80, (short)0x3F80, (short)0x3F80, (short)0x3F80, (short)0x3F80};
#pragma unroll 1
    for (int item = 0; item < 4; ++item) {
        const int j = item >> 1, s = (wid >> 2) + 2 * (item & 1), head = (2 * kp + j) * 4 + g;
        const int qpos = n * 128 + 32 * s + ql;
        const int kbase = j * AT_UNIT + AT_K, vbase = j * AT_UNIT + AT_V;
        if (item < 3) {
            const int jn = (item + 1) >> 1, sn = (wid >> 2) + 2 * ((item + 1) & 1), hn = (2 * kp + jn) * 4 + g;
            const bf16_t* qp = F.PROJ + (tok0 + n * 128 + 32 * sn + ql) * INW + QOFF + hn * HD + hi * 8;
#pragma unroll
            for (int d0 = 0; d0 < 4; ++d0) qn[d0] = *(const GAS u32x4*)(qp + d0 * 16);
        }
        const float sink2 = F.sinks[head] * 1.4426950408889634f;
        float qv[4][8];
        float ss = 0.f;
#pragma unroll
        for (int d0 = 0; d0 < 4; ++d0) { const u32x4 raw = qc[d0];
            qv[d0][0] = bflo(raw.x); qv[d0][1] = bfhi(raw.x); qv[d0][2] = bflo(raw.y); qv[d0][3] = bfhi(raw.y); qv[d0][4] = bflo(raw.z); qv[d0][5] = bfhi(raw.z); qv[d0][6] = bflo(raw.w); qv[d0][7] = bfhi(raw.w);
#pragma unroll
            for (int q = 0; q < 8; ++q) ss += qv[d0][q] * qv[d0][q]; }
        ss += __shfl_xor(ss, 32);
        const float rn = SC * __builtin_amdgcn_rsqf(ss * (1.0f / HD) + EPS);
#pragma unroll
        for (int d0 = 0; d0 < 4; ++d0) { const GAS f32x4* gp = (const GAS f32x4*)(F.q_norm + d0 * 16 + hi * 8); const f32x4 g0 = gp[0], g1 = gp[1];
            const float gq[8] = {g0.x, g0.y, g0.z, g0.w, g1.x, g1.y, g1.z, g1.w};
#pragma unroll
            for (int q = 0; q < 8; ++q) qv[d0][q] = qv[d0][q] * rn * gq[q]; }
        { const GAS f32x4* rp = (const GAS f32x4*)(F.rope + qpos * 16); const f32x4 c0 = rp[0], c1 = rp[1], s0 = rp[2], s1 = rp[3];
          const float cs8[8] = {c0.x, c0.y, c0.z, c0.w, c1.x, c1.y, c1.z, c1.w}, sn8[8] = {s0.x, s0.y, s0.z, s0.w, s1.x, s1.y, s1.z, s1.w};
#pragma unroll
          for (int q = 0; q < 8; ++q) { const float pr = __shfl_xor(qv[0][q], 32);
              qv[0][q] = (hi == 0) ? (qv[0][q] * cs8[q] - pr * sn8[q]) : (qv[0][q] * cs8[q] + pr * sn8[q]); } }
        bf16x8 qr[4];
#pragma unroll
        for (int d0 = 0; d0 < 4; ++d0) { u32x4 w; w.x = pk2(qv[d0][0], qv[d0][1]); w.y = pk2(qv[d0][2], qv[d0][3]); w.z = pk2(qv[d0][4], qv[d0][5]); w.w = pk2(qv[d0][6], qv[d0][7]);
            qr[d0] = __builtin_bit_cast(bf16x8, w); }
        const float mref = fmaxf(cbound, sink2);
        f32x16 p[5];
#pragma unroll
        for (int jt = 0; jt < 5; ++jt) {
            const int krow = 32 * (s + jt) + ql;
            f32x16 a;
#pragma unroll
            for (int r = 0; r < 16; ++r) a[r] = -mref;
#pragma unroll
            for (int d0 = 0; d0 < 4; ++d0) { const int c = 2 * d0 + hi;
                const bf16x8 kf = *(const LAS bf16x8*)(lds + kbase + krow * 128 + ((c ^ (krow & 7)) * 16));
                a = __builtin_amdgcn_mfma_f32_32x32x16_bf16(kf, qr[d0], a, 0, 0, 0); }
            p[jt] = a;
        }
#pragma unroll
        for (int jt = 0; jt < 5; ++jt)
#pragma unroll
            for (int r = 0; r < 16; ++r) p[jt][r] = __builtin_amdgcn_exp2f(p[jt][r]);
#pragma unroll
        for (int r = 0; r < 16; ++r) { const int kl = (r & 3) + 8 * (r >> 2) + 4 * hi;
            p[0][r] = (kl > ql) ? p[0][r] : 0.f; p[4][r] = (kl <= ql) ? p[4][r] : 0.f; }
        if (n == 0) {
#pragma unroll
            for (int jt = 0; jt < 4; ++jt) if (s + jt < 4) {
#pragma unroll
                for (int r = 0; r < 16; ++r) p[jt][r] = 0.f; }
        }
        u32x4 pnw[4]; const int pstep = step0 + item; const bool pdo = ps.active && pstep < 8;
        __builtin_amdgcn_sched_barrier(0); if (pdo) pool_issue(F, ps, pstep, pnw); __builtin_amdgcn_sched_barrier(0);
        f32x16 o[2]; o[0] = f32x16{}; o[1] = f32x16{}; f32x16 sacc = f32x16{};
#pragma unroll
        for (int jt = 0; jt < 5; ++jt)
#pragma unroll
            for (int s2 = 0; s2 < 2; ++s2) {
                u32x4 pw; pw.x = cvt_pk_bf16(p[jt][8 * s2 + 0], p[jt][8 * s2 + 1]); pw.y = cvt_pk_bf16(p[jt][8 * s2 + 2], p[jt][8 * s2 + 3]);
                pw.z = cvt_pk_bf16(p[jt][8 * s2 + 4], p[jt][8 * s2 + 5]); pw.w = cvt_pk_bf16(p[jt][8 * s2 + 6], p[jt][8 * s2 + 7]);
                const bf16x8 pf = __builtin_bit_cast(bf16x8, pw);
                const int kb = 32 * (s + jt) + 16 * s2 + 4 * hi;
#pragma unroll
                for (int dt = 0; dt < 2; ++dt) {
                    const LAS unsigned char* vp = lds + vbase + (dt * 32 + ql) * AT_VSTR + kb * 2;
                    const u32x2 v0 = *(const LAS u32x2*)vp, v1 = *(const LAS u32x2*)(vp + 16);
                    u32x4 vw; vw.x = v0.x; vw.y = v0.y; vw.z = v1.x; vw.w = v1.y;
                    o[dt] = __builtin_amdgcn_mfma_f32_32x32x16_bf16(__builtin_bit_cast(bf16x8, vw), pf, o[dt], 0, 0, 0);
                }
                sacc = __builtin_amdgcn_mfma_f32_32x32x16_bf16(ones8, pf, sacc, 0, 0, 0);
            }
        const float inv = __builtin_amdgcn_rcpf(sacc[0] + __builtin_amdgcn_exp2f(sink2 - mref));
        bf16_t* op = F.MIXED + (tok0 + qpos) * DM + head * HD + (hi ? 8 : 0);
#pragma unroll
        for (int dt = 0; dt < 2; ++dt)
#pragma unroll
            for (int gp = 0; gp < 2; ++gp) {
                const int r0 = 8 * gp;
                unsigned ax = cvt_pk_bf16(o[dt][r0 + 0] * inv, o[dt][r0 + 1] * inv), ay = cvt_pk_bf16(o[dt][r0 + 2] * inv, o[dt][r0 + 3] * inv);
                unsigned bx = cvt_pk_bf16(o[dt][r0 + 4] * inv, o[dt][r0 + 5] * inv), by = cvt_pk_bf16(o[dt][r0 + 6] * inv, o[dt][r0 + 7] * inv);
                { auto rr = __builtin_amdgcn_permlane32_swap(ax, bx, false, false); ax = rr[0]; bx = rr[1]; }
                { auto rr = __builtin_amdgcn_permlane32_swap(ay, by, false, false); ay = rr[0]; by = rr[1]; }
                u32x4 w; w.x = ax; w.y = ay; w.z = bx; w.w = by;
                *(GAS u32x4*)(op + dt * 32 + 16 * gp) = w;
            }
        if (pdo) pool_finish(F, ps, pstep, pnw);
#pragma unroll
        for (int d0 = 0; d0 < 4; ++d0) qc[d0] = qn[d0];
    }
    __syncthreads();
}

__device__ __forceinline__ void pool_diff(Frame& F, int first_it) {
    const int NITEM = (NTOK / 32) * 128;
    for (int it = first_it; it < NITEM; it += F.G * 512) {
        const int ri = it >> 7, c8 = it & 127, w = 2 << (c8 >> 5), t0 = ri * 32, pos0 = t0 & (SEQ - 1);
        const bf16_t* up = F.PROJ + (size_t)t0 * INW + UOFF + c8 * 8;
        float S[8];
#pragma unroll
        for (int j = 0; j < 8; ++j) S[j] = 0.f;
        for (int i0 = 1; i0 < w; i0 += 5) { u32x4 pr[5];
#pragma unroll
            for (int q = 0; q < 5; ++q) { const int i = i0 + q; pr[q] = (u32x4){0u, 0u, 0u, 0u}; if (i < w && pos0 - i >= 0) pr[q] = *(const GAS u32x4*)(up - (ptrdiff_t)i * INW); }
#pragma unroll
            for (int q = 0; q < 5; ++q) { const u32x4 raw = pr[q];
                S[0] += bflo(raw.x); S[1] += bfhi(raw.x); S[2] += bflo(raw.y); S[3] += bfhi(raw.y); S[4] += bflo(raw.z); S[5] += bfhi(raw.z); S[6] += bflo(raw.w); S[7] += bfhi(raw.w); } }
#pragma unroll 1
        for (int tc = 0; tc < 32; tc += 8) {
            u32x4 nw[8], od[8];
#pragma unroll
            for (int q = 0; q < 8; ++q) { const int t = tc + q; nw[q] = *(const GAS u32x4*)(up + (ptrdiff_t)t * INW);
                od[q] = (u32x4){0u, 0u, 0u, 0u}; if (pos0 + t - w + 1 >= 0) od[q] = *(const GAS u32x4*)(up + (ptrdiff_t)(t - w + 1) * INW); }
#pragma unroll
            for (int q = 0; q < 8; ++q) { const int t = tc + q; const u32x4 raw = nw[q], old = od[q];
                const float xv[8] = {bflo(raw.x), bfhi(raw.x), bflo(raw.y), bfhi(raw.y), bflo(raw.z), bfhi(raw.z), bflo(raw.w), bfhi(raw.w)};
                const int pos = pos0 + t; const float ic = 1.0f / (float)((pos + 1 < w) ? (pos + 1) : w);
                float d[8];
#pragma unroll
                for (int j = 0; j < 8; ++j) { S[j] += xv[j]; d[j] = S[j] * ic - xv[j]; }
                u32x4 o; o.x = pk2(d[0], d[1]); o.y = pk2(d[2], d[3]); o.z = pk2(d[4], d[5]); o.w = pk2(d[6], d[7]);
                *(GAS u32x4*)(F.MIXED + (size_t)(t0 + t) * DM + 1024 + c8 * 8) = o;
                S[0] -= bflo(old.x); S[1] -= bfhi(old.x); S[2] -= bflo(old.y); S[3] -= bfhi(old.y); S[4] -= bflo(old.z); S[5] -= bfhi(old.z); S[6] -= bflo(old.w); S[7] -= bfhi(old.w); }
        }
    }
}

constexpr int RT_WSTR = 528, RT_W = 0, RT_WLO = 64 * RT_WSTR, RT_L = 2 * 64 * RT_WSTR, RT_LSTR = 65;
__device__ __forceinline__ void route_phase(Frame& F, bool dry) {
    LAS unsigned char* lds = F.lds;
    const int tid = F.tid, lane = F.lane, wid = F.wave, row = lane & 15, kq = lane >> 4;
    for (int tile = F.bx; tile < NTOK / 128; tile += F.G) {
        const int t0 = tile * 128 + wid * 16;
        const bf16_t* hp = F.XB + (size_t)(t0 + row) * DM + kq * 8;
        unsigned char* h8 = F.H8 + (size_t)(t0 + row) * DM + kq * 8;
        f32x4 acc[4]; acc[0] = acc[1] = acc[2] = acc[3] = (f32x4){0.f, 0.f, 0.f, 0.f};
        float ssq = 0.f;
        u32x4 hv[8]; u32x4 wv[8];
#pragma unroll
        for (int ks = 0; ks < 8; ++ks) hv[ks] = *(const GAS u32x4*)(hp + ks * 32);
#pragma unroll
        for (int i = 0; i < 8; ++i) { const int p = i * 512 + tid, which = p >> 11, col = (p & 2047) >> 5, ch = p & 31;
            wv[i] = *(const GAS u32x4*)(F.Wr + (size_t)which * 64 * DM + (size_t)col * DM + ch * 8); }
#pragma unroll 1
        for (int kc = 0; kc < 8; ++kc) {
            __syncthreads();
#pragma unroll
            for (int i = 0; i < 8; ++i) { const int p = i * 512 + tid, which = p >> 11, col = (p & 2047) >> 5, ch = p & 31;
                *(LAS u32x4*)(lds + which * RT_WLO + col * RT_WSTR + ch * 16) = wv[i]; }
            __syncthreads();
            if (kc < 7) {
#pragma unroll
                for (int i = 0; i < 8; ++i) { const int p = i * 512 + tid, which = p >> 11, col = (p & 2047) >> 5, ch = p & 31;
                    wv[i] = *(const GAS u32x4*)(F.Wr + (size_t)which * 64 * DM + (size_t)col * DM + (kc + 1) * 256 + ch * 8); } }
#pragma unroll
            for (int ks = 0; ks < 8; ++ks) {
                const int k = kc * 256 + ks * 32;
                const u32x4 ah = hv[ks];
                if (kc < 7) hv[ks] = *(const GAS u32x4*)(hp + k + 256);
                { const float a0 = bflo(ah.x), a1 = bfhi(ah.x), a2 = bflo(ah.y), a3 = bfhi(ah.y), a4 = bflo(ah.z), a5 = bfhi(ah.z), a6 = bflo(ah.w), a7 = bfhi(ah.w);
                  ssq += (a0 * a0 + a1 * a1) + (a2 * a2 + a3 * a3) + (a4 * a4 + a5 * a5) + (a6 * a6 + a7 * a7);
                  u32x2 w8; w8.x = pk4_fp8(a0, a1, a2, a3); w8.y = pk4_fp8(a4, a5, a6, a7); *(GAS u32x2*)(h8 + k) = w8; }
                const bf16x8 Ah = __builtin_bit_cast(bf16x8, ah);
#pragma unroll
                for (int tc = 0; tc < 4; ++tc) {
                    const LAS unsigned char* bp = lds + (tc * 16 + row) * RT_WSTR + (ks * 32 + kq * 8) * 2;
                    const bf16x8 Bh = *(const LAS bf16x8*)bp, Bl = *(const LAS bf16x8*)(bp + RT_WLO);
                    acc[tc] = __builtin_amdgcn_mfma_f32_16x16x32_bf16(Ah, Bh, acc[tc], 0, 0, 0);
                    acc[tc] = __builtin_amdgcn_mfma_f32_16x16x32_bf16(Ah, Bl, acc[tc], 0, 0, 0);
                }
            }
        }
        ssq += __shfl_xor(ssq, 16); ssq += __shfl_xor(ssq, 32);
        const float rt = 1.0f / sqrtf(ssq * (1.0f / DM) + EPS);
        LAS float* L = (LAS float*)(lds + RT_L) + wid * 16 * RT_LSTR;
#pragma unroll
        for (int tc = 0; tc < 4; ++tc)
#pragma unroll
            for (int r = 0; r < 4; ++r) L[(kq * 4 + r) * RT_LSTR + tc * 16 + row] = acc[tc][r];
        LAS unsigned* lcnt = (LAS unsigned*)(lds + RT_L + 8 * 16 * RT_LSTR * 4); LAS unsigned* lbase = lcnt + NEXP;
        if (tid < NEXP) lcnt[tid] = 0u;
        __syncthreads();
        int me1 = 0, me2 = 0; unsigned r1 = 0u, r2 = 0u;
        if (lane < 16) {
            const int t = t0 + lane; const LAS float* Lt = L + lane * RT_LSTR;
            float c[4]; int grp = 0; float cm;
#pragma unroll
            for (int j = 0; j < 4; ++j) c[j] = Lt[j] * rt + F.b_coarse[j];
            cm = c[0];
#pragma unroll
            for (int j = 1; j < 4; ++j) if (c[j] > cm) { cm = c[j]; grp = j; }
            float den = 0.f;
#pragma unroll
            for (int j = 0; j < 4; ++j) den += __expf(c[j] - cm);
            const float pg = 1.0f / den;
            float f[8];
#pragma unroll
            for (int j = 0; j < 8; ++j) f[j] = Lt[4 + grp * 8 + j] * rt + F.b_fine[grp * 8 + j];
            int i1 = 0; float l1 = f[0];
#pragma unroll
            for (int j = 1; j < 8; ++j) if (f[j] > l1) { l1 = f[j]; i1 = j; }
            int i2 = -1; float l2 = -3.0e38f;
#pragma unroll
            for (int j = 0; j < 8; ++j) if (j != i1 && f[j] > l2) { l2 = f[j]; i2 = j; }
            const float e2 = __expf(l2 - l1), g1 = pg / (1.0f + e2), g2 = pg * e2 / (1.0f + e2);
            F.rtok[t] = rt; F.gate[2 * t] = g1; F.gate[2 * t + 1] = g2;
            me1 = grp * 8 + i1; me2 = grp * 8 + i2;
            r1 = __hip_atomic_fetch_add(&lcnt[me1], 1u, __ATOMIC_RELAXED, __HIP_MEMORY_SCOPE_WORKGROUP);
            r2 = __hip_atomic_fetch_add(&lcnt[me2], 1u, __ATOMIC_RELAXED, __HIP_MEMORY_SCOPE_WORKGROUP);
        }
        __syncthreads();
        if (tid < NEXP) { const unsigned c = lcnt[tid]; unsigned base = 0u;
            if (c && !dry) base = __hip_atomic_fetch_add((unsigned*)(F.ctl + CW_CNT + 64 * tid), c, RLX_AGENT);
            lbase[tid] = base; }
        __syncthreads();
        if (lane < 16 && !dry) { const int t = t0 + lane;
            F.rowl[(size_t)me1 * RCAP + lbase[me1] + r1] = 2 * t;
            F.rowl[(size_t)me2 * RCAP + lbase[me2] + r2] = 2 * t + 1; }
    }
}

__device__ __forceinline__ void moe_setup(Frame& F, int nN, bool with_rg) {
    LAS int* expt = (LAS int*)(F.lds + EXPT_OFF); LAS int* tab = (LAS int*)(F.lds + TAB_OFF); LAS float* tabr = (LAS float*)(F.lds + TABR_OFF); LAS float* tabg = (LAS float*)(F.lds + TABG_OFF);
    __syncthreads();
    if (F.tid < NEXP) expt[33 + F.tid] = (int)__hip_atomic_load((unsigned*)(F.ctl + CW_CNT + 64 * F.tid), RLX_AGENT);
    __syncthreads();
    if (F.tid == 0) { int acc = 0, maxT = 0;
        for (int e = 0; e < NEXP; ++e) { const int T = (expt[33 + e] + 255) >> 8; expt[e] = acc; acc += T * nN; maxT = T > maxT ? T : maxT; }
        expt[32] = acc; expt[70] = (MOE_OWNER && F.G == 256 && maxT <= 12) ? 1 : 0; expt[71] = maxT; }
    __syncthreads();
    pg8::MoeProb P; P.expt = expt; P.nN = nN; P.G = F.G; P.c = F.bx;
    pg8::Unit u;
    int nu = 0; while (P.next(nu, u)) ++nu;
    constexpr int KMAX = (TAB_UNITS * 256 + 511) / 512;
    int v[KMAX]; bool ok[KMAX];
#pragma unroll
    for (int k = 0; k < KMAX; ++k) { const int idx = F.tid + k * 512, i = idx >> 8, r = idx & 255; v[k] = 0; ok[k] = false;
        if (i < nu) { P.next(i, u); const int j = u.pm * 256 + r, cnt = expt[33 + u.e]; ok[k] = j < cnt; v[k] = F.rowl[(size_t)u.e * RCAP + (ok[k] ? j : 0)]; } }
#pragma unroll
    for (int k = 0; k < KMAX; ++k) { const int idx = F.tid + k * 512, i = idx >> 8; if (i < nu) tab[idx] = ok[k] ? v[k] : (v[k] | (int)0x80000000); }
    if (with_rg) {
        float rr[KMAX], gg[KMAX];
#pragma unroll
        for (int k = 0; k < KMAX; ++k) { const int idx = F.tid + k * 512, i = idx >> 8; rr[k] = 0.f; gg[k] = 0.f; if (i < nu && i < TABRG_UNITS) { rr[k] = F.rtok[v[k] >> 1]; gg[k] = F.gate[v[k]]; } }
#pragma unroll
        for (int k = 0; k < KMAX; ++k) { const int idx = F.tid + k * 512, i = idx >> 8; if (i < nu && i < TABRG_UNITS) { const float r = rr[k] * (1.0f / W8_SCALE); tabr[idx] = r; tabg[idx] = r * gg[k] * ACT8_SCALE; } }
    }
    __syncthreads();
}

__device__ __forceinline__ void combine_phase(Frame& F, float* dst) {
    const size_t NIT = (size_t)NTOK * (DM / 8), stride = (size_t)F.G * 512;
    const unsigned char* Y8 = (const unsigned char*)F.Y;
    constexpr float IS = 1.0f / Y8_SCALE;
    for (size_t it0 = (size_t)F.bx * 512 + F.tid; it0 < NIT; it0 += 4 * stride) {
        u32x4 h[4]; u32x2 y0[4], y1[4];
#pragma unroll
        for (int q = 0; q < 4; ++q) { const size_t it = it0 + q * stride; if (it < NIT) { const size_t t = it >> 8; const int c = (int)(it & 255) * 8;
            h[q] = *(const GAS u32x4*)(F.XB + t * DM + c); y0[q] = *(const GAS u32x2*)(Y8 + (2 * t) * DM + c); y1[q] = *(const GAS u32x2*)(Y8 + (2 * t + 1) * DM + c); } }
#pragma unroll
        for (int q = 0; q < 4; ++q) { const size_t it = it0 + q * stride; if (it < NIT) { const size_t t = it >> 8; const int c = (int)(it & 255) * 8;
            float* wp = dst + t * DM + c; f32x4 o0, o1;
            const f32x2 a0 = __builtin_amdgcn_cvt_pk_f32_fp8((int)y0[q].x, false), a1 = __builtin_amdgcn_cvt_pk_f32_fp8((int)y0[q].x, true), a2 = __builtin_amdgcn_cvt_pk_f32_fp8((int)y0[q].y, false), a3 = __builtin_amdgcn_cvt_pk_f32_fp8((int)y0[q].y, true);
            const f32x2 b0 = __builtin_amdgcn_cvt_pk_f32_fp8((int)y1[q].x, false), b1 = __builtin_amdgcn_cvt_pk_f32_fp8((int)y1[q].x, true), b2 = __builtin_amdgcn_cvt_pk_f32_fp8((int)y1[q].y, false), b3 = __builtin_amdgcn_cvt_pk_f32_fp8((int)y1[q].y, true);
            o0.x = bflo(h[q].x) + (a0.x + b0.x) * IS; o0.y = bfhi(h[q].x) + (a0.y + b0.y) * IS; o0.z = bflo(h[q].y) + (a1.x + b1.x) * IS; o0.w = bfhi(h[q].y) + (a1.y + b1.y) * IS;
            o1.x = bflo(h[q].z) + (a2.x + b2.x) * IS; o1.y = bfhi(h[q].z) + (a2.y + b2.y) * IS; o1.z = bflo(h[q].w) + (a3.x + b3.x) * IS; o1.w = bfhi(h[q].w) + (a3.y + b3.y) * IS;
            *(GAS f32x4*)wp = o0; *(GAS f32x4*)(wp + 4) = o1; } }
    }
}

struct Args { const float* in[17]; float* out; unsigned char* ws; int ph_lo, ph_hi, use_bar, pad; };
__global__ void __launch_bounds__(512, 2) hymba_fwd(Args args) {
    extern __shared__ __attribute__((aligned(16))) unsigned char lds[];
    Frame F;
    F.lds = (LAS unsigned char*)lds;
    F.tid = threadIdx.x; F.lane = F.tid & 63; F.wave = __builtin_amdgcn_readfirstlane(F.tid >> 6);
    F.G = gridDim.x; F.bx = blockIdx.x;
    unsigned char* ws = args.ws;
    F.ctl = (gu32*)(ws + WS_CTL);
    F.x = args.in[0]; F.norm_mix = args.in[1]; F.w_in = args.in[2]; F.q_norm = args.in[3]; F.k_norm = args.in[4]; F.sinks = args.in[5]; F.w_pool = args.in[6]; F.pool_scale = args.in[7];
    F.w_out = args.in[8]; F.norm_ffn = args.in[9]; F.w_coarse = args.in[10]; F.b_coarse = args.in[11]; F.w_fine = args.in[12]; F.b_fine = args.in[13]; F.w_gate = args.in[14]; F.w_up = args.in[15]; F.w_down = args.in[16];
    F.out = args.out;
    F.rope = (float*)(ws + WS_ROPE); F.rinv = (float*)(ws + WS_RINV); F.rtok = (float*)(ws + WS_RTOK); F.gate = (float*)(ws + WS_GATE);
    F.Wr = (bf16_t*)(ws + WS_WR); F.Wpool = (bf16_t*)(ws + WS_WPOOL); F.Win = (bf16_t*)(ws + WS_WIN); F.Wout = (bf16_t*)(ws + WS_WOUT); F.Wgu8 = ws + WS_WGU; F.Wd8 = ws + WS_WD; F.H8 = ws + WS_H8; F.ACT8 = ws + WS_ACT8;
    F.XB = (bf16_t*)(ws + WS_XB); F.PROJ = (bf16_t*)(ws + WS_PROJ); F.MIXED = (bf16_t*)(ws + WS_MIXED); F.DPOOL = (bf16_t*)(ws + WS_DPOOL); F.Y = (bf16_t*)(ws + WS_Y);
    F.rowl = (int*)(ws + WS_ROWL);
    if (F.tid < 4) ((LAS unsigned*)(F.lds + MISC_OFF))[F.tid] = 0u;
    __syncthreads();
    XcdBarrier bar; bar.bar = (unsigned*)(F.ctl + CW_BAR); bar.x = 0; bar.st = nullptr;
    if (args.use_bar) bar = xcd_barrier_post((unsigned*)(F.ctl + CW_BAR), (volatile LAS unsigned*)(F.lds + MISC_OFF));
    const int lo = args.ph_lo, hi = args.ph_hi;
#ifndef PHASE_MASK
#define PHASE_MASK 0x1ff
#endif
#define IN(k) (((PHASE_MASK >> (k)) & 1) && lo <= (k) && (k) < hi)
#define SEAM(k) do { if (IN(k) && IN((k) + 1)) xcd_barrier(bar); } while (0)

#define REPS(k) ((PROBE_DUP == (k)) ? 2 : 1)
    if (IN(0)) { for (int rep = 0; rep < REPS(0); ++rep) { if (rep) xcd_barrier(bar); p0_prologue(F); } SEAM(0); }
    if (IN(1)) {
        for (int rep = 0; rep < REPS(1); ++rep) { if (rep) xcd_barrier(bar);
        pg8::DenseProb P; P.A = (const char*)F.XB; P.Bt = (const char*)F.Win; P.ldaB = DM * 2; P.KB = DM * 2; P.acolB = 0; P.so.init(NTOK, INW, F.G, F.bx);
        pg8::EpiBf16 E{F.PROJ, INW, 0, 1.0f};
        pg8::gemm_phase(F.lds, P, E); }
        SEAM(1);
    }
    if (IN(2)) {
#if PROBE_DUP == 2
        { PoolSt ps; pool_begin(F, F.bx * 512 + F.tid, ps); int pstep = 0;
#pragma unroll 1
          for (int u = F.bx; u < BATCH * (SEQ / 128) * (NKV / 2); u += F.G) { const int kp = u & 1, n = (u >> 1) & 31, b = u >> 6; attn_super(F, b, n, kp, ps, pstep); pstep += 4; }
          if (ps.active) for (; pstep < 8; ++pstep) { u32x4 a4[4]; pool_issue(F, ps, pstep, a4); pool_finish(F, ps, pstep, a4); } }
        xcd_barrier(bar);
#elif PROBE_DUP == 22
        pool_diff(F, F.bx * 512 + F.tid + F.G * 512);
        xcd_barrier(bar);
#endif
        { PoolSt ps; pool_begin(F, F.bx * 512 + F.tid, ps); int pstep = 0;
#pragma unroll 1
          for (int u = F.bx; u < BATCH * (SEQ / 128) * (NKV / 2); u += F.G) { const int kp = u & 1, n = (u >> 1) & 31, b = u >> 6; attn_super(F, b, n, kp, ps, pstep); pstep += 4; }
          if (ps.active) for (; pstep < 8; ++pstep) { u32x4 a4[4]; pool_issue(F, ps, pstep, a4); pool_finish(F, ps, pstep, a4); } }
        pool_diff(F, F.bx * 512 + F.tid + F.G * 512);
        SEAM(2);
    }
    if (IN(4)) {
        for (int rep = 0; rep < REPS(4); ++rep) { if (rep) xcd_barrier(bar);
        pg8::DenseProb P; P.A = (const char*)F.MIXED; P.Bt = (const char*)F.Wout; P.ldaB = DM * 2; P.KB = DM * 2; P.acolB = 0; P.so.init(NTOK, DM, F.G, F.bx);
        pg8::EpiResBf16 E{F.rinv, F.XB, DM, F.H8};
        pg8::gemm_phase(F.lds, P, E); }
        SEAM(4);
    }
    if (IN(5)) { for (int rep = 0; rep < REPS(5); ++rep) { if (rep) xcd_barrier(bar); route_phase(F, rep + 1 < REPS(5)); } SEAM(5); }
    if (IN(6)) {
        for (int rep = 0; rep < REPS(6); ++rep) { if (rep) xcd_barrier(bar);
        moe_setup(F, 4, true);
        pg8::MoeProb P; P.A = (const char*)F.H8; P.Bt = (const char*)F.Wgu8; P.ldaB = DM; P.KB = DM; P.nN = 4; P.shift = 1; P.tab = (LAS const int*)(F.lds + TAB_OFF); P.expt = (LAS const int*)(F.lds + EXPT_OFF); P.G = F.G; P.c = F.bx;
        pg8::EpiSwiGLU E{F.ACT8, (LAS const int*)(F.lds + TAB_OFF), (LAS const float*)(F.lds + TABR_OFF), (LAS const float*)(F.lds + TABG_OFF)};
        pg8::gemm_phase<pg8::EpiSwiGLU, pg8::MoeProb, true>(F.lds, P, E);
        if (rep == 0) {
            LAS int* ex = (LAS int*)(F.lds + EXPT_OFF);
            const int U = ex[32], per = F.G >> 3, q = (F.bx & 7) * per + (F.bx >> 3);
            if (ex[70]) {
                if (F.tid == 0) { const int maxnu = (ex[71] + 1) >> 1; int idx = -1, nidle = 0;
                    for (int c2 = 0; c2 < 256; ++c2) { const int e2 = (c2 & 7) + 8 * ((c2 >> 3) >> 3), par = ((c2 >> 3) & 7) >> 2, T2 = (ex[33 + e2] + 255) >> 8, nu2 = (T2 - par + 1) >> 1;
                        if (nu2 < maxnu) { if (c2 == F.bx) idx = nidle; ++nidle; } }
                    ex[72] = idx; ex[73] = nidle; }
                __syncthreads();
                const int idx = ex[72], nidle = ex[73];
                if (nidle == 0) wd_convert(F, q, F.G); else if (idx >= 0) wd_convert(F, idx, nidle);
            } else {
                const int rounds = (U + F.G - 1) / F.G, nb = U - (rounds - 1) * F.G;
                if (U <= 0 || nb >= F.G) wd_convert(F, q, F.G); else if (q >= nb) wd_convert(F, q - nb, F.G - nb);
            }
        } }
        SEAM(6);
    }
    if (IN(7)) {
        for (int rep = 0; rep < REPS(7); ++rep) { if (rep) xcd_barrier(bar);
        moe_setup(F, 8, false);
        pg8::MoeProb P; P.A = (const char*)F.ACT8; P.Bt = (const char*)F.Wd8; P.ldaB = DEXP; P.KB = DEXP; P.nN = 8; P.shift = 0; P.tab = (LAS const int*)(F.lds + TAB_OFF); P.expt = (LAS const int*)(F.lds + EXPT_OFF); P.G = F.G; P.c = F.bx;
        pg8::EpiScatterF8 E{(unsigned char*)F.Y, DM, (LAS const int*)(F.lds + TAB_OFF), Y8_SCALE / (W8_SCALE * ACT8_SCALE)};
        pg8::gemm_phase<pg8::EpiScatterF8, pg8::MoeProb, true, 1, PROBE_EPI2 ? 2 : 1>(F.lds, P, E); }
        SEAM(7);
    }
    if (IN(8)) { for (int rep = 0; rep < REPS(8); ++rep) { if (rep) xcd_barrier(bar); combine_phase(F, (rep + 1 < REPS(8)) ? (float*)(ws + WS_END) : F.out); } }
#undef REPS
#undef IN
#undef SEAM
}

extern "C" void kernel_launch(void* const* d_in, const int* in_sizes, int n_in, void* d_out, int out_size, void* d_ws, size_t ws_size, hipStream_t stream) {
    static int grid = 0;
    if (grid == 0) {
        if (n_in != 17 || out_size != NTOK * DM || ws_size < WS_END) { fprintf(stderr, "kernel_launch: unexpected problem (n_in %d, out %d, ws %zu)\n", n_in, out_size, ws_size); grid = -1; return; }
        int dev = 0, cus = 0;
        if (hipGetDevice(&dev) != hipSuccess || hipDeviceGetAttribute(&cus, hipDeviceAttributeMultiprocessorCount, dev) != hipSuccess) { grid = -1; return; }
        if (hipFuncSetAttribute((const void*)hymba_fwd, hipFuncAttributeMaxDynamicSharedMemorySize, LDS_BYTES) != hipSuccess) { fprintf(stderr, "kernel_launch: hipFuncSetAttribute failed\n"); grid = -1; return; }
        int per_cu = 0;
        if (hipOccupancyMaxActiveBlocksPerMultiprocessor(&per_cu, (const void*)hymba_fwd, 512, LDS_BYTES) != hipSuccess || per_cu < 1) { fprintf(stderr, "kernel_launch: occupancy query says %d\n", per_cu); }
        (void)hipGetLastError();
        grid = cus - (cus % 8);
        if (grid <= 0) grid = -1;
    }
    if (grid < 0) return;
    if (hipMemsetAsync((char*)d_ws + WS_CTL, 0, CTL_ZERO_BYTES, stream) != hipSuccess) return;
    Args a{};
    for (int i = 0; i < 17; ++i) a.in[i] = (const float*)d_in[i];
    a.out = (float*)d_out; a.ws = (unsigned char*)d_ws;
    if (MK_N_LAUNCHES == 1) { a.ph_lo = 0; a.ph_hi = NPHASE; a.use_bar = 1; hipLaunchKernelGGL(hymba_fwd, dim3(grid), dim3(512), LDS_BYTES, stream, a); }
    else for (int p = 0; p < NPHASE; ++p) { a.ph_lo = p; a.ph_hi = p + 1; a.use_bar = 0; hipLaunchKernelGGL(hymba_fwd, dim3(grid), dim3(512), LDS_BYTES, stream, a); }
}
```

```cpp
#include <hip/hip_runtime.h>
#include <cstdio>
#include <cstdint>

#ifndef MK_N_LAUNCHES
#define MK_N_LAUNCHES 1
#endif
#ifndef DENSE_A_NT
#define DENSE_A_NT false
#endif
#ifndef MOE_OWNER
#define MOE_OWNER 1
#endif
#ifndef STORE_AUX
#define STORE_AUX 0
#endif
#ifndef STAGGER_TICKS
#define STAGGER_TICKS 0
#endif
#ifndef PROBE_EPI2
#define PROBE_EPI2 0
#endif
#ifndef PROBE_K2
#define PROBE_K2 0
#endif
#ifndef PROBE_DUP
#define PROBE_DUP -1
#endif

#define GAS __attribute__((address_space(1)))
#define LAS __attribute__((address_space(3)))
typedef unsigned short bf16_t;
typedef short bf16x8 __attribute__((ext_vector_type(8)));
typedef short s16x4 __attribute__((ext_vector_type(4)));
typedef float f32x4 __attribute__((ext_vector_type(4)));
typedef float f32x2 __attribute__((ext_vector_type(2)));
typedef float f32x16 __attribute__((ext_vector_type(16)));
typedef unsigned u32x4 __attribute__((ext_vector_type(4)));
typedef unsigned u32x2 __attribute__((ext_vector_type(2)));
typedef GAS unsigned gu32;

constexpr int BATCH = 8, SEQ = 4096, NTOK = BATCH * SEQ, DM = 2048;
constexpr int NH = 16, NKV = 4, HD = 64, INW = 2560, QOFF = 0, KOFF = 1024, VOFF = 1280, UOFF = 1536, PW = 1024;
constexpr int NEXP = 32, DEXP = 512, NASG = NTOK * 2, RCAP = NASG;
constexpr float EPS = 1e-6f;
constexpr int NPHASE = 9;

constexpr size_t MiB = 1u << 20;
constexpr size_t WS_CTL = 0, CTL_ZERO_BYTES = 64 * 1024;
constexpr size_t WS_ROPE = 1 * MiB;
constexpr size_t WS_RINV = WS_ROPE + 256 * 1024;
constexpr size_t WS_RTOK = WS_RINV + 128 * 1024;
constexpr size_t WS_GATE = WS_RTOK + 128 * 1024;
constexpr size_t WS_WR = 2 * MiB;
constexpr size_t WS_WPOOL = WS_WR + 512 * 1024;
constexpr size_t WS_WIN = 3 * MiB;
constexpr size_t WS_WOUT = 13 * MiB;
constexpr size_t WS_ROWL = 21 * MiB;
constexpr size_t WS_WGU = 29 * MiB;
constexpr size_t WS_H8 = 93 * MiB;
constexpr size_t WS_WD = 157 * MiB;
constexpr size_t WS_ACT8 = 189 * MiB;
constexpr size_t WS_XB = 221 * MiB;
constexpr size_t WS_PROJ = 349 * MiB;
constexpr size_t WS_MIXED = 509 * MiB;
constexpr size_t WS_DPOOL = 637 * MiB;
constexpr size_t WS_ACT = WS_DPOOL;
constexpr size_t WS_Y = WS_PROJ;
constexpr size_t WS_END = 701 * MiB;
static_assert(WS_Y + (size_t)NASG * DM * 2 <= WS_DPOOL, "Y overlay");
constexpr int CW_TMO = 0, CW_BAR = 1024, CW_CNT = 8192;

constexpr int RING_BYTES = 131072;
constexpr int TAB_OFF = RING_BYTES;
constexpr int TAB_UNITS = 14, TABRG_UNITS = 6;
constexpr int TABR_OFF = TAB_OFF + TAB_UNITS * 1024;
constexpr int TABG_OFF = TABR_OFF + TABRG_UNITS * 1024;
constexpr int EXPT_OFF = TABG_OFF + TABRG_UNITS * 1024;
constexpr int MISC_OFF = EXPT_OFF + 512;
constexpr int LDS_BYTES = 159744;
static_assert(MISC_OFF + 16 <= LDS_BYTES, "LDS map");

#define RLX_AGENT __ATOMIC_RELAXED, __HIP_MEMORY_SCOPE_AGENT
#define LDS_WAIT() asm volatile("s_waitcnt lgkmcnt(0)" ::: "memory")
#define VM_WAIT() asm volatile("s_waitcnt vmcnt(0)" ::: "memory")

__device__ __forceinline__ unsigned f2bf(float f) { unsigned u = __builtin_bit_cast(unsigned, f); return (u + 0x7fffu + ((u >> 16) & 1u)) >> 16; }

__device__ __forceinline__ float bflo(unsigned w) { return __builtin_bit_cast(float, w << 16); }
__device__ __forceinline__ float bfhi(unsigned w) { return __builtin_bit_cast(float, w & 0xffff0000u); }
typedef __bf16 bf16x2_t __attribute__((ext_vector_type(2)));
__device__ __forceinline__ unsigned cvt_pk_bf16(float lo, float hi) { f32x2 v = {lo, hi}; bf16x2_t b = __builtin_convertvector(v, bf16x2_t); return __builtin_bit_cast(unsigned, b); }
__device__ __forceinline__ unsigned pk2(float lo, float hi) { return cvt_pk_bf16(lo, hi); }
__device__ __forceinline__ unsigned pk4_fp8(float a, float b, float c, float d) { int r = 0; r = __builtin_amdgcn_cvt_pk_fp8_f32(a, b, r, false); r = __builtin_amdgcn_cvt_pk_fp8_f32(c, d, r, true); return (unsigned)r; }
constexpr float W8_SCALE = 256.0f, ACT8_SCALE = 8.0f, Y8_SCALE = 32.0f;
__device__ __forceinline__ float wave_sum(float v) {
#pragma unroll
    for (int o = 1; o < 64; o <<= 1) v += __shfl_xor(v, o);
    return v;
}

#define XB_TMO      128
#define XB_XCNT(j)  (256  + 64 * (j))
#define XB_XSUB(j)  (1280 + 64 * (j))
#define XB_XGEN(j)  (2304 + 64 * (j))
#define XB_TOP      3328
#define XB_TOPGEN   3392
#define XCD_BAR_WORDS 3456
#define XB_SPIN_CAP (1u << 18)
__device__ __forceinline__ unsigned xb_ld(unsigned* p)              { return __hip_atomic_load(p, __ATOMIC_RELAXED, __HIP_MEMORY_SCOPE_AGENT); }
__device__ __forceinline__ unsigned xb_add(unsigned* p, unsigned v) { return __hip_atomic_fetch_add(p, v, __ATOMIC_RELAXED, __HIP_MEMORY_SCOPE_AGENT); }
__device__ __forceinline__ unsigned xb_xcc_id() { return (unsigned)__builtin_amdgcn_s_getreg((3 << 11) | 20) & 0xFu; }
#define XB_SPIN(cond, bar) do { unsigned _sp = 0; while (cond) { __builtin_amdgcn_s_sleep(1); \
    if ((++_sp & 255u) == 0u) { if (xb_ld(&(bar)[XB_TMO])) break; if (_sp > XB_SPIN_CAP) { atomicAdd(&(bar)[XB_TMO], 1u); break; } } } } while (0)
struct XcdBarrier { unsigned* bar; unsigned x; volatile LAS unsigned* st; };
__device__ __forceinline__ XcdBarrier xcd_barrier_post(unsigned* bar, volatile LAS unsigned* st) {
    XcdBarrier b; b.bar = bar; b.x = xb_xcc_id(); b.st = st;
    if (threadIdx.x == 0) (void)xb_add(&bar[XB_XCNT(b.x)], 1u);
    return b;
}
__device__ __forceinline__ void xcd_barrier_complete(unsigned* bar, unsigned x, unsigned& nloc, unsigned& nx) {
    const unsigned G = gridDim.x * gridDim.y * gridDim.z;
    unsigned sum, cnt, mine, sp = 0u;
    for (;;) {
        sum = 0u; cnt = 0u; mine = 0u;
#pragma unroll
        for (unsigned j = 0; j < 16; ++j) { const unsigned c = xb_ld(&bar[XB_XCNT(j)]); sum += c; cnt += (c > 0u) ? 1u : 0u; mine = (j == x) ? c : mine; }
        if (sum == G) break;
        __builtin_amdgcn_s_sleep(1);
        if ((++sp & 255u) == 0u) { if (xb_ld(&bar[XB_TMO])) break; if (sp > XB_SPIN_CAP) { atomicAdd(&bar[XB_TMO], 1u); break; } }
    }
    nloc = mine > 0u ? mine : 1u; nx = cnt > 0u ? cnt : 1u;
}
__device__ __forceinline__ void xcd_barrier(const XcdBarrier& b) {
    asm volatile("s_waitcnt vmcnt(0)" ::: "memory");
    __syncthreads();
    if (threadIdx.x == 0) {
        unsigned* bar = b.bar;
        __builtin_amdgcn_s_waitcnt(0);
        unsigned nloc = b.st[0], nx = b.st[1];
        if (nloc == 0u) { xcd_barrier_complete(bar, b.x, nloc, nx); b.st[0] = nloc; b.st[1] = nx; }
        const unsigned old = xb_add(&bar[XB_XSUB(b.x)], 1u);
        const unsigned gen = old / nloc;
        if (old + 1u == (gen + 1u) * nloc) {
            __builtin_amdgcn_fence(__ATOMIC_RELEASE, "agent");
            asm volatile("s_waitcnt vmcnt(0)" ::: "memory");
            const unsigned og = xb_add(&bar[XB_TOP], 1u);
            const unsigned tg = og / nx;
            if (og + 1u == (tg + 1u) * nx) xb_add(&bar[XB_TOPGEN], 1u);
            else XB_SPIN(xb_ld(&bar[XB_TOPGEN]) == tg, bar);
            __builtin_amdgcn_fence(__ATOMIC_ACQUIRE, "agent");
            xb_add(&bar[XB_XGEN(b.x)], 1u);
            asm volatile("s_waitcnt vmcnt(0)" ::: "memory");
        } else {
            XB_SPIN(xb_ld(&bar[XB_XGEN(b.x)]) == gen, bar);
            __builtin_amdgcn_fence(__ATOMIC_ACQUIRE, "agent");
            asm volatile("s_waitcnt vmcnt(0)" ::: "memory");
        }
    }
    __syncthreads();
}

namespace pg8 {
constexpr int BM = 256, BK = 64, HALF = 128, HTB = HALF * BK * 2, STAGE_BYTES = 8 * HTB, NXCD = 8, WGM = 2;
static_assert(STAGE_BYTES == RING_BYTES, "stage region");
__host__ __device__ __forceinline__ int lds_byte(int r, int c) { const int st = (r >> 4) * 2 + (c >> 5), rr = r & 15, cc = c & 31, ob = rr * 64 + cc * 2; return st * 1024 + (ob ^ (((ob >> 9) & 1) << 5)); }
__host__ __device__ __forceinline__ void stage_rc(int b, int& R, int& C) { const int st = b / 1024, sb = b % 1024, swz = sb ^ (((sb >> 9) & 1) << 5); R = (st >> 1) * 16 + swz / 64; C = (st & 1) * 32 + (swz % 64) / 2; }
__host__ __device__ __forceinline__ int perm32(int rho) { const int n = rho >> 4, i = rho & 15; return 8 * (i >> 2) + 4 * n + (i & 3); }

struct Unit { int pm, pn, ord, e, cnt; };

struct StaticOrder {
    int nM, nN, nwg, G, c;
    __device__ void init(int M, int N, int G_, int c_) { nM = M / BM; nN = N / BM; nwg = nM * nN; G = G_; c = c_; }
    __device__ bool next(int i, int& pm, int& pn) const {
        const long L = (long)i * G + c; if (L >= nwg) return false;
        int wgid = (int)L; { const int q = nwg / NXCD, r = nwg % NXCD, xcd = wgid % NXCD, off = wgid / NXCD; wgid = (xcd < r ? xcd * (q + 1) : r * (q + 1) + (xcd - r) * q) + off; }
        const int nig = WGM * nN, gid = wgid / nig, fm = gid * WGM, gsz = (nM - fm) < WGM ? (nM - fm) : WGM;
        pm = fm + ((wgid % nig) % gsz); pn = (wgid % nig) / gsz; return true;
    }
};

typedef int v8i32 __attribute__((ext_vector_type(8)));
template <class Epi, class Prob, bool F8 = false, int KREP = 1, int EPI_REP = 1>
__device__ __forceinline__ void gemm_phase(LAS unsigned char* lds, const Prob& S, const Epi& E) {
    const int tid = threadIdx.x, wid = __builtin_amdgcn_readfirstlane(tid >> 6), lane = tid & 63, wr = wid >> 2, wc = wid & 3, fr = lane & 15, fq = lane >> 4;
    const int KB = S.KB, ntr = KB / 128, nt = ntr * KREP, kmask = ntr - 1;
    int Rr[2], Cc[2]; unsigned voffB[2][2];
#pragma unroll
    for (int i = 0; i < 2; ++i) { stage_rc(tid * 16 + i * 8192, Rr[i], Cc[i]);
#pragma unroll
        for (int h = 0; h < 2; ++h) { const int R = Rr[i], ii = R & 15, Rb = 64 * (R >> 5) + 16 * (ii >> 2) + 8 * h + 4 * ((R >> 4) & 1) + (ii & 3); voffB[h][i] = (unsigned)(Rb * KB + Cc[i] * 2); } }
    const size_t kstep = (size_t)(BK * 2);
    const size_t hstep = (size_t)HALF * KB;
    const unsigned ldsw = (unsigned)wid * 1024u;
    const int aoff = lds_byte(wr * 64 + fr, fq * 8), boff = lds_byte(wc * 32 + fr, fq * 8);
    const int aoff8a = lds_byte(wr * 64 + fr, fq * 16), aoff8b = lds_byte(wr * 64 + fr, fq * 16 + 8), boff8a = lds_byte(wc * 32 + fr, fq * 16), boff8b = lds_byte(wc * 32 + fr, fq * 16 + 8);
#define PG8_SA(b, h) (((b) * 2 + (h)) * HTB)
#define PG8_SB(b, h) ((4 + (b) * 2 + (h)) * HTB)
#define PG8_STAGE_X(bufoff, gbase, voff, aux) do { _Pragma("unroll") for (int _i = 0; _i < 2; ++_i) \
        __builtin_amdgcn_global_load_lds((const unsigned*)((const char*)(gbase) + (voff)[_i]), (LAS unsigned*)(lds + (bufoff) + ldsw + _i * 8192), 16, 0, aux); } while (0)
#define PG8_STAGE(bufoff, gbase, voff) do { if constexpr (((bufoff) < 4 * HTB) && Prob::A_NT) PG8_STAGE_X(bufoff, gbase, voff, 2); else PG8_STAGE_X(bufoff, gbase, voff, 0); } while (0)
#define PG8_LDA_(dst, b, h) do { _Pragma("unroll") for (int m = 0; m < 4; ++m) _Pragma("unroll") for (int k = 0; k < 2; ++k) dst[m][k] = *(const LAS bf16x8*)(lds + PG8_SA(b, h) + aoff + m * 2048 + k * 1024); } while (0)
#define PG8_LDB_(dst, b, h) do { _Pragma("unroll") for (int n = 0; n < 2; ++n) _Pragma("unroll") for (int k = 0; k < 2; ++k) dst[n][k] = *(const LAS bf16x8*)(lds + PG8_SB(b, h) + boff + n * 2048 + k * 1024); } while (0)
#define PG8_LD8(dst, pa, pb) do { const u32x4 _lo = *(const LAS u32x4*)(pa), _hi = *(const LAS u32x4*)(pb); dst = __builtin_bit_cast(v8i32, __builtin_shufflevector(_lo, _hi, 0, 1, 2, 3, 4, 5, 6, 7)); } while (0)
#define PG8_LDA8(dst, b, h) do { _Pragma("unroll") for (int m = 0; m < 4; ++m) PG8_LD8(dst[m], lds + PG8_SA(b, h) + aoff8a + m * 2048, lds + PG8_SA(b, h) + aoff8b + m * 2048); } while (0)
#define PG8_LDB8(dst, b, h) do { _Pragma("unroll") for (int n = 0; n < 2; ++n) PG8_LD8(dst[n], lds + PG8_SB(b, h) + boff8a + n * 2048, lds + PG8_SB(b, h) + boff8b + n * 2048); } while (0)
#define PG8_LDA(dst, b, h) do { if constexpr (F8) PG8_LDA8(dst##8, b, h); else PG8_LDA_(dst, b, h); } while (0)
#define PG8_LDB(dst, b, h) do { if constexpr (F8) PG8_LDB8(dst##8, b, h); else PG8_LDB_(dst, b, h); } while (0)
#define PG8_MFMA8(c, b8, a8) asm volatile("s_nop 1\n\tv_mfma_f32_16x16x128_f8f6f4 %0, %1, %2, %0" : "+v"(c) : "v"(b8), "v"(a8))
#define PG8_MMA(ai, bj, At, Bt) do { __builtin_amdgcn_s_setprio(1); _Pragma("unroll") for (int m = 0; m < 4; ++m) _Pragma("unroll") for (int n = 0; n < 2; ++n) { \
        if constexpr (F8) PG8_MFMA8(acc[ai][bj][m][n], Bt##8[n], At##8[m]); \
        else { _Pragma("unroll") for (int k = 0; k < 2; ++k) acc[ai][bj][m][n] = __builtin_amdgcn_mfma_f32_16x16x32_bf16(Bt[n][k], At[m][k], acc[ai][bj][m][n], 0, 0, 0); } } __builtin_amdgcn_s_setprio(0); } while (0)
#define PG8_WAIT_V(n) asm volatile("s_waitcnt vmcnt(" #n ")" ::: "memory")
#define PG8_WAIT_L(n) asm volatile("s_waitcnt lgkmcnt(" #n ")" ::: "memory")
#define PG8_BAR __builtin_amdgcn_s_barrier()
#define PG8_SCHED __builtin_amdgcn_sched_barrier(0)
    Unit cur, nxt; int ui = 0;
    if (!S.next(0, cur)) return;
    if (STAGGER_TICKS > 0) {
        const unsigned long long t0 = __builtin_amdgcn_s_memrealtime(), dl = (unsigned long long)(((blockIdx.x >> 3) & 15) * STAGGER_TICKS);
        while (__builtin_amdgcn_s_memrealtime() - t0 < dl) __builtin_amdgcn_s_sleep(4);
    }
    f32x4 acc[2][2][4][2];
    E.init(acc, cur, wr, wc, fr, fq);
    bf16x8 At[4][2], B0[2][2], B1[2][2];
    v8i32 At8[4], B08[2], B18[2];
    unsigned vc[2][2], vn[2][2];
    S.a_voff(cur, Rr, Cc, vc);
    const char* cA = S.a_base(cur); const char* cB = S.b_base(cur);
    PG8_STAGE(PG8_SB(0, 0), cB, voffB[0]); PG8_STAGE(PG8_SB(0, 1), cB, voffB[1]); PG8_STAGE(PG8_SA(0, 0), cA, vc[0]); PG8_STAGE(PG8_SA(0, 1), cA, vc[1]);
    if (wr == 1) PG8_BAR;
    PG8_WAIT_V(2); PG8_BAR;
    PG8_STAGE(PG8_SB(1, 0), cB + kstep, voffB[0]); PG8_STAGE(PG8_SA(1, 0), cA + kstep, vc[0]); PG8_STAGE(PG8_SB(1, 1), cB + kstep, voffB[1]);
    PG8_WAIT_V(6); PG8_BAR;
    for (;;) {
        const bool has_next = S.next(ui + 1, nxt);
        const char* nA = has_next ? S.a_base(nxt) : cA; const char* nB = has_next ? S.b_base(nxt) : cB;
        if (has_next) S.a_voff(nxt, Rr, Cc, vn); else { vn[0][0] = vc[0][0]; vn[0][1] = vc[0][1]; vn[1][0] = vc[1][0]; vn[1][1] = vc[1][1]; }
        for (int t = 0; t < nt; t += 2) {
            const bool last = (t == nt - 2);
            const int t1 = (KREP == 1) ? t + 1 : ((t + 1) & kmask), t2 = (KREP == 1) ? t + 2 : ((t + 2) & kmask);
            const char* a1 = cA + (size_t)t1 * kstep;
            const char* a2 = last ? nA : cA + (size_t)t2 * kstep; const char* b2 = last ? nB : cB + (size_t)t2 * kstep;
            const char* a3 = a2 + kstep; const char* b3 = b2 + kstep;
            unsigned w0[2], w1[2]; w0[0] = last ? vn[0][0] : vc[0][0]; w0[1] = last ? vn[0][1] : vc[0][1]; w1[0] = last ? vn[1][0] : vc[1][0]; w1[1] = last ? vn[1][1] : vc[1][1];
            PG8_LDB(B0, 0, 0); PG8_LDB(B1, 0, 1); PG8_SCHED; PG8_LDA(At, 0, 0); PG8_STAGE(PG8_SA(1, 1), a1, vc[1]);
            PG8_WAIT_V(8); PG8_WAIT_L(0); PG8_BAR; PG8_MMA(0, 0, At, B0); PG8_MMA(0, 1, At, B1); PG8_BAR; PG8_SCHED;
            PG8_LDA(At, 0, 1); PG8_STAGE(PG8_SB(0, 0), b2, voffB[0]); PG8_STAGE(PG8_SB(0, 1), b2, voffB[1]); PG8_STAGE(PG8_SA(0, 0), a2, w0);
            PG8_WAIT_V(8); PG8_WAIT_L(0); PG8_BAR; PG8_MMA(1, 0, At, B0); PG8_MMA(1, 1, At, B1); PG8_BAR; PG8_SCHED;
            PG8_LDB(B0, 1, 0); PG8_LDB(B1, 1, 1); PG8_SCHED; PG8_LDA(At, 1, 0); PG8_STAGE(PG8_SA(0, 1), a2, w1);
            PG8_WAIT_V(8); PG8_WAIT_L(0); PG8_BAR; PG8_MMA(0, 0, At, B0); PG8_MMA(0, 1, At, B1); PG8_BAR; PG8_SCHED;
            PG8_LDA(At, 1, 1); PG8_STAGE(PG8_SB(1, 0), b3, voffB[0]); PG8_STAGE(PG8_SB(1, 1), b3, voffB[1]); PG8_STAGE(PG8_SA(1, 0), a3, w0);
            PG8_WAIT_V(8); PG8_WAIT_L(0); PG8_BAR; PG8_MMA(1, 0, At, B0); PG8_MMA(1, 1, At, B1); PG8_BAR; PG8_SCHED;
        }
        if (wr == 0) PG8_BAR;
        if constexpr (F8) asm volatile("s_nop 15\n\ts_nop 7" ::: "memory");
#pragma unroll
        for (int er = 0; er < EPI_REP; ++er) E(acc, cur, wr, wc, fr, fq);
        if (!has_next) break;
        E.init(acc, nxt, wr, wc, fr, fq);
        cur = nxt; cA = nA; cB = nB; ++ui;
        vc[0][0] = vn[0][0]; vc[0][1] = vn[0][1]; vc[1][0] = vn[1][0]; vc[1][1] = vn[1][1];
        if (wr == 1) PG8_BAR;
    }
    PG8_WAIT_V(0);
    PG8_BAR;
#undef PG8_SA
#undef PG8_SB
#undef PG8_STAGE
#undef PG8_STAGE_X
#undef PG8_LDA
#undef PG8_LDB
#undef PG8_MMA
#undef PG8_MFMA8
#undef PG8_LDA_
#undef PG8_LDB_
#undef PG8_LD8
#undef PG8_LDA8
#undef PG8_LDB8
#undef PG8_WAIT_V
#undef PG8_WAIT_L
#undef PG8_BAR
#undef PG8_SCHED
}

struct DenseProb {
    static constexpr bool A_NT = DENSE_A_NT;
    const char* A; const char* Bt; int ldaB, KB, acolB;
    StaticOrder so;
    __device__ __forceinline__ bool next(int i, Unit& u) const { u.ord = i; u.e = 0; u.cnt = 256; return so.next(i, u.pm, u.pn); }
    __device__ __forceinline__ const char* a_base(const Unit& u) const { return A + (size_t)u.pm * BM * ldaB + (size_t)u.pn * acolB; }
    __device__ __forceinline__ const char* b_base(const Unit& u) const { return Bt + (size_t)u.pn * BM * KB; }
    __device__ __forceinline__ void a_voff(const Unit&, const int (&R)[2], const int (&C)[2], unsigned (&vo)[2][2]) const {
#pragma unroll
        for (int h = 0; h < 2; ++h)
#pragma unroll
            for (int i = 0; i < 2; ++i) vo[h][i] = (unsigned)((h * HALF + R[i]) * ldaB + C[i] * 2);
    }
};

struct MoeProb {
    static constexpr bool A_NT = false;
    const char* A; const char* Bt; int ldaB, KB, nN, shift;
    LAS const int* tab;
    LAS const int* expt;
    int G, c;
    __device__ __forceinline__ bool next(int i, Unit& u) const {
        const int per = G >> 3, xcd = c & 7, rank = c >> 3;
        if (expt[70]) {
            const int e = xcd + 8 * (rank >> 3), sub = rank & 7, cnt = expt[33 + e], T = (cnt + 255) >> 8;
            const int pn = (nN == 8) ? sub : (sub & 3), pm = (nN == 8) ? i : 2 * i + (sub >> 2);
            if (pm >= T || i >= TAB_UNITS) return false;
            u.e = e; u.pn = pn; u.pm = pm; u.ord = i; u.cnt = cnt - pm * 256; return true;
        }
        const int L = (i * 8 + xcd) * per + rank;
        if (L >= expt[32] || i >= TAB_UNITS) return false;
        int e = 0;
#pragma unroll 1
        while (e < 31 && L >= expt[e + 1]) ++e;
        const int q = L - expt[e], cnt = expt[33 + e], T = (cnt + 255) >> 8;
        u.e = e; u.pn = q / T; u.pm = q % T; u.ord = i; u.cnt = cnt - u.pm * 256; return true;
    }
    __device__ __forceinline__ const char* a_base(const Unit&) const { return A; }
    __device__ __forceinline__ const char* b_base(const Unit& u) const { return Bt + ((size_t)u.e * nN + u.pn) * BM * KB; }
    __device__ __forceinline__ void a_voff(const Unit& u, const int (&R)[2], const int (&C)[2], unsigned (&vo)[2][2]) const {
#pragma unroll
        for (int h = 0; h < 2; ++h)
#pragma unroll
            for (int i = 0; i < 2; ++i) { const unsigned row = ((unsigned)tab[u.ord * 256 + h * HALF + R[i]] & 0x7fffffffu) >> shift; vo[h][i] = row * (unsigned)ldaB + (unsigned)C[i] * 2u; }
    }
};

struct EpiBf16 {
    bf16_t* O; int ldc, cbase; float scale;
    __device__ __forceinline__ void init(f32x4 (&acc)[2][2][4][2], const Unit&, int, int, int, int) const {
#pragma unroll
        for (int a = 0; a < 2; ++a)
#pragma unroll
            for (int b = 0; b < 2; ++b)
#pragma unroll
                for (int m = 0; m < 4; ++m)
#pragma unroll
                    for (int n = 0; n < 2; ++n) acc[a][b][m][n] = (f32x4){0.f, 0.f, 0.f, 0.f};
    }
    __device__ __forceinline__ void operator()(const f32x4 (&acc)[2][2][4][2], const Unit& u, int wr, int wc, int fr, int fq) const {
        const int row0 = u.pm * BM + wr * 64 + fr, col0 = cbase + u.pn * BM + wc * 64 + 16 * fq;
#pragma unroll
        for (int ai = 0; ai < 2; ++ai)
#pragma unroll
            for (int m = 0; m < 4; ++m) { bf16_t* rowp = O + (size_t)(row0 + ai * HALF + m * 16) * ldc + col0;
#pragma unroll
                for (int bj = 0; bj < 2; ++bj) { const f32x4 v0 = acc[ai][bj][m][0] * scale, v1 = acc[ai][bj][m][1] * scale;
                    u32x4 w; w.x = cvt_pk_bf16(v0[0], v0[1]); w.y = cvt_pk_bf16(v0[2], v0[3]); w.z = cvt_pk_bf16(v1[0], v1[1]); w.w = cvt_pk_bf16(v1[2], v1[3]);
                    *(u32x4*)(rowp + bj * 8) = w; } }
    }
};
struct EpiResBf16 {
    const float* rms; bf16_t* O; int ldc; unsigned char* O8;
    __device__ __forceinline__ void init(f32x4 (&acc)[2][2][4][2], const Unit& u, int wr, int wc, int fr, int fq) const {
        const int row0 = u.pm * BM + wr * 64 + fr, col0 = u.pn * BM + wc * 64 + 16 * fq;
        u32x4 raw[2][4][2]; float rs[2][4];
#pragma unroll
        for (int ai = 0; ai < 2; ++ai)
#pragma unroll
            for (int m = 0; m < 4; ++m) { const int row = row0 + ai * HALF + m * 16; rs[ai][m] = rms[row];
#pragma unroll
                for (int bj = 0; bj < 2; ++bj) raw[ai][m][bj] = *(const GAS u32x4*)(O + (size_t)row * ldc + col0 + bj * 8); }
#pragma unroll
        for (int ai = 0; ai < 2; ++ai)
#pragma unroll
            for (int m = 0; m < 4; ++m)
#pragma unroll
                for (int bj = 0; bj < 2; ++bj) { const u32x4 w = raw[ai][m][bj]; const float r = rs[ai][m];
                    acc[ai][bj][m][0] = (f32x4){bflo(w.x) * r, bfhi(w.x) * r, bflo(w.y) * r, bfhi(w.y) * r};
                    acc[ai][bj][m][1] = (f32x4){bflo(w.z) * r, bfhi(w.z) * r, bflo(w.w) * r, bfhi(w.w) * r}; }
    }
    __device__ __forceinline__ void operator()(const f32x4 (&acc)[2][2][4][2], const Unit& u, int wr, int wc, int fr, int fq) const {
        const int row0 = u.pm * BM + wr * 64 + fr, col0 = u.pn * BM + wc * 64 + 16 * fq;
#pragma unroll
        for (int ai = 0; ai < 2; ++ai)
#pragma unroll
            for (int m = 0; m < 4; ++m) { bf16_t* rowp = O + (size_t)(row0 + ai * HALF + m * 16) * ldc + col0;
#pragma unroll
                for (int bj = 0; bj < 2; ++bj) { const f32x4 v0 = acc[ai][bj][m][0], v1 = acc[ai][bj][m][1];
                    u32x4 w; w.x = cvt_pk_bf16(v0[0], v0[1]); w.y = cvt_pk_bf16(v0[2], v0[3]); w.z = cvt_pk_bf16(v1[0], v1[1]); w.w = cvt_pk_bf16(v1[2], v1[3]);
                    *(u32x4*)(rowp + bj * 8) = w; } }
    }
};
struct EpiSwiGLU {
    unsigned char* act; LAS const int* tab; LAS const float* tabr; LAS const float* tabg;
    __device__ __forceinline__ void init(f32x4 (&acc)[2][2][4][2], const Unit&, int, int, int, int) const {
#pragma unroll
        for (int a = 0; a < 2; ++a)
#pragma unroll
            for (int b = 0; b < 2; ++b)
#pragma unroll
                for (int m = 0; m < 4; ++m)
#pragma unroll
                    for (int n = 0; n < 2; ++n) acc[a][b][m][n] = (f32x4){0.f, 0.f, 0.f, 0.f};
    }
    __device__ __forceinline__ void operator()(const f32x4 (&acc)[2][2][4][2], const Unit& u, int wr, int wc, int fr, int fq) const {
        const int col0 = u.pn * HALF + wc * 32 + 8 * fq;
#pragma unroll
        for (int ai = 0; ai < 2; ++ai)
#pragma unroll
            for (int m = 0; m < 4; ++m) { const int rl = ai * HALF + wr * 64 + m * 16 + fr; const int a = tab[u.ord * 256 + rl];
                const float r = tabr[u.ord * 256 + rl], rg = tabg[u.ord * 256 + rl];
                if (a >= 0) { float o[8];
#pragma unroll
                    for (int n = 0; n < 2; ++n)
#pragma unroll
                        for (int j = 0; j < 4; ++j) { const float g = acc[ai][0][m][n][j] * r; o[n * 4 + j] = g * __builtin_amdgcn_rcpf(1.0f + __builtin_amdgcn_exp2f(g * -1.4426950408889634f)) * (acc[ai][1][m][n][j] * rg); }
                    u32x2 w; w.x = pk4_fp8(o[0], o[1], o[2], o[3]); w.y = pk4_fp8(o[4], o[5], o[6], o[7]);
                    *(u32x2*)(act + (size_t)a * DEXP + col0) = w; } }
    }
};
struct EpiScatterF8 {
    unsigned char* Y; int ldc; LAS const int* tab; float scale;
    __device__ __forceinline__ void init(f32x4 (&acc)[2][2][4][2], const Unit&, int, int, int, int) const {
#pragma unroll
        for (int a = 0; a < 2; ++a)
#pragma unroll
            for (int b = 0; b < 2; ++b)
#pragma unroll
                for (int m = 0; m < 4; ++m)
#pragma unroll
                    for (int n = 0; n < 2; ++n) acc[a][b][m][n] = (f32x4){0.f, 0.f, 0.f, 0.f};
    }
    __device__ __forceinline__ void operator()(const f32x4 (&acc)[2][2][4][2], const Unit& u, int wr, int wc, int fr, int fq) const {
        const int col0 = u.pn * BM + wc * 64 + 16 * fq;
#pragma unroll
        for (int ai = 0; ai < 2; ++ai)
#pragma unroll
            for (int m = 0; m < 4; ++m) { const int rl = ai * HALF + wr * 64 + m * 16 + fr; const int a = tab[u.ord * 256 + rl];
                if (a >= 0) { const f32x4 v0 = acc[ai][0][m][0] * scale, v1 = acc[ai][0][m][1] * scale, v2 = acc[ai][1][m][0] * scale, v3 = acc[ai][1][m][1] * scale;
                    u32x4 w; w.x = pk4_fp8(v0[0], v0[1], v0[2], v0[3]); w.y = pk4_fp8(v1[0], v1[1], v1[2], v1[3]); w.z = pk4_fp8(v2[0], v2[1], v2[2], v2[3]); w.w = pk4_fp8(v3[0], v3[1], v3[2], v3[3]);
                    *(u32x4*)(Y + (size_t)a * ldc + col0) = w; } }
    }
};
}

struct Frame {
    LAS unsigned char* lds;
    gu32* ctl;
    int tid, lane, wave, G, bx;
    const float *x, *norm_mix, *w_in, *q_norm, *k_norm, *sinks, *w_pool, *pool_scale, *w_out, *norm_ffn, *w_coarse, *b_coarse, *w_fine, *b_fine, *w_gate, *w_up, *w_down;
    float* out;
    float *rope, *rinv, *rtok, *gate;
    bf16_t *Wr, *Wpool, *Win, *Wout, *XB, *PROJ, *MIXED, *DPOOL, *Y;
    unsigned char *Wgu8, *Wd8, *H8, *ACT8;
    int* rowl;
};

__device__ __forceinline__ void tr_item(const float* W, int N, int k0, int n0, bf16_t* dst0, int Kd, const float* gk, const float* gn, LAS float* scr, int lane) {
    const int kk0 = lane >> 3, n4 = (lane & 7) * 4;
    f32x4 v[8];
#pragma unroll
    for (int i = 0; i < 8; ++i) v[i] = __builtin_nontemporal_load((const GAS f32x4*)(W + (size_t)(k0 + 8 * i + kk0) * N + n0 + n4));
    f32x4 sn = (f32x4){1.f, 1.f, 1.f, 1.f}; if (gn) sn = *(const GAS f32x4*)(gn + n0 + n4);
#pragma unroll
    for (int i = 0; i < 8; ++i) { const float g = gk ? gk[k0 + 8 * i + kk0] : 1.0f; const f32x4 w = v[i] * sn * g; LAS float* d = scr + (8 * i + kk0) * 33 + n4; d[0] = w.x; d[1] = w.y; d[2] = w.z; d[3] = w.w; }
    LDS_WAIT(); asm volatile("" ::: "memory");
    const int c = lane & 7;
#pragma unroll
    for (int j = 0; j < 4; ++j) { const int n = (lane >> 3) + 8 * j; const LAS float* s = scr + (8 * c) * 33 + n;
        u32x4 o; o.x = pk2(s[0 * 33], s[1 * 33]); o.y = pk2(s[2 * 33], s[3 * 33]); o.z = pk2(s[4 * 33], s[5 * 33]); o.w = pk2(s[6 * 33], s[7 * 33]);
        *(GAS u32x4*)(dst0 + (size_t)n * Kd + k0 + 8 * c) = o; }
    LDS_WAIT(); asm volatile("" ::: "memory");
}

__device__ __forceinline__ void tr_item8(const float* W, int N, int k0, int n0, unsigned char* dst0, int Kd, const float* gk, LAS float* scr, int lane, int gu = 0) {
    const int kk0 = lane >> 3, n4 = (lane & 7) * 4;
    f32x4 v[8];
#pragma unroll
    for (int i = 0; i < 8; ++i) v[i] = __builtin_nontemporal_load((const GAS f32x4*)(W + (size_t)(k0 + 8 * i + kk0) * N + n0 + n4));
#pragma unroll
    for (int i = 0; i < 8; ++i) { const float g = (gk ? gk[k0 + 8 * i + kk0] : 1.0f) * W8_SCALE; const f32x4 w = v[i] * g; LAS float* d = scr + (8 * i + kk0) * 33 + n4; d[0] = w.x; d[1] = w.y; d[2] = w.z; d[3] = w.w; }
    LDS_WAIT(); asm volatile("" ::: "memory");
    const int c = lane & 7;
#pragma unroll
    for (int j = 0; j < 4; ++j) { const int n = (lane >> 3) + 8 * j; const LAS float* s = scr + (8 * c) * 33 + n;
        u32x2 o; o.x = pk4_fp8(s[0 * 33], s[1 * 33], s[2 * 33], s[3 * 33]); o.y = pk4_fp8(s[4 * 33], s[5 * 33], s[6 * 33], s[7 * 33]);
        const int x = n0 + n, drow = gu ? (256 * (x >> 7) + 64 * ((x >> 5) & 3) + 16 * ((x >> 3) & 3) + 8 * (gu - 1) + (x & 7)) : n;
        *(GAS u32x2*)(dst0 + (size_t)drow * Kd + k0 + 8 * c) = o; }
    LDS_WAIT(); asm volatile("" ::: "memory");
}

__device__ __forceinline__ void wd_convert(Frame& F, int iw, int nwg) {
    LAS float* scr = (LAS float*)(F.lds + F.wave * 16384);
    constexpr int I_D = NEXP * (DEXP / 64) * (DM / 32);
    for (int r = iw * 8 + F.wave; r < I_D; r += nwg * 8) {
        const int per = (DEXP / 64) * (DM / 32), e = r / per, q = r % per, nb = DM / 32, kb = q / nb, nn = q % nb;
        tr_item8(F.w_down + (size_t)e * DEXP * DM, DM, 64 * kb, 32 * nn, F.Wd8 + ((size_t)e * DM + 32 * nn) * DEXP, DEXP, nullptr, scr, F.lane);
    }
}

__device__ __forceinline__ void gu_convert(Frame& F) {
    LAS float* scr = (LAS float*)(F.lds + F.wave * 16384);
    constexpr int I_G = NEXP * (DM / 64) * (DEXP / 32);
    for (int it = F.bx * 8 + F.wave; it < 2 * I_G; it += F.G * 8) {
        int r = it; const int up = r >= I_G; if (up) r -= I_G;
        const int per = (DM / 64) * (DEXP / 32), e = r / per, q = r % per, nb = DEXP / 32, kb = q / nb, nn = q % nb, n0 = 32 * nn;
        const float* W = (up ? F.w_up : F.w_gate) + (size_t)e * DM * DEXP;
        tr_item8(W, DEXP, 64 * kb, n0, F.Wgu8 + (size_t)e * 1024 * DM, DM, F.norm_ffn, scr, F.lane, up ? 2 : 1);
    }
}

__device__ __forceinline__ void p0_prologue(Frame& F) {
    const int gw = F.bx * 8 + F.wave, NGW = F.G * 8, gt = F.bx * 512 + F.tid, NGT = F.G * 512;
    LAS float* scr = (LAS float*)(F.lds + F.wave * 16384);
    for (int i = gt; i < SEQ * 8; i += NGT) {
        const int pos = i >> 3, j = i & 7;
        const double invf[8] = {1.0, 0.19392274474868576, 0.03760603093086393, 0.007292664737217109, 0.001414213562373095, 0.0002742481756762073, 5.318295896944988e-05, 1.031338537721246e-05};
        double f = invf[0];
#pragma unroll
        for (int q = 1; q < 8; ++q) f = (j == q) ? invf[q] : f;
        double s, c; sincos((double)pos * f, &s, &c);
        F.rope[pos * 16 + j] = (float)c; F.rope[pos * 16 + 8 + j] = (float)s;
    }
    for (int i = gt; i < 64 * DM; i += NGT) {
        const int j = i / DM, k = i % DM; float v = 0.f;
        if (j < 4) v = F.w_coarse[k * 4 + j] * F.norm_ffn[k]; else if (j < 36) v = F.w_fine[k * 32 + (j - 4)] * F.norm_ffn[k];
        const unsigned hi = f2bf(v); const float lo = v - bflo(hi);
        F.Wr[i] = (bf16_t)hi; F.Wr[64 * DM + i] = (bf16_t)f2bf(lo);
    }
    constexpr int I_IN = (DM / 64) * (INW / 32), I_OUT = (1024 / 64) * (DM / 32), I_POOL = 0, I_G = NEXP * (DM / 64) * (DEXP / 32);
    constexpr int NITEMS = I_IN + I_OUT + I_POOL;
    for (int it = gw; it < NITEMS; it += NGW) {
        int r = it;
        if (r < I_IN) { const int nb = INW / 32, kb = r / nb, nn = r % nb; tr_item(F.w_in, INW, 64 * kb, 32 * nn, F.Win + (size_t)(32 * nn) * DM, DM, F.norm_mix, nullptr, scr, F.lane); continue; } r -= I_IN;
        if (r < I_OUT) { const int nb = DM / 32, kb = r / nb, nn = r % nb; tr_item(F.w_out, DM, 64 * kb, 32 * nn, F.Wout + (size_t)(32 * nn) * DM, DM, nullptr, nullptr, scr, F.lane); continue; } r -= I_OUT;
    }
    for (int wt = F.bx; wt < 256; wt += F.G) {
        const int pr = wt >> 3, g = pr >> 3, c0 = (pr & 7) * 32, n0 = ((wt & 7) * 8 + F.wave) * 32, i = F.lane & 31, kk = F.lane >> 5;
        LAS float* wp = (LAS float*)F.lds;
        __syncthreads();
        for (int e = F.tid; e < 32 * 256; e += 512) { const int c = e >> 8, j = e & 255; wp[c * 257 + j] = F.w_pool[(size_t)g * 65536 + (size_t)(c0 + c) * 256 + j] * F.pool_scale[g * 256 + j]; }
        __syncthreads();
        const float* ap = F.w_out + (size_t)(1024 + g * 256 + kk) * DM + n0 + i;
        const LAS float* bp = wp + i * 257 + kk;
        f32x16 acc = {};
#pragma unroll 16
        for (int j0 = 0; j0 < 256; j0 += 2) acc = __builtin_amdgcn_mfma_f32_32x32x2f32(ap[(size_t)j0 * DM], bp[j0], acc, 0, 0, 0);
        bf16_t* op = F.Wout + (size_t)n0 * DM + 1024 + g * 256 + c0 + i;
#pragma unroll
        for (int r = 0; r < 16; ++r) { const int nr = (r & 3) + 8 * (r >> 2) + 4 * kk; op[(size_t)nr * DM] = (bf16_t)f2bf(acc[r]); }
    }
    __syncthreads();
    for (int m = gw; m < NTOK; m += NGW) {
        const GAS f32x4* xr = (const GAS f32x4*)(F.x + (size_t)m * DM) + F.lane;
        f32x4 v[8]; float s = 0.f;
#pragma unroll
        for (int j = 0; j < 8; ++j) { v[j] = __builtin_nontemporal_load(xr + 64 * j); s += (v[j].x * v[j].x + v[j].y * v[j].y) + (v[j].z * v[j].z + v[j].w * v[j].w); }
        s = wave_sum(s);
        const float rms = sqrtf(s * (1.0f / DM) + EPS), rr = 1.0f / rms;
        if (F.lane == 0) F.rinv[m] = rms;
        GAS u32x2* o8 = (GAS u32x2*)(F.XB + (size_t)m * DM) + F.lane;
#pragma unroll
        for (int j = 0; j < 8; ++j) { u32x2 w; w.x = pk2(v[j].x * rr, v[j].y * rr); w.y = pk2(v[j].z * rr, v[j].w * rr); o8[64 * j] = w; }
    }
}

struct PoolSt { int it; float S[8]; bool active; };
struct PoolGeo { const bf16_t* up; bf16_t* dp; int w, pos0; };
__device__ __forceinline__ PoolGeo pool_geo(const Frame& F, int it) {
    const int ri = it >> 7, c8 = it & 127, t0 = ri * 32; PoolGeo g;
    g.w = 2 << (c8 >> 5); g.pos0 = t0 & (SEQ - 1); g.up = F.PROJ + (size_t)t0 * INW + UOFF + c8 * 8; g.dp = F.MIXED + (size_t)t0 * DM + 1024 + c8 * 8; return g;
}
__device__ __forceinline__ void pool_begin(Frame& F, int it, PoolSt& ps) {
    const int NITEM = (NTOK / 32) * 128;
    ps.active = it < NITEM; ps.it = ps.active ? it : 0;
    const PoolGeo g = pool_geo(F, ps.it);
#pragma unroll
    for (int j = 0; j < 8; ++j) ps.S[j] = 0.f;
    for (int i0 = 1; i0 < g.w; i0 += 5) { u32x4 pr[5];
#pragma unroll
        for (int q = 0; q < 5; ++q) { const int i = i0 + q; pr[q] = (u32x4){0u, 0u, 0u, 0u}; if (i < g.w && g.pos0 - i >= 0) pr[q] = *(const GAS u32x4*)(g.up - (ptrdiff_t)i * INW); }
#pragma unroll
        for (int q = 0; q < 5; ++q) { const u32x4 raw = pr[q];
            ps.S[0] += bflo(raw.x); ps.S[1] += bfhi(raw.x); ps.S[2] += bflo(raw.y); ps.S[3] += bfhi(raw.y); ps.S[4] += bflo(raw.z); ps.S[5] += bfhi(raw.z); ps.S[6] += bflo(raw.w); ps.S[7] += bfhi(raw.w); } }
}
__device__ __forceinline__ void pool_issue(const Frame& F, const PoolSt& ps, int k, u32x4 (&nw)[4]) {
    const PoolGeo g = pool_geo(F, ps.it);
#pragma unroll
    for (int q = 0; q < 4; ++q) nw[q] = *(const GAS u32x4*)(g.up + (ptrdiff_t)(4 * k + q) * INW);
}
__device__ __forceinline__ void pool_finish(const Frame& F, PoolSt& ps, int k, const u32x4 (&nw)[4]) {
    const PoolGeo g = pool_geo(F, ps.it);
    u32x4 od[4];
#pragma unroll
    for (int q = 0; q < 4; ++q) { const int t = 4 * k + q; const int to = t - g.w + 1, toc = (g.pos0 + to >= 0) ? to : t;
        od[q] = *(const GAS u32x4*)(g.up + (ptrdiff_t)toc * INW); }
#pragma unroll
    for (int q = 0; q < 4; ++q) { const int t = 4 * k + q; const u32x4 raw = nw[q]; const bool has_old = g.pos0 + t - g.w + 1 >= 0;
        const u32x4 old = has_old ? od[q] : (u32x4){0u, 0u, 0u, 0u};
        const float xv[8] = {bflo(raw.x), bfhi(raw.x), bflo(raw.y), bfhi(raw.y), bflo(raw.z), bfhi(raw.z), bflo(raw.w), bfhi(raw.w)};
        const int pos = g.pos0 + t; const float ic = __builtin_amdgcn_rcpf((float)((pos + 1 < g.w) ? (pos + 1) : g.w));
        float d[8];
#pragma unroll
        for (int j = 0; j < 8; ++j) { ps.S[j] += xv[j]; d[j] = ps.S[j] * ic - xv[j]; }
        u32x4 o; o.x = pk2(d[0], d[1]); o.y = pk2(d[2], d[3]); o.z = pk2(d[4], d[5]); o.w = pk2(d[6], d[7]);
        *(GAS u32x4*)(g.dp + (size_t)t * DM) = o;
        ps.S[0] -= bflo(old.x); ps.S[1] -= bfhi(old.x); ps.S[2] -= bflo(old.y); ps.S[3] -= bfhi(old.y); ps.S[4] -= bflo(old.z); ps.S[5] -= bfhi(old.z); ps.S[6] -= bflo(old.w); ps.S[7] -= bfhi(old.w); }
}

constexpr int AT_K = 0, AT_V = 32768, AT_VSTR = 520, AT_UNIT = 32768 + 64 * 520;
static_assert(2 * AT_UNIT <= EXPT_OFF, "attention LDS");
__device__ __forceinline__ void attn_super(Frame& F, int b, int n, int kp, PoolSt& ps, int step0) {
    LAS unsigned char* lds = F.lds;
    const int tid = F.tid, lane = F.lane, wid = F.wave;
    const size_t tok0 = (size_t)b * SEQ;
    const int g = wid & 3, ql = lane & 31, hi = lane >> 5;
    u32x4 qc[4], qn[4];
    { const int head = (2 * kp) * 4 + g, s0 = wid >> 2; const bf16_t* qp = F.PROJ + (tok0 + n * 128 + 32 * s0 + ql) * INW + QOFF + head * HD + hi * 8;
#pragma unroll
      for (int d0 = 0; d0 < 4; ++d0) qc[d0] = *(const GAS u32x4*)(qp + d0 * 16); }
    u32x4 kraw[2][4], vraw[2][2][2];
#pragma unroll
    for (int j = 0; j < 2; ++j) { const int kvh = 2 * kp + j;
#pragma unroll
        for (int i = 0; i < 4; ++i) { const int idx = i * 512 + tid, row = idx >> 3, c = idx & 7, pos = n * 128 - 128 + row, pc = pos < 0 ? 0 : pos;
            kraw[j][i] = *(const GAS u32x4*)(F.PROJ + (tok0 + pc) * INW + KOFF + kvh * HD + c * 8); }
#pragma unroll
        for (int i = 0; i < 2; ++i) { const int idx = i * 512 + tid, kpr = idx >> 3, c = idx & 7, pos = n * 128 - 128 + 2 * kpr, pc = pos < 0 ? 0 : pos;
            const bf16_t* p = F.PROJ + (tok0 + pc) * INW + VOFF + kvh * HD + c * 8; vraw[j][i][0] = *(const GAS u32x4*)p; vraw[j][i][1] = *(const GAS u32x4*)(p + INW); } }
    float kn[8];
#pragma unroll
    for (int q = 0; q < 8; ++q) kn[q] = F.k_norm[(tid & 7) * 8 + q];
#pragma unroll
    for (int j = 0; j < 2; ++j) {
#pragma unroll
        for (int i = 0; i < 4; ++i) {
            const int idx = i * 512 + tid, row = idx >> 3, c = idx & 7, pos = n * 128 - 128 + row;
            const u32x4 raw = kraw[j][i];
            float xv[8] = {bflo(raw.x), bfhi(raw.x), bflo(raw.y), bfhi(raw.y), bflo(raw.z), bfhi(raw.z), bflo(raw.w), bfhi(raw.w)};
            float ss = 0.f;
#pragma unroll
            for (int q = 0; q < 8; ++q) ss += xv[q] * xv[q];
            ss += __shfl_xor(ss, 1); ss += __shfl_xor(ss, 2); ss += __shfl_xor(ss, 4);
            const float rn = __builtin_amdgcn_rsqf(ss * (1.0f / HD) + EPS);
#pragma unroll
            for (int q = 0; q < 8; ++q) xv[q] = xv[q] * rn * kn[q];
            const int pp = pos >= 0 ? pos : 0;
            f32x4 cs4[2] = {(f32x4){1.f, 1.f, 1.f, 1.f}, (f32x4){1.f, 1.f, 1.f, 1.f}}, sn4[2] = {(f32x4){0.f, 0.f, 0.f, 0.f}, (f32x4){0.f, 0.f, 0.f, 0.f}};
            if (c < 2) { const GAS f32x4* rp = (const GAS f32x4*)(F.rope + pp * 16); cs4[0] = rp[0]; cs4[1] = rp[1]; sn4[0] = rp[2]; sn4[1] = rp[3]; }
#pragma unroll
            for (int q = 0; q < 8; ++q) { const float pr = __shfl_xor(xv[q], 1); const float cs = cs4[q >> 2][q & 3], sn = sn4[q >> 2][q & 3];
                const float r0 = xv[q] * cs - pr * sn, r1 = xv[q] * cs + pr * sn; xv[q] = (c == 0) ? r0 : (c == 1) ? r1 : xv[q]; }
            u32x4 w; w.x = pk2(xv[0], xv[1]); w.y = pk2(xv[2], xv[3]); w.z = pk2(xv[4], xv[5]); w.w = pk2(xv[6], xv[7]);
            *(LAS u32x4*)(lds + j * AT_UNIT + AT_K + row * 128 + ((c ^ (row & 7)) * 16)) = w;
        }
#pragma unroll
        for (int i = 0; i < 2; ++i) {
            const int idx = i * 512 + tid, kpr = idx >> 3, c = idx & 7;
            const u32x4 r0 = vraw[j][i][0], r1 = vraw[j][i][1];
            const unsigned a0[4] = {r0.x, r0.y, r0.z, r0.w}, a1[4] = {r1.x, r1.y, r1.z, r1.w};
#pragma unroll
            for (int q = 0; q < 4; ++q) {
                const unsigned lo = (a0[q] & 0xffffu) | (a1[q] << 16), hi2 = (a0[q] >> 16) | (a1[q] & 0xffff0000u);
                *(LAS unsigned*)(lds + j * AT_UNIT + AT_V + (c * 8 + 2 * q) * AT_VSTR + kpr * 4) = lo;
                *(LAS unsigned*)(lds + j * AT_UNIT + AT_V + (c * 8 + 2 * q + 1) * AT_VSTR + kpr * 4) = hi2;
            }
        }
    }
    __syncthreads();
    const float SC = 0.125f * 1.4426950408889634f;
    float cbound;
    { float gq = fabsf(F.q_norm[lane]), gk = fabsf(F.k_norm[lane]);
#pragma unroll
      for (int o = 1; o < 64; o <<= 1) { gq = fmaxf(gq, __shfl_xor(gq, o)); gk = fmaxf(gk, __shfl_xor(gk, o)); }
      cbound = 64.0f * SC * gq * gk * 1.02f; }
    const bf16x8 ones8 = {(short)0x3F80, (short)0x3F80, (short)0x3F80, (short)0x3F80, (short)0x3F80, (short)0x3F80, (short)0x3F80, (short)0x3F80};
#pragma unroll 1
    for (int item = 0; item < 4; ++item) {
        const int j = item >> 1, s = (wid >> 2) + 2 * (item & 1), head = (2 * kp + j) * 4 + g;
        const int qpos = n * 128 + 32 * s + ql;
        const int kbase = j * AT_UNIT + AT_K, vbase = j * AT_UNIT + AT_V;
        if (item < 3) {
            const int jn = (item + 1) >> 1, sn = (wid >> 2) + 2 * ((item + 1) & 1), hn = (2 * kp + jn) * 4 + g;
            const bf16_t* qp = F.PROJ + (tok0 + n * 128 + 32 * sn + ql) * INW + QOFF + hn * HD + hi * 8;
#pragma unroll
            for (int d0 = 0; d0 < 4; ++d0) qn[d0] = *(const GAS u32x4*)(qp + d0 * 16);
        }
        const float sink2 = F.sinks[head] * 1.4426950408889634f;
        float qv[4][8];
        float ss = 0.f;
#pragma unroll
        for (int d0 = 0; d0 < 4; ++d0) { const u32x4 raw = qc[d0];
            qv[d0][0] = bflo(raw.x); qv[d0][1] = bfhi(raw.x); qv[d0][2] = bflo(raw.y); qv[d0][3] = bfhi(raw.y); qv[d0][4] = bflo(raw.z); qv[d0][5] = bfhi(raw.z); qv[d0][6] = bflo(raw.w); qv[d0][7] = bfhi(raw.w);
#pragma unroll
            for (int q = 0; q < 8; ++q) ss += qv[d0][q] * qv[d0][q]; }
        ss += __shfl_xor(ss, 32);
        const float rn = SC * __builtin_amdgcn_rsqf(ss * (1.0f / HD) + EPS);
#pragma unroll
        for (int d0 = 0; d0 < 4; ++d0) { const GAS f32x4* gp = (const GAS f32x4*)(F.q_norm + d0 * 16 + hi * 8); const f32x4 g0 = gp[0], g1 = gp[1];
            const float gq[8] = {g0.x, g0.y, g0.z, g0.w, g1.x, g1.y, g1.z, g1.w};
#pragma unroll
            for (int q = 0; q < 8; ++q) qv[d0][q] = qv[d0][q] * rn * gq[q]; }
        { const GAS f32x4* rp = (const GAS f32x4*)(F.rope + qpos * 16); const f32x4 c0 = rp[0], c1 = rp[1], s0 = rp[2], s1 = rp[3];
          const float cs8[8] = {c0.x, c0.y, c0.z, c0.w, c1.x, c1.y, c1.z, c1.w}, sn8[8] = {s0.x, s0.y, s0.z, s0.w, s1.x, s1.y, s1.z, s1.w};
#pragma unroll
          for (int q = 0; q < 8; ++q) { const float pr = __shfl_xor(qv[0][q], 32);
              qv[0][q] = (hi == 0) ? (qv[0][q] * cs8[q] - pr * sn8[q]) : (qv[0][q] * cs8[q] + pr * sn8[q]); } }
        bf16x8 qr[4];
#pragma unroll
        for (int d0 = 0; d0 < 4; ++d0) { u32x4 w; w.x = pk2(qv[d0][0], qv[d0][1]); w.y = pk2(qv[d0][2], qv[d0][3]); w.z = pk2(qv[d0][4], qv[d0][5]); w.w = pk2(qv[d0][6], qv[d0][7]);
            qr[d0] = __builtin_bit_cast(bf16x8, w); }
        const float mref = fmaxf(cbound, sink2);
        f32x16 p[5];
#pragma unroll
        for (int jt = 0; jt < 5; ++jt) {
            const int krow = 32 * (s + jt) + ql;
            f32x16 a;
#pragma unroll
            for (int r = 0; r < 16; ++r) a[r] = -mref;
#pragma unroll
            for (int d0 = 0; d0 < 4; ++d0) { const int c = 2 * d0 + hi;
                const bf16x8 kf = *(const LAS bf16x8*)(lds + kbase + krow * 128 + ((c ^ (krow & 7)) * 16));
                a = __builtin_amdgcn_mfma_f32_32x32x16_bf16(kf, qr[d0], a, 0, 0, 0); }
            p[jt] = a;
        }
#pragma unroll
        for (int jt = 0; jt < 5; ++jt)
#pragma unroll
            for (int r = 0; r < 16; ++r) p[jt][r] = __builtin_amdgcn_exp2f(p[jt][r]);
#pragma unroll
        for (int r = 0; r < 16; ++r) { const int kl = (r & 3) + 8 * (r >> 2) + 4 * hi;
            p[0][r] = (kl > ql) ? p[0][r] : 0.f; p[4][r] = (kl <= ql) ? p[4][r] : 0.f; }
        if (n == 0) {
#pragma unroll
            for (int jt = 0; jt < 4; ++jt) if (s + jt < 4) {
#pragma unroll
                for (int r = 0; r < 16; ++r) p[jt][r] = 0.f; }
        }
        u32x4 pnw[4]; const int pstep = step0 + item; const bool pdo = ps.active && pstep < 8;
        __builtin_amdgcn_sched_barrier(0); if (pdo) pool_issue(F, ps, pstep, pnw); __builtin_amdgcn_sched_barrier(0);
        f32x16 o[2]; o[0] = f32x16{}; o[1] = f32x16{}; f32x16 sacc = f32x16{};
#pragma unroll
        for (int jt = 0; jt < 5; ++jt)
#pragma unroll
            for (int s2 = 0; s2 < 2; ++s2) {
                u32x4 pw; pw.x = cvt_pk_bf16(p[jt][8 * s2 + 0], p[jt][8 * s2 + 1]); pw.y = cvt_pk_bf16(p[jt][8 * s2 + 2], p[jt][8 * s2 + 3]);
                pw.z = cvt_pk_bf16(p[jt][8 * s2 + 4], p[jt][8 * s2 + 5]); pw.w = cvt_pk_bf16(p[jt][8 * s2 + 6], p[jt][8 * s2 + 7]);
                const bf16x8 pf = __builtin_bit_cast(bf16x8, pw);
                const int kb = 32 * (s + jt) + 16 * s2 + 4 * hi;
#pragma unroll
                for (int dt = 0; dt < 2; ++dt) {
                    const LAS unsigned char* vp = lds + vbase + (dt * 32 + ql) * AT_VSTR + kb * 2;
                    const u32x2 v0 = *(const LAS u32x2*)vp, v1 = *(const LAS u32x2*)(vp + 16);
                    u32x4 vw; vw.x = v0.x; vw.y = v0.y; vw.z = v1.x; vw.w = v1.y;
                    o[dt] = __builtin_amdgcn_mfma_f32_32x32x16_bf16(__builtin_bit_cast(bf16x8, vw), pf, o[dt], 0, 0, 0);
                }
                sacc = __builtin_amdgcn_mfma_f32_32x32x16_bf16(ones8, pf, sacc, 0, 0, 0);
            }
        const float inv = __builtin_amdgcn_rcpf(sacc[0] + __builtin_amdgcn_exp2f(sink2 - mref));
        bf16_t* op = F.MIXED + (tok0 + qpos) * DM + head * HD + (hi ? 8 : 0);
#pragma unroll
        for (int dt = 0; dt < 2; ++dt)
#pragma unroll
            for (int gp = 0; gp < 2; ++gp) {
                const int r0 = 8 * gp;
                unsigned ax = cvt_pk_bf16(o[dt][r0 + 0] * inv, o[dt][r0 + 1] * inv), ay = cvt_pk_bf16(o[dt][r0 + 2] * inv, o[dt][r0 + 3] * inv);
                unsigned bx = cvt_pk_bf16(o[dt][r0 + 4] * inv, o[dt][r0 + 5] * inv), by = cvt_pk_bf16(o[dt][r0 + 6] * inv, o[dt][r0 + 7] * inv);
                { auto rr = __builtin_amdgcn_permlane32_swap(ax, bx, false, false); ax = rr[0]; bx = rr[1]; }
                { auto rr = __builtin_amdgcn_permlane32_swap(ay, by, false, false); ay = rr[0]; by = rr[1]; }
                u32x4 w; w.x = ax; w.y = ay; w.z = bx; w.w = by;
                *(GAS u32x4*)(op + dt * 32 + 16 * gp) = w;
            }
        if (pdo) pool_finish(F, ps, pstep, pnw);
#pragma unroll
        for (int d0 = 0; d0 < 4; ++d0) qc[d0] = qn[d0];
    }
    __syncthreads();
}

__device__ __forceinline__ void pool_diff(Frame& F, int first_it) {
    const int NITEM = (NTOK / 32) * 128;
    for (int it = first_it; it < NITEM; it += F.G * 512) {
        const int ri = it >> 7, c8 = it & 127, w = 2 << (c8 >> 5), t0 = ri * 32, pos0 = t0 & (SEQ - 1);
        const bf16_t* up = F.PROJ + (size_t)t0 * INW + UOFF + c8 * 8;
        float S[8];
#pragma unroll
        for (int j = 0; j < 8; ++j) S[j] = 0.f;
        for (int i0 = 1; i0 < w; i0 += 5) { u32x4 pr[5];
#pragma unroll
            for (int q = 0; q < 5; ++q) { const int i = i0 + q; pr[q] = (u32x4){0u, 0u, 0u, 0u}; if (i < w && pos0 - i >= 0) pr[q] = *(const GAS u32x4*)(up - (ptrdiff_t)i * INW); }
#pragma unroll
            for (int q = 0; q < 5; ++q) { const u32x4 raw = pr[q];
                S[0] += bflo(raw.x); S[1] += bfhi(raw.x); S[2] += bflo(raw.y); S[3] += bfhi(raw.y); S[4] += bflo(raw.z); S[5] += bfhi(raw.z); S[6] += bflo(raw.w); S[7] += bfhi(raw.w); } }
#pragma unroll 1
        for (int tc = 0; tc < 32; tc += 8) {
            u32x4 nw[8], od[8];
#pragma unroll
            for (int q = 0; q < 8; ++q) { const int t = tc + q; nw[q] = *(const GAS u32x4*)(up + (ptrdiff_t)t * INW);
                od[q] = (u32x4){0u, 0u, 0u, 0u}; if (pos0 + t - w + 1 >= 0) od[q] = *(const GAS u32x4*)(up + (ptrdiff_t)(t - w + 1) * INW); }
#pragma unroll
            for (int q = 0; q < 8; ++q) { const int t = tc + q; const u32x4 raw = nw[q], old = od[q];
                const float xv[8] = {bflo(raw.x), bfhi(raw.x), bflo(raw.y), bfhi(raw.y), bflo(raw.z), bfhi(raw.z), bflo(raw.w), bfhi(raw.w)};
                const int pos = pos0 + t; const float ic = 1.0f / (float)((pos + 1 < w) ? (pos + 1) : w);
                float d[8];
#pragma unroll
                for (int j = 0; j < 8; ++j) { S[j] += xv[j]; d[j] = S[j] * ic - xv[j]; }
                u32x4 o; o.x = pk2(d[0], d[1]); o.y = pk2(d[2], d[3]); o.z = pk2(d[4], d[5]); o.w = pk2(d[6], d[7]);
                *(GAS u32x4*)(F.MIXED + (size_t)(t0 + t) * DM + 1024 + c8 * 8) = o;
                S[0] -= bflo(old.x); S[1] -= bfhi(old.x); S[2] -= bflo(old.y); S[3] -= bfhi(old.y); S[4] -= bflo(old.z); S[5] -= bfhi(old.z); S[6] -= bflo(old.w); S[7] -= bfhi(old.w); }
        }
    }
}

constexpr int RT_WSTR = 528, RT_W = 0, RT_WLO = 64 * RT_WSTR, RT_L = 2 * 64 * RT_WSTR, RT_LSTR = 65;
__device__ __forceinline__ void route_phase(Frame& F, bool dry) {
    LAS unsigned char* lds = F.lds;
    const int tid = F.tid, lane = F.lane, wid = F.wave, row = lane & 15, kq = lane >> 4;
    for (int tile = F.bx; tile < NTOK / 128; tile += F.G) {
        const int t0 = tile * 128 + wid * 16;
        const bf16_t* hp = F.XB + (size_t)(t0 + row) * DM + kq * 8;
        unsigned char* h8 = F.H8 + (size_t)(t0 + row) * DM + kq * 8;
        f32x4 acc[4]; acc[0] = acc[1] = acc[2] = acc[3] = (f32x4){0.f, 0.f, 0.f, 0.f};
        float ssq = 0.f;
        u32x4 hv[8]; u32x4 wv[8];
#pragma unroll
        for (int ks = 0; ks < 8; ++ks) hv[ks] = *(const GAS u32x4*)(hp + ks * 32);
#pragma unroll
        for (int i = 0; i < 8; ++i) { const int p = i * 512 + tid, which = p >> 11, col = (p & 2047) >> 5, ch = p & 31;
            wv[i] = *(const GAS u32x4*)(F.Wr + (size_t)which * 64 * DM + (size_t)col * DM + ch * 8); }
#pragma unroll 1
        for (int kc = 0; kc < 8; ++kc) {
            __syncthreads();
#pragma unroll
            for (int i = 0; i < 8; ++i) { const int p = i * 512 + tid, which = p >> 11, col = (p & 2047) >> 5, ch = p & 31;
                *(LAS u32x4*)(lds + which * RT_WLO + col * RT_WSTR + ch * 16) = wv[i]; }
            __syncthreads();
            if (kc < 7) {
#pragma unroll
                for (int i = 0; i < 8; ++i) { const int p = i * 512 + tid, which = p >> 11, col = (p & 2047) >> 5, ch = p & 31;
                    wv[i] = *(const GAS u32x4*)(F.Wr + (size_t)which * 64 * DM + (size_t)col * DM + (kc + 1) * 256 + ch * 8); } }
#pragma unroll
            for (int ks = 0; ks < 8; ++ks) {
                const int k = kc * 256 + ks * 32;
                const u32x4 ah = hv[ks];
                if (kc < 7) hv[ks] = *(const GAS u32x4*)(hp + k + 256);
                { const float a0 = bflo(ah.x), a1 = bfhi(ah.x), a2 = bflo(ah.y), a3 = bfhi(ah.y), a4 = bflo(ah.z), a5 = bfhi(ah.z), a6 = bflo(ah.w), a7 = bfhi(ah.w);
                  ssq += (a0 * a0 + a1 * a1) + (a2 * a2 + a3 * a3) + (a4 * a4 + a5 * a5) + (a6 * a6 + a7 * a7);
                  u32x2 w8; w8.x = pk4_fp8(a0, a1, a2, a3); w8.y = pk4_fp8(a4, a5, a6, a7); *(GAS u32x2*)(h8 + k) = w8; }
                const bf16x8 Ah = __builtin_bit_cast(bf16x8, ah);
#pragma unroll
                for (int tc = 0; tc < 4; ++tc) {
                    const LAS unsigned char* bp = lds + (tc * 16 + row) * RT_WSTR + (ks * 32 + kq * 8) * 2;
                    const bf16x8 Bh = *(const LAS bf16x8*)bp, Bl = *(const LAS bf16x8*)(bp + RT_WLO);
                    acc[tc] = __builtin_amdgcn_mfma_f32_16x16x32_bf16(Ah, Bh, acc[tc], 0, 0, 0);
                    acc[tc] = __builtin_amdgcn_mfma_f32_16x16x32_bf16(Ah, Bl, acc[tc], 0, 0, 0);
                }
            }
        }
        ssq += __shfl_xor(ssq, 16); ssq += __shfl_xor(ssq, 32);
        const float rt = 1.0f / sqrtf(ssq * (1.0f / DM) + EPS);
        LAS float* L = (LAS float*)(lds + RT_L) + wid * 16 * RT_LSTR;
#pragma unroll
        for (int tc = 0; tc < 4; ++tc)
#pragma unroll
            for (int r = 0; r < 4; ++r) L[(kq * 4 + r) * RT_LSTR + tc * 16 + row] = acc[tc][r];
        LAS unsigned* lcnt = (LAS unsigned*)(lds + RT_L + 8 * 16 * RT_LSTR * 4); LAS unsigned* lbase = lcnt + NEXP;
        if (tid < NEXP) lcnt[tid] = 0u;
        __syncthreads();
        int me1 = 0, me2 = 0; unsigned r1 = 0u, r2 = 0u;
        if (lane < 16) {
            const int t = t0 + lane; const LAS float* Lt = L + lane * RT_LSTR;
            float c[4]; int grp = 0; float cm;
#pragma unroll
            for (int j = 0; j < 4; ++j) c[j] = Lt[j] * rt + F.b_coarse[j];
            cm = c[0];
#pragma unroll
            for (int j = 1; j < 4; ++j) if (c[j] > cm) { cm = c[j]; grp = j; }
            float den = 0.f;
#pragma unroll
            for (int j = 0; j < 4; ++j) den += __expf(c[j] - cm);
            const float pg = 1.0f / den;
            float f[8];
#pragma unroll
            for (int j = 0; j < 8; ++j) f[j] = Lt[4 + grp * 8 + j] * rt + F.b_fine[grp * 8 + j];
            int i1 = 0; float l1 = f[0];
#pragma unroll
            for (int j = 1; j < 8; ++j) if (f[j] > l1) { l1 = f[j]; i1 = j; }
            int i2 = -1; float l2 = -3.0e38f;
#pragma unroll
            for (int j = 0; j < 8; ++j) if (j != i1 && f[j] > l2) { l2 = f[j]; i2 = j; }
            const float e2 = __expf(l2 - l1), g1 = pg / (1.0f + e2), g2 = pg * e2 / (1.0f + e2);
            F.rtok[t] = rt; F.gate[2 * t] = g1; F.gate[2 * t + 1] = g2;
            me1 = grp * 8 + i1; me2 = grp * 8 + i2;
            r1 = __hip_atomic_fetch_add(&lcnt[me1], 1u, __ATOMIC_RELAXED, __HIP_MEMORY_SCOPE_WORKGROUP);
            r2 = __hip_atomic_fetch_add(&lcnt[me2], 1u, __ATOMIC_RELAXED, __HIP_MEMORY_SCOPE_WORKGROUP);
        }
        __syncthreads();
        if (tid < NEXP) { const unsigned c = lcnt[tid]; unsigned base = 0u;
            if (c && !dry) base = __hip_atomic_fetch_add((unsigned*)(F.ctl + CW_CNT + 64 * tid), c, RLX_AGENT);
            lbase[tid] = base; }
        __syncthreads();
        if (lane < 16 && !dry) { const int t = t0 + lane;
            F.rowl[(size_t)me1 * RCAP + lbase[me1] + r1] = 2 * t;
            F.rowl[(size_t)me2 * RCAP + lbase[me2] + r2] = 2 * t + 1; }
    }
}

__device__ __forceinline__ void moe_setup(Frame& F, int nN, bool with_rg) {
    LAS int* expt = (LAS int*)(F.lds + EXPT_OFF); LAS int* tab = (LAS int*)(F.lds + TAB_OFF); LAS float* tabr = (LAS float*)(F.lds + TABR_OFF); LAS float* tabg = (LAS float*)(F.lds + TABG_OFF);
    __syncthreads();
    if (F.tid < NEXP) expt[33 + F.tid] = (int)__hip_atomic_load((unsigned*)(F.ctl + CW_CNT + 64 * F.tid), RLX_AGENT);
    __syncthreads();
    if (F.tid == 0) { int acc = 0, maxT = 0;
        for (int e = 0; e < NEXP; ++e) { const int T = (expt[33 + e] + 255) >> 8; expt[e] = acc; acc += T * nN; maxT = T > maxT ? T : maxT; }
        expt[32] = acc; expt[70] = (MOE_OWNER && F.G == 256 && maxT <= 12) ? 1 : 0; expt[71] = maxT; }
    __syncthreads();
    pg8::MoeProb P; P.expt = expt; P.nN = nN; P.G = F.G; P.c = F.bx;
    pg8::Unit u;
    int nu = 0; while (P.next(nu, u)) ++nu;
    constexpr int KMAX = (TAB_UNITS * 256 + 511) / 512;
    int v[KMAX]; bool ok[KMAX];
#pragma unroll
    for (int k = 0; k < KMAX; ++k) { const int idx = F.tid + k * 512, i = idx >> 8, r = idx & 255; v[k] = 0; ok[k] = false;
        if (i < nu) { P.next(i, u); const int j = u.pm * 256 + r, cnt = expt[33 + u.e]; ok[k] = j < cnt; v[k] = F.rowl[(size_t)u.e * RCAP + (ok[k] ? j : 0)]; } }
#pragma unroll
    for (int k = 0; k < KMAX; ++k) { const int idx = F.tid + k * 512, i = idx >> 8; if (i < nu) tab[idx] = ok[k] ? v[k] : (v[k] | (int)0x80000000); }
    if (with_rg) {
        float rr[KMAX], gg[KMAX];
#pragma unroll
        for (int k = 0; k < KMAX; ++k) { const int idx = F.tid + k * 512, i = idx >> 8; rr[k] = 0.f; gg[k] = 0.f; if (i < nu && i < TABRG_UNITS) { rr[k] = F.rtok[v[k] >> 1]; gg[k] = F.gate[v[k]]; } }
#pragma unroll
        for (int k = 0; k < KMAX; ++k) { const int idx = F.tid + k * 512, i = idx >> 8; if (i < nu && i < TABRG_UNITS) { const float r = rr[k] * (1.0f / W8_SCALE); tabr[idx] = r; tabg[idx] = r * gg[k] * ACT8_SCALE; } }
    }
    __syncthreads();
}

__device__ __forceinline__ void combine_phase(Frame& F, float* dst) {
    const size_t NIT = (size_t)NTOK * (DM / 8), stride = (size_t)F.G * 512;
    const unsigned char* Y8 = (const unsigned char*)F.Y;
    constexpr float IS = 1.0f / Y8_SCALE;
    for (size_t it0 = (size_t)F.bx * 512 + F.tid; it0 < NIT; it0 += 4 * stride) {
        u32x4 h[4]; u32x2 y0[4], y1[4];
#pragma unroll
        for (int q = 0; q < 4; ++q) { const size_t it = it0 + q * stride; if (it < NIT) { const size_t t = it >> 8; const int c = (int)(it & 255) * 8;
            h[q] = *(const GAS u32x4*)(F.XB + t * DM + c); y0[q] = *(const GAS u32x2*)(Y8 + (2 * t) * DM + c); y1[q] = *(const GAS u32x2*)(Y8 + (2 * t + 1) * DM + c); } }
#pragma unroll
        for (int q = 0; q < 4; ++q) { const size_t it = it0 + q * stride; if (it < NIT) { const size_t t = it >> 8; const int c = (int)(it & 255) * 8;
            float* wp = dst + t * DM + c; f32x4 o0, o1;
            const f32x2 a0 = __builtin_amdgcn_cvt_pk_f32_fp8((int)y0[q].x, false), a1 = __builtin_amdgcn_cvt_pk_f32_fp8((int)y0[q].x, true), a2 = __builtin_amdgcn_cvt_pk_f32_fp8((int)y0[q].y, false), a3 = __builtin_amdgcn_cvt_pk_f32_fp8((int)y0[q].y, true);
            const f32x2 b0 = __builtin_amdgcn_cvt_pk_f32_fp8((int)y1[q].x, false), b1 = __builtin_amdgcn_cvt_pk_f32_fp8((int)y1[q].x, true), b2 = __builtin_amdgcn_cvt_pk_f32_fp8((int)y1[q].y, false), b3 = __builtin_amdgcn_cvt_pk_f32_fp8((int)y1[q].y, true);
            o0.x = bflo(h[q].x) + (a0.x + b0.x) * IS; o0.y = bfhi(h[q].x) + (a0.y + b0.y) * IS; o0.z = bflo(h[q].y) + (a1.x + b1.x) * IS; o0.w = bfhi(h[q].y) + (a1.y + b1.y) * IS;
            o1.x = bflo(h[q].z) + (a2.x + b2.x) * IS; o1.y = bfhi(h[q].z) + (a2.y + b2.y) * IS; o1.z = bflo(h[q].w) + (a3.x + b3.x) * IS; o1.w = bfhi(h[q].w) + (a3.y + b3.y) * IS;
            *(GAS f32x4*)wp = o0; *(GAS f32x4*)(wp + 4) = o1; } }
    }
}

struct Args { const float* in[17]; float* out; unsigned char* ws; int ph_lo, ph_hi, use_bar, pad; };
__global__ void __launch_bounds__(512, 2) hymba_fwd(Args args) {
    extern __shared__ __attribute__((aligned(16))) unsigned char lds[];
    Frame F;
    F.lds = (LAS unsigned char*)lds;
    F.tid = threadIdx.x; F.lane = F.tid & 63; F.wave = __builtin_amdgcn_readfirstlane(F.tid >> 6);
    F.G = gridDim.x; F.bx = blockIdx.x;
    unsigned char* ws = args.ws;
    F.ctl = (gu32*)(ws + WS_CTL);
    F.x = args.in[0]; F.norm_mix = args.in[1]; F.w_in = args.in[2]; F.q_norm = args.in[3]; F.k_norm = args.in[4]; F.sinks = args.in[5]; F.w_pool = args.in[6]; F.pool_scale = args.in[7];
    F.w_out = args.in[8]; F.norm_ffn = args.in[9]; F.w_coarse = args.in[10]; F.b_coarse = args.in[11]; F.w_fine = args.in[12]; F.b_fine = args.in[13]; F.w_gate = args.in[14]; F.w_up = args.in[15]; F.w_down = args.in[16];
    F.out = args.out;
    F.rope = (float*)(ws + WS_ROPE); F.rinv = (float*)(ws + WS_RINV); F.rtok = (float*)(ws + WS_RTOK); F.gate = (float*)(ws + WS_GATE);
    F.Wr = (bf16_t*)(ws + WS_WR); F.Wpool = (bf16_t*)(ws + WS_WPOOL); F.Win = (bf16_t*)(ws + WS_WIN); F.Wout = (bf16_t*)(ws + WS_WOUT); F.Wgu8 = ws + WS_WGU; F.Wd8 = ws + WS_WD; F.H8 = ws + WS_H8; F.ACT8 = ws + WS_ACT8;
    F.XB = (bf16_t*)(ws + WS_XB); F.PROJ = (bf16_t*)(ws + WS_PROJ); F.MIXED = (bf16_t*)(ws + WS_MIXED); F.DPOOL = (bf16_t*)(ws + WS_DPOOL); F.Y = (bf16_t*)(ws + WS_Y);
    F.rowl = (int*)(ws + WS_ROWL);
    if (F.tid < 4) ((LAS unsigned*)(F.lds + MISC_OFF))[F.tid] = 0u;
    __syncthreads();
    XcdBarrier bar; bar.bar = (unsigned*)(F.ctl + CW_BAR); bar.x = 0; bar.st = nullptr;
    if (args.use_bar) bar = xcd_barrier_post((unsigned*)(F.ctl + CW_BAR), (volatile LAS unsigned*)(F.lds + MISC_OFF));
    const int lo = args.ph_lo, hi = args.ph_hi;
#ifndef PHASE_MASK
#define PHASE_MASK 0x1ff
#endif
#define IN(k) (((PHASE_MASK >> (k)) & 1) && lo <= (k) && (k) < hi)
#define SEAM(k) do { if (IN(k) && IN((k) + 1)) xcd_barrier(bar); } while (0)

#define REPS(k) ((PROBE_DUP == (k)) ? 2 : 1)
    if (IN(0)) { for (int rep = 0; rep < REPS(0); ++rep) { if (rep) xcd_barrier(bar); p0_prologue(F); } SEAM(0); }
    if (IN(1)) {
        for (int rep = 0; rep < REPS(1); ++rep) { if (rep) xcd_barrier(bar);
        pg8::DenseProb P; P.A = (const char*)F.XB; P.Bt = (const char*)F.Win; P.ldaB = DM * 2; P.KB = DM * 2; P.acolB = 0; P.so.init(NTOK, INW, F.G, F.bx);
        pg8::EpiBf16 E{F.PROJ, INW, 0, 1.0f};
        pg8::gemm_phase(F.lds, P, E); }
        SEAM(1);
    }
    if (IN(2)) {
#if PROBE_DUP == 2
        { PoolSt ps; pool_begin(F, F.bx * 512 + F.tid, ps); int pstep = 0;
#pragma unroll 1
          for (int u = F.bx; u < BATCH * (SEQ / 128) * (NKV / 2); u += F.G) { const int kp = u & 1, n = (u >> 1) & 31, b = u >> 6; attn_super(F, b, n, kp, ps, pstep); pstep += 4; }
          if (ps.active) for (; pstep < 8; ++pstep) { u32x4 a4[4]; pool_issue(F, ps, pstep, a4); pool_finish(F, ps, pstep, a4); } }
        xcd_barrier(bar);
#elif PROBE_DUP == 22
        pool_diff(F, F.bx * 512 + F.tid + F.G * 512);
        xcd_barrier(bar);
#endif
        { PoolSt ps; pool_begin(F, F.bx * 512 + F.tid, ps); int pstep = 0;
#pragma unroll 1
          for (int u = F.bx; u < BATCH * (SEQ / 128) * (NKV / 2); u += F.G) { const int kp = u & 1, n = (u >> 1) & 31, b = u >> 6; attn_super(F, b, n, kp, ps, pstep); pstep += 4; }
          if (ps.active) for (; pstep < 8; ++pstep) { u32x4 a4[4]; pool_issue(F, ps, pstep, a4); pool_finish(F, ps, pstep, a4); } }
        pool_diff(F, F.bx * 512 + F.tid + F.G * 512);
        SEAM(2);
    }
    if (IN(4)) {
        for (int rep = 0; rep < REPS(4); ++rep) { if (rep) xcd_barrier(bar);
        pg8::DenseProb P; P.A = (const char*)F.MIXED; P.Bt = (const char*)F.Wout; P.ldaB = DM * 2; P.KB = DM * 2; P.acolB = 0; P.so.init(NTOK, DM, F.G, F.bx);
        pg8::EpiResBf16 E{F.rinv, F.XB, DM, F.H8};
        pg8::gemm_phase(F.lds, P, E); }
        SEAM(4);
    }
    if (IN(5)) { for (int rep = 0; rep < REPS(5); ++rep) { if (rep) xcd_barrier(bar); route_phase(F, rep + 1 < REPS(5)); __syncthreads(); if (rep == 0) gu_convert(F); } SEAM(5); }
    if (IN(6)) {
        for (int rep = 0; rep < REPS(6); ++rep) { if (rep) xcd_barrier(bar);
        moe_setup(F, 4, true);
        pg8::MoeProb P; P.A = (const char*)F.H8; P.Bt = (const char*)F.Wgu8; P.ldaB = DM; P.KB = DM; P.nN = 4; P.shift = 1; P.tab = (LAS const int*)(F.lds + TAB_OFF); P.expt = (LAS const int*)(F.lds + EXPT_OFF); P.G = F.G; P.c = F.bx;
        pg8::EpiSwiGLU E{F.ACT8, (LAS const int*)(F.lds + TAB_OFF), (LAS const float*)(F.lds + TABR_OFF), (LAS const float*)(F.lds + TABG_OFF)};
        pg8::gemm_phase<pg8::EpiSwiGLU, pg8::MoeProb, true>(F.lds, P, E);
        if (rep == 0) {
            LAS int* ex = (LAS int*)(F.lds + EXPT_OFF);
            const int U = ex[32], per = F.G >> 3, q = (F.bx & 7) * per + (F.bx >> 3);
            if (ex[70]) {
                if (F.tid == 0) { const int maxnu = (ex[71] + 1) >> 1; int idx = -1, nidle = 0;
                    for (int c2 = 0; c2 < 256; ++c2) { const int e2 = (c2 & 7) + 8 * ((c2 >> 3) >> 3), par = ((c2 >> 3) & 7) >> 2, T2 = (ex[33 + e2] + 255) >> 8, nu2 = (T2 - par + 1) >> 1;
                        if (nu2 < maxnu) { if (c2 == F.bx) idx = nidle; ++nidle; } }
                    ex[72] = idx; ex[73] = nidle; }
                __syncthreads();
                const int idx = ex[72], nidle = ex[73];
                if (nidle == 0) wd_convert(F, q, F.G); else if (idx >= 0) wd_convert(F, idx, nidle);
            } else {
                const int rounds = (U + F.G - 1) / F.G, nb = U - (rounds - 1) * F.G;
                if (U <= 0 || nb >= F.G) wd_convert(F, q, F.G); else if (q >= nb) wd_convert(F, q - nb, F.G - nb);
            }
        } }
        SEAM(6);
    }
    if (IN(7)) {
        for (int rep = 0; rep < REPS(7); ++rep) { if (rep) xcd_barrier(bar);
        moe_setup(F, 8, false);
        pg8::MoeProb P; P.A = (const char*)F.ACT8; P.Bt = (const char*)F.Wd8; P.ldaB = DEXP; P.KB = DEXP; P.nN = 8; P.shift = 0; P.tab = (LAS const int*)(F.lds + TAB_OFF); P.expt = (LAS const int*)(F.lds + EXPT_OFF); P.G = F.G; P.c = F.bx;
        pg8::EpiScatterF8 E{(unsigned char*)F.Y, DM, (LAS const int*)(F.lds + TAB_OFF), Y8_SCALE / (W8_SCALE * ACT8_SCALE)};
        pg8::gemm_phase<pg8::EpiScatterF8, pg8::MoeProb, true, 1, PROBE_EPI2 ? 2 : 1>(F.lds, P, E); }
        SEAM(7);
    }
    if (IN(8)) { for (int rep = 0; rep < REPS(8); ++rep) { if (rep) xcd_barrier(bar); combine_phase(F, (rep + 1 < REPS(8)) ? (float*)(ws + WS_END) : F.out); } }
#undef REPS
#undef IN
#undef SEAM
}

extern "C" void kernel_launch(void* const* d_in, const int* in_sizes, int n_in, void* d_out, int out_size, void* d_ws, size_t ws_size, hipStream_t stream) {
    static int grid = 0;
    if (grid == 0) {
        if (n_in != 17 || out_size != NTOK * DM || ws_size < WS_END) { fprintf(stderr, "kernel_launch: unexpected problem (n_in %d, out %d, ws %zu)\n", n_in, out_size, ws_size); grid = -1; return; }
        int dev = 0, cus = 0;
        if (hipGetDevice(&dev) != hipSuccess || hipDeviceGetAttribute(&cus, hipDeviceAttributeMultiprocessorCount, dev) != hipSuccess) { grid = -1; return; }
        if (hipFuncSetAttribute((const void*)hymba_fwd, hipFuncAttributeMaxDynamicSharedMemorySize, LDS_BYTES) != hipSuccess) { fprintf(stderr, "kernel_launch: hipFuncSetAttribute failed\n"); grid = -1; return; }
        int per_cu = 0;
        if (hipOccupancyMaxActiveBlocksPerMultiprocessor(&per_cu, (const void*)hymba_fwd, 512, LDS_BYTES) != hipSuccess || per_cu < 1) { fprintf(stderr, "kernel_launch: occupancy query says %d\n", per_cu); }
        (void)hipGetLastError();
        grid = cus - (cus % 8);
        if (grid <= 0) grid = -1;
    }
    if (grid < 0) return;
    if (hipMemsetAsync((char*)d_ws + WS_CTL, 0, CTL_ZERO_BYTES, stream) != hipSuccess) return;
    Args a{};
    for (int i = 0; i < 17; ++i) a.in[i] = (const float*)d_in[i];
    a.out = (float*)d_out; a.ws = (unsigned char*)d_ws;
    if (MK_N_LAUNCHES == 1) { a.ph_lo = 0; a.ph_hi = NPHASE; a.use_bar = 1; hipLaunchKernelGGL(hymba_fwd, dim3(grid), dim3(512), LDS_BYTES, stream, a); }
    else for (int p = 0; p < NPHASE; ++p) { a.ph_lo = p; a.ph_hi = p + 1; a.use_bar = 0; hipLaunchKernelGGL(hymba_fwd, dim3(grid), dim3(512), LDS_BYTES, stream, a); }
}
```

```cpp
#include <hip/hip_runtime.h>
#include <cstdio>
#include <cstdint>

#ifndef MK_N_LAUNCHES
#define MK_N_LAUNCHES 1
#endif
#ifndef DENSE_A_NT
#define DENSE_A_NT false
#endif
#ifndef MOE_OWNER
#define MOE_OWNER 1
#endif
#ifndef STORE_AUX
#define STORE_AUX 0
#endif
#ifndef STAGGER_TICKS
#define STAGGER_TICKS 0
#endif
#ifndef PROBE_EPI2
#define PROBE_EPI2 0
#endif
#ifndef PROBE_K2
#define PROBE_K2 0
#endif
#ifndef PROBE_DUP
#define PROBE_DUP -1
#endif

#define GAS __attribute__((address_space(1)))
#define LAS __attribute__((address_space(3)))
typedef unsigned short bf16_t;
typedef short bf16x8 __attribute__((ext_vector_type(8)));
typedef short s16x4 __attribute__((ext_vector_type(4)));
typedef float f32x4 __attribute__((ext_vector_type(4)));
typedef float f32x2 __attribute__((ext_vector_type(2)));
typedef float f32x16 __attribute__((ext_vector_type(16)));
typedef unsigned u32x4 __attribute__((ext_vector_type(4)));
typedef unsigned u32x2 __attribute__((ext_vector_type(2)));
typedef GAS unsigned gu32;

constexpr int BATCH = 8, SEQ = 4096, NTOK = BATCH * SEQ, DM = 2048;
constexpr int NH = 16, NKV = 4, HD = 64, INW = 2560, QOFF = 0, KOFF = 1024, VOFF = 1280, UOFF = 1536, PW = 1024;
constexpr int NEXP = 32, DEXP = 512, NASG = NTOK * 2, RCAP = NASG;
constexpr float EPS = 1e-6f;
constexpr int NPHASE = 9;

constexpr size_t MiB = 1u << 20;
constexpr size_t WS_CTL = 0, CTL_ZERO_BYTES = 64 * 1024;
constexpr size_t WS_ROPE = 1 * MiB;
constexpr size_t WS_RINV = WS_ROPE + 256 * 1024;
constexpr size_t WS_RTOK = WS_RINV + 128 * 1024;
constexpr size_t WS_GATE = WS_RTOK + 128 * 1024;
constexpr size_t WS_WR = 2 * MiB;
constexpr size_t WS_WPOOL = WS_WR + 512 * 1024;
constexpr size_t WS_WIN = 3 * MiB;
constexpr size_t WS_WOUT = 13 * MiB;
constexpr size_t WS_ROWL = 21 * MiB;
constexpr size_t WS_WGU = 29 * MiB;
constexpr size_t WS_H8 = 93 * MiB;
constexpr size_t WS_WD = 157 * MiB;
constexpr size_t WS_ACT8 = 189 * MiB;
constexpr size_t WS_XB = 221 * MiB;
constexpr size_t WS_PROJ = 349 * MiB;
constexpr size_t WS_MIXED = 509 * MiB;
constexpr size_t WS_DPOOL = 637 * MiB;
constexpr size_t WS_ACT = WS_DPOOL;
constexpr size_t WS_Y = WS_PROJ;
constexpr size_t WS_END = 701 * MiB;
static_assert(WS_Y + (size_t)NASG * DM * 2 <= WS_DPOOL, "Y overlay");
constexpr int CW_TMO = 0, CW_BAR = 1024, CW_CNT = 8192;

constexpr int RING_BYTES = 131072;
constexpr int TAB_OFF = RING_BYTES;
constexpr int TAB_UNITS = 14, TABRG_UNITS = 6;
constexpr int TABR_OFF = TAB_OFF + TAB_UNITS * 1024;
constexpr int TABG_OFF = TABR_OFF + TABRG_UNITS * 1024;
constexpr int EXPT_OFF = TABG_OFF + TABRG_UNITS * 1024;
constexpr int MISC_OFF = EXPT_OFF + 512;
constexpr int LDS_BYTES = 159744;
static_assert(MISC_OFF + 16 <= LDS_BYTES, "LDS map");

#define RLX_AGENT __ATOMIC_RELAXED, __HIP_MEMORY_SCOPE_AGENT
#define LDS_WAIT() asm volatile("s_waitcnt lgkmcnt(0)" ::: "memory")
#define VM_WAIT() asm volatile("s_waitcnt vmcnt(0)" ::: "memory")

__device__ __forceinline__ unsigned f2bf(float f) { unsigned u = __builtin_bit_cast(unsigned, f); return (u + 0x7fffu + ((u >> 16) & 1u)) >> 16; }

__device__ __forceinline__ float bflo(unsigned w) { return __builtin_bit_cast(float, w << 16); }
__device__ __forceinline__ float bfhi(unsigned w) { return __builtin_bit_cast(float, w & 0xffff0000u); }
typedef __bf16 bf16x2_t __attribute__((ext_vector_type(2)));
__device__ __forceinline__ unsigned cvt_pk_bf16(float lo, float hi) { f32x2 v = {lo, hi}; bf16x2_t b = __builtin_convertvector(v, bf16x2_t); return __builtin_bit_cast(unsigned, b); }
__device__ __forceinline__ unsigned pk2(float lo, float hi) { return cvt_pk_bf16(lo, hi); }
__device__ __forceinline__ unsigned pk4_fp8(float a, float b, float c, float d) { int r = 0; r = __builtin_amdgcn_cvt_pk_fp8_f32(a, b, r, false); r = __builtin_amdgcn_cvt_pk_fp8_f32(c, d, r, true); return (unsigned)r; }
constexpr float W8_SCALE = 256.0f, ACT8_SCALE = 8.0f, Y8_SCALE = 32.0f;
__device__ __forceinline__ float wave_sum(float v) {
#pragma unroll
    for (int o = 1; o < 64; o <<= 1) v += __shfl_xor(v, o);
    return v;
}

#define XB_TMO      128
#define XB_XCNT(j)  (256  + 64 * (j))
#define XB_XSUB(j)  (1280 + 64 * (j))
#define XB_XGEN(j)  (2304 + 64 * (j))
#define XB_TOP      3328
#define XB_TOPGEN   3392
#define XCD_BAR_WORDS 3456
#define XB_SPIN_CAP (1u << 18)
__device__ __forceinline__ unsigned xb_ld(unsigned* p)              { return __hip_atomic_load(p, __ATOMIC_RELAXED, __HIP_MEMORY_SCOPE_AGENT); }
__device__ __forceinline__ unsigned xb_add(unsigned* p, unsigned v) { return __hip_atomic_fetch_add(p, v, __ATOMIC_RELAXED, __HIP_MEMORY_SCOPE_AGENT); }
__device__ __forceinline__ unsigned xb_xcc_id() { return (unsigned)__builtin_amdgcn_s_getreg((3 << 11) | 20) & 0xFu; }
#define XB_SPIN(cond, bar) do { unsigned _sp = 0; while (cond) { __builtin_amdgcn_s_sleep(1); \
    if ((++_sp & 255u) == 0u) { if (xb_ld(&(bar)[XB_TMO])) break; if (_sp > XB_SPIN_CAP) { atomicAdd(&(bar)[XB_TMO], 1u); break; } } } } while (0)
struct XcdBarrier { unsigned* bar; unsigned x; volatile LAS unsigned* st; };
__device__ __forceinline__ XcdBarrier xcd_barrier_post(unsigned* bar, volatile LAS unsigned* st) {
    XcdBarrier b; b.bar = bar; b.x = xb_xcc_id(); b.st = st;
    if (threadIdx.x == 0) (void)xb_add(&bar[XB_XCNT(b.x)], 1u);
    return b;
}
__device__ __forceinline__ void xcd_barrier_complete(unsigned* bar, unsigned x, unsigned& nloc, unsigned& nx) {
    const unsigned G = gridDim.x * gridDim.y * gridDim.z;
    unsigned sum, cnt, mine, sp = 0u;
    for (;;) {
        sum = 0u; cnt = 0u; mine = 0u;
#pragma unroll
        for (unsigned j = 0; j < 16; ++j) { const unsigned c = xb_ld(&bar[XB_XCNT(j)]); sum += c; cnt += (c > 0u) ? 1u : 0u; mine = (j == x) ? c : mine; }
        if (sum == G) break;
        __builtin_amdgcn_s_sleep(1);
        if ((++sp & 255u) == 0u) { if (xb_ld(&bar[XB_TMO])) break; if (sp > XB_SPIN_CAP) { atomicAdd(&bar[XB_TMO], 1u); break; } }
    }
    nloc = mine > 0u ? mine : 1u; nx = cnt > 0u ? cnt : 1u;
}
__device__ __forceinline__ void xcd_barrier(const XcdBarrier& b) {
    asm volatile("s_waitcnt vmcnt(0)" ::: "memory");
    __syncthreads();
    if (threadIdx.x == 0) {
        unsigned* bar = b.bar;
        __builtin_amdgcn_s_waitcnt(0);
        unsigned nloc = b.st[0], nx = b.st[1];
        if (nloc == 0u) { xcd_barrier_complete(bar, b.x, nloc, nx); b.st[0] = nloc; b.st[1] = nx; }
        const unsigned old = xb_add(&bar[XB_XSUB(b.x)], 1u);
        const unsigned gen = old / nloc;
        if (old + 1u == (gen + 1u) * nloc) {
            __builtin_amdgcn_fence(__ATOMIC_RELEASE, "agent");
            asm volatile("s_waitcnt vmcnt(0)" ::: "memory");
            const unsigned og = xb_add(&bar[XB_TOP], 1u);
            const unsigned tg = og / nx;
            if (og + 1u == (tg + 1u) * nx) xb_add(&bar[XB_TOPGEN], 1u);
            else XB_SPIN(xb_ld(&bar[XB_TOPGEN]) == tg, bar);
            __builtin_amdgcn_fence(__ATOMIC_ACQUIRE, "agent");
            xb_add(&bar[XB_XGEN(b.x)], 1u);
            asm volatile("s_waitcnt vmcnt(0)" ::: "memory");
        } else {
            XB_SPIN(xb_ld(&bar[XB_XGEN(b.x)]) == gen, bar);
            __builtin_amdgcn_fence(__ATOMIC_ACQUIRE, "agent");
            asm volatile("s_waitcnt vmcnt(0)" ::: "memory");
        }
    }
    __syncthreads();
}

namespace pg8 {
constexpr int BM = 256, BK = 64, HALF = 128, HTB = HALF * BK * 2, STAGE_BYTES = 8 * HTB, NXCD = 8, WGM = 2;
static_assert(STAGE_BYTES == RING_BYTES, "stage region");
__host__ __device__ __forceinline__ int lds_byte(int r, int c) { const int st = (r >> 4) * 2 + (c >> 5), rr = r & 15, cc = c & 31, ob = rr * 64 + cc * 2; return st * 1024 + (ob ^ (((ob >> 9) & 1) << 5)); }
__host__ __device__ __forceinline__ void stage_rc(int b, int& R, int& C) { const int st = b / 1024, sb = b % 1024, swz = sb ^ (((sb >> 9) & 1) << 5); R = (st >> 1) * 16 + swz / 64; C = (st & 1) * 32 + (swz % 64) / 2; }
__host__ __device__ __forceinline__ int perm32(int rho) { const int n = rho >> 4, i = rho & 15; return 8 * (i >> 2) + 4 * n + (i & 3); }

struct Unit { int pm, pn, ord, e, cnt; };

struct StaticOrder {
    int nM, nN, nwg, G, c;
    __device__ void init(int M, int N, int G_, int c_) { nM = M / BM; nN = N / BM; nwg = nM * nN; G = G_; c = c_; }
    __device__ bool next(int i, int& pm, int& pn) const {
        const long L = (long)i * G + c; if (L >= nwg) return false;
        int wgid = (int)L; { const int q = nwg / NXCD, r = nwg % NXCD, xcd = wgid % NXCD, off = wgid / NXCD; wgid = (xcd < r ? xcd * (q + 1) : r * (q + 1) + (xcd - r) * q) + off; }
        const int nig = WGM * nN, gid = wgid / nig, fm = gid * WGM, gsz = (nM - fm) < WGM ? (nM - fm) : WGM;
        pm = fm + ((wgid % nig) % gsz); pn = (wgid % nig) / gsz; return true;
    }
};

typedef int v8i32 __attribute__((ext_vector_type(8)));
template <class Epi, class Prob, bool F8 = false, int KREP = 1, int EPI_REP = 1>
__device__ __forceinline__ void gemm_phase(LAS unsigned char* lds, const Prob& S, const Epi& E) {
    const int tid = threadIdx.x, wid = __builtin_amdgcn_readfirstlane(tid >> 6), lane = tid & 63, wr = wid >> 2, wc = wid & 3, fr = lane & 15, fq = lane >> 4;
    const int KB = S.KB, ntr = KB / 128, nt = ntr * KREP, kmask = ntr - 1;
    int Rr[2], Cc[2]; unsigned voffB[2][2];
#pragma unroll
    for (int i = 0; i < 2; ++i) { stage_rc(tid * 16 + i * 8192, Rr[i], Cc[i]);
#pragma unroll
        for (int h = 0; h < 2; ++h) { const int R = Rr[i], ii = R & 15, Rb = 64 * (R >> 5) + 16 * (ii >> 2) + 8 * h + 4 * ((R >> 4) & 1) + (ii & 3); voffB[h][i] = (unsigned)(Rb * KB + Cc[i] * 2); } }
    const size_t kstep = (size_t)(BK * 2);
    const size_t hstep = (size_t)HALF * KB;
    const unsigned ldsw = (unsigned)wid * 1024u;
    const int aoff = lds_byte(wr * 64 + fr, fq * 8), boff = lds_byte(wc * 32 + fr, fq * 8);
    const int aoff8a = aoff, aoff8b = aoff + 1024, boff8a = boff, boff8b = boff + 1024;
#define PG8_SA(b, h) (((b) * 2 + (h)) * HTB)
#define PG8_SB(b, h) ((4 + (b) * 2 + (h)) * HTB)
#define PG8_STAGE_X(bufoff, gbase, voff, aux) do { _Pragma("unroll") for (int _i = 0; _i < 2; ++_i) \
        __builtin_amdgcn_global_load_lds((const unsigned*)((const char*)(gbase) + (voff)[_i]), (LAS unsigned*)(lds + (bufoff) + ldsw + _i * 8192), 16, 0, aux); } while (0)
#define PG8_STAGE(bufoff, gbase, voff) do { if constexpr (((bufoff) < 4 * HTB) && Prob::A_NT) PG8_STAGE_X(bufoff, gbase, voff, 2); else PG8_STAGE_X(bufoff, gbase, voff, 0); } while (0)
#define PG8_LDA_(dst, b, h) do { _Pragma("unroll") for (int m = 0; m < 4; ++m) _Pragma("unroll") for (int k = 0; k < 2; ++k) dst[m][k] = *(const LAS bf16x8*)(lds + PG8_SA(b, h) + aoff + m * 2048 + k * 1024); } while (0)
#define PG8_LDB_(dst, b, h) do { _Pragma("unroll") for (int n = 0; n < 2; ++n) _Pragma("unroll") for (int k = 0; k < 2; ++k) dst[n][k] = *(const LAS bf16x8*)(lds + PG8_SB(b, h) + boff + n * 2048 + k * 1024); } while (0)
#define PG8_LD8(dst, pa, pb) do { const u32x4 _lo = *(const LAS u32x4*)(pa), _hi = *(const LAS u32x4*)(pb); dst = __builtin_bit_cast(v8i32, __builtin_shufflevector(_lo, _hi, 0, 1, 2, 3, 4, 5, 6, 7)); } while (0)
#define PG8_LDA8(dst, b, h) do { _Pragma("unroll") for (int m = 0; m < 4; ++m) PG8_LD8(dst[m], lds + PG8_SA(b, h) + aoff8a + m * 2048, lds + PG8_SA(b, h) + aoff8b + m * 2048); } while (0)
#define PG8_LDB8(dst, b, h) do { _Pragma("unroll") for (int n = 0; n < 2; ++n) PG8_LD8(dst[n], lds + PG8_SB(b, h) + boff8a + n * 2048, lds + PG8_SB(b, h) + boff8b + n * 2048); } while (0)
#define PG8_LDA(dst, b, h) do { if constexpr (F8) PG8_LDA8(dst##8, b, h); else PG8_LDA_(dst, b, h); } while (0)
#define PG8_LDB(dst, b, h) do { if constexpr (F8) PG8_LDB8(dst##8, b, h); else PG8_LDB_(dst, b, h); } while (0)
#define PG8_MFMA8(c, b8, a8) asm volatile("s_nop 1\n\tv_mfma_f32_16x16x128_f8f6f4 %0, %1, %2, %0" : "+v"(c) : "v"(b8), "v"(a8))
#define PG8_MMA(ai, bj, At, Bt) do { __builtin_amdgcn_s_setprio(1); _Pragma("unroll") for (int m = 0; m < 4; ++m) _Pragma("unroll") for (int n = 0; n < 2; ++n) { \
        if constexpr (F8) PG8_MFMA8(acc[ai][bj][m][n], Bt##8[n], At##8[m]); \
        else { _Pragma("unroll") for (int k = 0; k < 2; ++k) acc[ai][bj][m][n] = __builtin_amdgcn_mfma_f32_16x16x32_bf16(Bt[n][k], At[m][k], acc[ai][bj][m][n], 0, 0, 0); } } __builtin_amdgcn_s_setprio(0); } while (0)
#define PG8_WAIT_V(n) asm volatile("s_waitcnt vmcnt(" #n ")" ::: "memory")
#define PG8_WAIT_L(n) asm volatile("s_waitcnt lgkmcnt(" #n ")" ::: "memory")
#define PG8_BAR __builtin_amdgcn_s_barrier()
#define PG8_SCHED __builtin_amdgcn_sched_barrier(0)
    Unit cur, nxt; int ui = 0;
    if (!S.next(0, cur)) return;
    if (STAGGER_TICKS > 0) {
        const unsigned long long t0 = __builtin_amdgcn_s_memrealtime(), dl = (unsigned long long)(((blockIdx.x >> 3) & 15) * STAGGER_TICKS);
        while (__builtin_amdgcn_s_memrealtime() - t0 < dl) __builtin_amdgcn_s_sleep(4);
    }
    f32x4 acc[2][2][4][2];
    E.init(acc, cur, wr, wc, fr, fq);
    bf16x8 At[4][2], B0[2][2], B1[2][2];
    v8i32 At8[4], B08[2], B18[2];
    unsigned vc[2][2], vn[2][2];
    S.a_voff(cur, Rr, Cc, vc);
    const char* cA = S.a_base(cur); const char* cB = S.b_base(cur);
    PG8_STAGE(PG8_SB(0, 0), cB, voffB[0]); PG8_STAGE(PG8_SB(0, 1), cB, voffB[1]); PG8_STAGE(PG8_SA(0, 0), cA, vc[0]); PG8_STAGE(PG8_SA(0, 1), cA, vc[1]);
    if (wr == 1) PG8_BAR;
    PG8_WAIT_V(2); PG8_BAR;
    PG8_STAGE(PG8_SB(1, 0), cB + kstep, voffB[0]); PG8_STAGE(PG8_SA(1, 0), cA + kstep, vc[0]); PG8_STAGE(PG8_SB(1, 1), cB + kstep, voffB[1]);
    PG8_WAIT_V(6); PG8_BAR;
    for (;;) {
        const bool has_next = S.next(ui + 1, nxt);
        const char* nA = has_next ? S.a_base(nxt) : cA; const char* nB = has_next ? S.b_base(nxt) : cB;
        if (has_next) S.a_voff(nxt, Rr, Cc, vn); else { vn[0][0] = vc[0][0]; vn[0][1] = vc[0][1]; vn[1][0] = vc[1][0]; vn[1][1] = vc[1][1]; }
        for (int t = 0; t < nt; t += 2) {
            const bool last = (t == nt - 2);
            const int t1 = (KREP == 1) ? t + 1 : ((t + 1) & kmask), t2 = (KREP == 1) ? t + 2 : ((t + 2) & kmask);
            const char* a1 = cA + (size_t)t1 * kstep;
            const char* a2 = last ? nA : cA + (size_t)t2 * kstep; const char* b2 = last ? nB : cB + (size_t)t2 * kstep;
            const char* a3 = a2 + kstep; const char* b3 = b2 + kstep;
            unsigned w0[2], w1[2]; w0[0] = last ? vn[0][0] : vc[0][0]; w0[1] = last ? vn[0][1] : vc[0][1]; w1[0] = last ? vn[1][0] : vc[1][0]; w1[1] = last ? vn[1][1] : vc[1][1];
            PG8_LDB(B0, 0, 0); PG8_LDB(B1, 0, 1); PG8_SCHED; PG8_LDA(At, 0, 0); PG8_STAGE(PG8_SA(1, 1), a1, vc[1]);
            PG8_WAIT_V(8); PG8_WAIT_L(0); PG8_BAR; PG8_MMA(0, 0, At, B0); PG8_MMA(0, 1, At, B1); PG8_BAR; PG8_SCHED;
            PG8_LDA(At, 0, 1); PG8_STAGE(PG8_SB(0, 0), b2, voffB[0]); PG8_STAGE(PG8_SB(0, 1), b2, voffB[1]); PG8_STAGE(PG8_SA(0, 0), a2, w0);
            PG8_WAIT_V(8); PG8_WAIT_L(0); PG8_BAR; PG8_MMA(1, 0, At, B0); PG8_MMA(1, 1, At, B1); PG8_BAR; PG8_SCHED;
            PG8_LDB(B0, 1, 0); PG8_LDB(B1, 1, 1); PG8_SCHED; PG8_LDA(At, 1, 0); PG8_STAGE(PG8_SA(0, 1), a2, w1);
            PG8_WAIT_V(8); PG8_WAIT_L(0); PG8_BAR; PG8_MMA(0, 0, At, B0); PG8_MMA(0, 1, At, B1); PG8_BAR; PG8_SCHED;
            PG8_LDA(At, 1, 1); PG8_STAGE(PG8_SB(1, 0), b3, voffB[0]); PG8_STAGE(PG8_SB(1, 1), b3, voffB[1]); PG8_STAGE(PG8_SA(1, 0), a3, w0);
            PG8_WAIT_V(8); PG8_WAIT_L(0); PG8_BAR; PG8_MMA(1, 0, At, B0); PG8_MMA(1, 1, At, B1); PG8_BAR; PG8_SCHED;
        }
        if (wr == 0) PG8_BAR;
        if constexpr (F8) asm volatile("s_nop 15\n\ts_nop 7" ::: "memory");
#pragma unroll
        for (int er = 0; er < EPI_REP; ++er) E(acc, cur, wr, wc, fr, fq);
        if (!has_next) break;
        E.init(acc, nxt, wr, wc, fr, fq);
        cur = nxt; cA = nA; cB = nB; ++ui;
        vc[0][0] = vn[0][0]; vc[0][1] = vn[0][1]; vc[1][0] = vn[1][0]; vc[1][1] = vn[1][1];
        if (wr == 1) PG8_BAR;
    }
    PG8_WAIT_V(0);
    PG8_BAR;
#undef PG8_SA
#undef PG8_SB
#undef PG8_STAGE
#undef PG8_STAGE_X
#undef PG8_LDA
#undef PG8_LDB
#undef PG8_MMA
#undef PG8_MFMA8
#undef PG8_LDA_
#undef PG8_LDB_
#undef PG8_LD8
#undef PG8_LDA8
#undef PG8_LDB8
#undef PG8_WAIT_V
#undef PG8_WAIT_L
#undef PG8_BAR
#undef PG8_SCHED
}

struct DenseProb {
    static constexpr bool A_NT = DENSE_A_NT;
    const char* A; const char* Bt; int ldaB, KB, acolB;
    StaticOrder so;
    __device__ __forceinline__ bool next(int i, Unit& u) const { u.ord = i; u.e = 0; u.cnt = 256; return so.next(i, u.pm, u.pn); }
    __device__ __forceinline__ const char* a_base(const Unit& u) const { return A + (size_t)u.pm * BM * ldaB + (size_t)u.pn * acolB; }
    __device__ __forceinline__ const char* b_base(const Unit& u) const { return Bt + (size_t)u.pn * BM * KB; }
    __device__ __forceinline__ void a_voff(const Unit&, const int (&R)[2], const int (&C)[2], unsigned (&vo)[2][2]) const {
#pragma unroll
        for (int h = 0; h < 2; ++h)
#pragma unroll
            for (int i = 0; i < 2; ++i) vo[h][i] = (unsigned)((h * HALF + R[i]) * ldaB + C[i] * 2);
    }
};

struct MoeProb {
    static constexpr bool A_NT = false;
    const char* A; const char* Bt; int ldaB, KB, nN, shift;
    LAS const int* tab;
    LAS const int* expt;
    int G, c;
    __device__ __forceinline__ bool next(int i, Unit& u) const {
        const int per = G >> 3, xcd = c & 7, rank = c >> 3;
        if (expt[70]) {
            const int e = xcd + 8 * (rank >> 3), sub = rank & 7, cnt = expt[33 + e], T = (cnt + 255) >> 8;
            const int pn = (nN == 8) ? sub : (sub & 3), pm = (nN == 8) ? i : 2 * i + (sub >> 2);
            if (pm >= T || i >= TAB_UNITS) return false;
            u.e = e; u.pn = pn; u.pm = pm; u.ord = i; u.cnt = cnt - pm * 256; return true;
        }
        const int L = (i * 8 + xcd) * per + rank;
        if (L >= expt[32] || i >= TAB_UNITS) return false;
        int e = 0;
#pragma unroll 1
        while (e < 31 && L >= expt[e + 1]) ++e;
        const int q = L - expt[e], cnt = expt[33 + e], T = (cnt + 255) >> 8;
        u.e = e; u.pn = q / T; u.pm = q % T; u.ord = i; u.cnt = cnt - u.pm * 256; return true;
    }
    __device__ __forceinline__ const char* a_base(const Unit&) const { return A; }
    __device__ __forceinline__ const char* b_base(const Unit& u) const { return Bt + ((size_t)u.e * nN + u.pn) * BM * KB; }
    __device__ __forceinline__ void a_voff(const Unit& u, const int (&R)[2], const int (&C)[2], unsigned (&vo)[2][2]) const {
#pragma unroll
        for (int h = 0; h < 2; ++h)
#pragma unroll
            for (int i = 0; i < 2; ++i) { const unsigned row = ((unsigned)tab[u.ord * 256 + h * HALF + R[i]] & 0x7fffffffu) >> shift; vo[h][i] = row * (unsigned)ldaB + (unsigned)C[i] * 2u; }
    }
};

struct EpiBf16 {
    bf16_t* O; int ldc, cbase; float scale;
    __device__ __forceinline__ void init(f32x4 (&acc)[2][2][4][2], const Unit&, int, int, int, int) const {
#pragma unroll
        for (int a = 0; a < 2; ++a)
#pragma unroll
            for (int b = 0; b < 2; ++b)
#pragma unroll
                for (int m = 0; m < 4; ++m)
#pragma unroll
                    for (int n = 0; n < 2; ++n) acc[a][b][m][n] = (f32x4){0.f, 0.f, 0.f, 0.f};
    }
    __device__ __forceinline__ void operator()(const f32x4 (&acc)[2][2][4][2], const Unit& u, int wr, int wc, int fr, int fq) const {
        const int row0 = u.pm * BM + wr * 64 + fr, col0 = cbase + u.pn * BM + wc * 64 + 16 * fq;
#pragma unroll
        for (int ai = 0; ai < 2; ++ai)
#pragma unroll
            for (int m = 0; m < 4; ++m) { bf16_t* rowp = O + (size_t)(row0 + ai * HALF + m * 16) * ldc + col0;
#pragma unroll
                for (int bj = 0; bj < 2; ++bj) { const f32x4 v0 = acc[ai][bj][m][0] * scale, v1 = acc[ai][bj][m][1] * scale;
                    u32x4 w; w.x = cvt_pk_bf16(v0[0], v0[1]); w.y = cvt_pk_bf16(v0[2], v0[3]); w.z = cvt_pk_bf16(v1[0], v1[1]); w.w = cvt_pk_bf16(v1[2], v1[3]);
                    *(u32x4*)(rowp + bj * 8) = w; } }
    }
};
struct EpiResBf16 {
    const float* rms; bf16_t* O; int ldc; unsigned char* O8;
    __device__ __forceinline__ void init(f32x4 (&acc)[2][2][4][2], const Unit& u, int wr, int wc, int fr, int fq) const {
        const int row0 = u.pm * BM + wr * 64 + fr, col0 = u.pn * BM + wc * 64 + 16 * fq;
        u32x4 raw[2][4][2]; float rs[2][4];
#pragma unroll
        for (int ai = 0; ai < 2; ++ai)
#pragma unroll
            for (int m = 0; m < 4; ++m) { const int row = row0 + ai * HALF + m * 16; rs[ai][m] = rms[row];
#pragma unroll
                for (int bj = 0; bj < 2; ++bj) raw[ai][m][bj] = *(const GAS u32x4*)(O + (size_t)row * ldc + col0 + bj * 8); }
#pragma unroll
        for (int ai = 0; ai < 2; ++ai)
#pragma unroll
            for (int m = 0; m < 4; ++m)
#pragma unroll
                for (int bj = 0; bj < 2; ++bj) { const u32x4 w = raw[ai][m][bj]; const float r = rs[ai][m];
                    acc[ai][bj][m][0] = (f32x4){bflo(w.x) * r, bfhi(w.x) * r, bflo(w.y) * r, bfhi(w.y) * r};
                    acc[ai][bj][m][1] = (f32x4){bflo(w.z) * r, bfhi(w.z) * r, bflo(w.w) * r, bfhi(w.w) * r}; }
    }
    __device__ __forceinline__ void operator()(const f32x4 (&acc)[2][2][4][2], const Unit& u, int wr, int wc, int fr, int fq) const {
        const int row0 = u.pm * BM + wr * 64 + fr, col0 = u.pn * BM + wc * 64 + 16 * fq;
#pragma unroll
        for (int ai = 0; ai < 2; ++ai)
#pragma unroll
            for (int m = 0; m < 4; ++m) { bf16_t* rowp = O + (size_t)(row0 + ai * HALF + m * 16) * ldc + col0;
#pragma unroll
                for (int bj = 0; bj < 2; ++bj) { const f32x4 v0 = acc[ai][bj][m][0], v1 = acc[ai][bj][m][1];
                    u32x4 w; w.x = cvt_pk_bf16(v0[0], v0[1]); w.y = cvt_pk_bf16(v0[2], v0[3]); w.z = cvt_pk_bf16(v1[0], v1[1]); w.w = cvt_pk_bf16(v1[2], v1[3]);
                    *(u32x4*)(rowp + bj * 8) = w; } }
    }
};
struct EpiSwiGLU {
    unsigned char* act; LAS const int* tab; LAS const float* tabr; LAS const float* tabg;
    __device__ __forceinline__ void init(f32x4 (&acc)[2][2][4][2], const Unit&, int, int, int, int) const {
#pragma unroll
        for (int a = 0; a < 2; ++a)
#pragma unroll
            for (int b = 0; b < 2; ++b)
#pragma unroll
                for (int m = 0; m < 4; ++m)
#pragma unroll
                    for (int n = 0; n < 2; ++n) acc[a][b][m][n] = (f32x4){0.f, 0.f, 0.f, 0.f};
    }
    __device__ __forceinline__ void operator()(const f32x4 (&acc)[2][2][4][2], const Unit& u, int wr, int wc, int fr, int fq) const {
        const int col0 = u.pn * HALF + wc * 32 + 8 * fq;
#pragma unroll
        for (int ai = 0; ai < 2; ++ai)
#pragma unroll
            for (int m = 0; m < 4; ++m) { const int rl = ai * HALF + wr * 64 + m * 16 + fr; const int a = tab[u.ord * 256 + rl];
                const float r = tabr[u.ord * 256 + rl], rg = tabg[u.ord * 256 + rl];
                if (a >= 0) { float o[8];
#pragma unroll
                    for (int n = 0; n < 2; ++n)
#pragma unroll
                        for (int j = 0; j < 4; ++j) { const float g = acc[ai][0][m][n][j] * r; o[n * 4 + j] = g * __builtin_amdgcn_rcpf(1.0f + __builtin_amdgcn_exp2f(g * -1.4426950408889634f)) * (acc[ai][1][m][n][j] * rg); }
                    u32x2 w; w.x = pk4_fp8(o[0], o[1], o[2], o[3]); w.y = pk4_fp8(o[4], o[5], o[6], o[7]);
                    *(u32x2*)(act + (size_t)a * DEXP + col0) = w; } }
    }
};
struct EpiScatterF8 {
    unsigned char* Y; int ldc; LAS const int* tab; float scale;
    __device__ __forceinline__ void init(f32x4 (&acc)[2][2][4][2], const Unit&, int, int, int, int) const {
#pragma unroll
        for (int a = 0; a < 2; ++a)
#pragma unroll
            for (int b = 0; b < 2; ++b)
#pragma unroll
                for (int m = 0; m < 4; ++m)
#pragma unroll
                    for (int n = 0; n < 2; ++n) acc[a][b][m][n] = (f32x4){0.f, 0.f, 0.f, 0.f};
    }
    __device__ __forceinline__ void operator()(const f32x4 (&acc)[2][2][4][2], const Unit& u, int wr, int wc, int fr, int fq) const {
        const int col0 = u.pn * BM + wc * 64 + 16 * fq;
#pragma unroll
        for (int ai = 0; ai < 2; ++ai)
#pragma unroll
            for (int m = 0; m < 4; ++m) { const int rl = ai * HALF + wr * 64 + m * 16 + fr; const int a = tab[u.ord * 256 + rl];
                if (a >= 0) { const f32x4 v0 = acc[ai][0][m][0] * scale, v1 = acc[ai][0][m][1] * scale, v2 = acc[ai][1][m][0] * scale, v3 = acc[ai][1][m][1] * scale;
                    u32x4 w; w.x = pk4_fp8(v0[0], v0[1], v0[2], v0[3]); w.y = pk4_fp8(v1[0], v1[1], v1[2], v1[3]); w.z = pk4_fp8(v2[0], v2[1], v2[2], v2[3]); w.w = pk4_fp8(v3[0], v3[1], v3[2], v3[3]);
                    *(u32x4*)(Y + (size_t)a * ldc + col0) = w; } }
    }
};
}

struct Frame {
    LAS unsigned char* lds;
    gu32* ctl;
    int tid, lane, wave, G, bx;
    const float *x, *norm_mix, *w_in, *q_norm, *k_norm, *sinks, *w_pool, *pool_scale, *w_out, *norm_ffn, *w_coarse, *b_coarse, *w_fine, *b_fine, *w_gate, *w_up, *w_down;
    float* out;
    float *rope, *rinv, *rtok, *gate;
    bf16_t *Wr, *Wpool, *Win, *Wout, *XB, *PROJ, *MIXED, *DPOOL, *Y;
    unsigned char *Wgu8, *Wd8, *H8, *ACT8;
    int* rowl;
};

__device__ __forceinline__ void tr_item(const float* W, int N, int k0, int n0, bf16_t* dst0, int Kd, const float* gk, const float* gn, LAS float* scr, int lane) {
    const int kk0 = lane >> 3, n4 = (lane & 7) * 4;
    f32x4 v[8];
#pragma unroll
    for (int i = 0; i < 8; ++i) v[i] = __builtin_nontemporal_load((const GAS f32x4*)(W + (size_t)(k0 + 8 * i + kk0) * N + n0 + n4));
    f32x4 sn = (f32x4){1.f, 1.f, 1.f, 1.f}; if (gn) sn = *(const GAS f32x4*)(gn + n0 + n4);
#pragma unroll
    for (int i = 0; i < 8; ++i) { const float g = gk ? gk[k0 + 8 * i + kk0] : 1.0f; const f32x4 w = v[i] * sn * g; LAS float* d = scr + (8 * i + kk0) * 33 + n4; d[0] = w.x; d[1] = w.y; d[2] = w.z; d[3] = w.w; }
    LDS_WAIT(); asm volatile("" ::: "memory");
    const int c = lane & 7;
#pragma unroll
    for (int j = 0; j < 4; ++j) { const int n = (lane >> 3) + 8 * j; const LAS float* s = scr + (8 * c) * 33 + n;
        u32x4 o; o.x = pk2(s[0 * 33], s[1 * 33]); o.y = pk2(s[2 * 33], s[3 * 33]); o.z = pk2(s[4 * 33], s[5 * 33]); o.w = pk2(s[6 * 33], s[7 * 33]);
        *(GAS u32x4*)(dst0 + (size_t)n * Kd + k0 + 8 * c) = o; }
    LDS_WAIT(); asm volatile("" ::: "memory");
}

__device__ __forceinline__ void tr_item8(const float* W, int N, int k0, int n0, unsigned char* dst0, int Kd, const float* gk, LAS float* scr, int lane, int gu = 0) {
    const int kk0 = lane >> 3, n4 = (lane & 7) * 4;
    f32x4 v[8];
#pragma unroll
    for (int i = 0; i < 8; ++i) v[i] = __builtin_nontemporal_load((const GAS f32x4*)(W + (size_t)(k0 + 8 * i + kk0) * N + n0 + n4));
#pragma unroll
    for (int i = 0; i < 8; ++i) { const float g = (gk ? gk[k0 + 8 * i + kk0] : 1.0f) * W8_SCALE; const f32x4 w = v[i] * g; LAS float* d = scr + (8 * i + kk0) * 33 + n4; d[0] = w.x; d[1] = w.y; d[2] = w.z; d[3] = w.w; }
    LDS_WAIT(); asm volatile("" ::: "memory");
    const int c = lane & 7;
#pragma unroll
    for (int j = 0; j < 4; ++j) { const int n = (lane >> 3) + 8 * j; const LAS float* s = scr + (8 * c) * 33 + n;
        u32x2 o; o.x = pk4_fp8(s[0 * 33], s[1 * 33], s[2 * 33], s[3 * 33]); o.y = pk4_fp8(s[4 * 33], s[5 * 33], s[6 * 33], s[7 * 33]);
        const int x = n0 + n, drow = gu ? (256 * (x >> 7) + 64 * ((x >> 5) & 3) + 16 * ((x >> 3) & 3) + 8 * (gu - 1) + (x & 7)) : n;
        *(GAS u32x2*)(dst0 + (size_t)drow * Kd + k0 + 8 * c) = o; }
    LDS_WAIT(); asm volatile("" ::: "memory");
}

__device__ __forceinline__ void wd_convert(Frame& F, int iw, int nwg) {
    LAS float* scr = (LAS float*)(F.lds + F.wave * 16384);
    constexpr int I_D = NEXP * (DEXP / 64) * (DM / 32);
    for (int r = iw * 8 + F.wave; r < I_D; r += nwg * 8) {
        const int per = (DEXP / 64) * (DM / 32), e = r / per, q = r % per, nb = DM / 32, kb = q / nb, nn = q % nb;
        tr_item8(F.w_down + (size_t)e * DEXP * DM, DM, 64 * kb, 32 * nn, F.Wd8 + ((size_t)e * DM + 32 * nn) * DEXP, DEXP, nullptr, scr, F.lane);
    }
}

__device__ __forceinline__ void gu_convert(Frame& F) {
    LAS float* scr = (LAS float*)(F.lds + F.wave * 16384);
    constexpr int I_G = NEXP * (DM / 64) * (DEXP / 32);
    for (int it = F.bx * 8 + F.wave; it < 2 * I_G; it += F.G * 8) {
        int r = it; const int up = r >= I_G; if (up) r -= I_G;
        const int per = (DM / 64) * (DEXP / 32), e = r / per, q = r % per, nb = DEXP / 32, kb = q / nb, nn = q % nb, n0 = 32 * nn;
        const float* W = (up ? F.w_up : F.w_gate) + (size_t)e * DM * DEXP;
        tr_item8(W, DEXP, 64 * kb, n0, F.Wgu8 + (size_t)e * 1024 * DM, DM, F.norm_ffn, scr, F.lane, up ? 2 : 1);
    }
}

__device__ __forceinline__ void p0_prologue(Frame& F) {
    const int gw = F.bx * 8 + F.wave, NGW = F.G * 8, gt = F.bx * 512 + F.tid, NGT = F.G * 512;
    LAS float* scr = (LAS float*)(F.lds + F.wave * 16384);
    for (int i = gt; i < SEQ * 8; i += NGT) {
        const int pos = i >> 3, j = i & 7;
        const double invf[8] = {1.0, 0.19392274474868576, 0.03760603093086393, 0.007292664737217109, 0.001414213562373095, 0.0002742481756762073, 5.318295896944988e-05, 1.031338537721246e-05};
        double f = invf[0];
#pragma unroll
        for (int q = 1; q < 8; ++q) f = (j == q) ? invf[q] : f;
        double s, c; sincos((double)pos * f, &s, &c);
        F.rope[pos * 16 + j] = (float)c; F.rope[pos * 16 + 8 + j] = (float)s;
    }
    for (int i = gt; i < 64 * DM; i += NGT) {
        const int j = i / DM, k = i % DM; float v = 0.f;
        if (j < 4) v = F.w_coarse[k * 4 + j] * F.norm_ffn[k]; else if (j < 36) v = F.w_fine[k * 32 + (j - 4)] * F.norm_ffn[k];
        const unsigned hi = f2bf(v); const float lo = v - bflo(hi);
        F.Wr[i] = (bf16_t)hi; F.Wr[64 * DM + i] = (bf16_t)f2bf(lo);
    }
    constexpr int I_IN = (DM / 64) * (INW / 32), I_OUT = (1024 / 64) * (DM / 32), I_POOL = 0, I_G = NEXP * (DM / 64) * (DEXP / 32);
    constexpr int NITEMS = I_IN + I_OUT + I_POOL;
    for (int it = gw; it < NITEMS; it += NGW) {
        int r = it;
        if (r < I_IN) { const int nb = INW / 32, kb = r / nb, nn = r % nb; tr_item(F.w_in, INW, 64 * kb, 32 * nn, F.Win + (size_t)(32 * nn) * DM, DM, F.norm_mix, nullptr, scr, F.lane); continue; } r -= I_IN;
        if (r < I_OUT) { const int nb = DM / 32, kb = r / nb, nn = r % nb; tr_item(F.w_out, DM, 64 * kb, 32 * nn, F.Wout + (size_t)(32 * nn) * DM, DM, nullptr, nullptr, scr, F.lane); continue; } r -= I_OUT;
    }
    for (int wt = F.bx; wt < 256; wt += F.G) {
        const int pr = wt >> 3, g = pr >> 3, c0 = (pr & 7) * 32, n0 = ((wt & 7) * 8 + F.wave) * 32, i = F.lane & 31, kk = F.lane >> 5;
        LAS float* wp = (LAS float*)F.lds;
        __syncthreads();
        for (int e = F.tid; e < 32 * 256; e += 512) { const int c = e >> 8, j = e & 255; wp[c * 257 + j] = F.w_pool[(size_t)g * 65536 + (size_t)(c0 + c) * 256 + j] * F.pool_scale[g * 256 + j]; }
        __syncthreads();
        const float* ap = F.w_out + (size_t)(1024 + g * 256 + kk) * DM + n0 + i;
        const LAS float* bp = wp + i * 257 + kk;
        f32x16 acc = {};
#pragma unroll 16
        for (int j0 = 0; j0 < 256; j0 += 2) acc = __builtin_amdgcn_mfma_f32_32x32x2f32(ap[(size_t)j0 * DM], bp[j0], acc, 0, 0, 0);
        bf16_t* op = F.Wout + (size_t)n0 * DM + 1024 + g * 256 + c0 + i;
#pragma unroll
        for (int r = 0; r < 16; ++r) { const int nr = (r & 3) + 8 * (r >> 2) + 4 * kk; op[(size_t)nr * DM] = (bf16_t)f2bf(acc[r]); }
    }
    __syncthreads();
    for (int m = gw; m < NTOK; m += NGW) {
        const GAS f32x4* xr = (const GAS f32x4*)(F.x + (size_t)m * DM) + F.lane;
        f32x4 v[8]; float s = 0.f;
#pragma unroll
        for (int j = 0; j < 8; ++j) { v[j] = __builtin_nontemporal_load(xr + 64 * j); s += (v[j].x * v[j].x + v[j].y * v[j].y) + (v[j].z * v[j].z + v[j].w * v[j].w); }
        s = wave_sum(s);
        const float rms = sqrtf(s * (1.0f / DM) + EPS), rr = 1.0f / rms;
        if (F.lane == 0) F.rinv[m] = rms;
        GAS u32x2* o8 = (GAS u32x2*)(F.XB + (size_t)m * DM) + F.lane;
#pragma unroll
        for (int j = 0; j < 8; ++j) { u32x2 w; w.x = pk2(v[j].x * rr, v[j].y * rr); w.y = pk2(v[j].z * rr, v[j].w * rr); o8[64 * j] = w; }
    }
}

struct PoolSt { int it; float S[8]; bool active; };
struct PoolGeo { const bf16_t* up; bf16_t* dp; int w, pos0; };
__device__ __forceinline__ PoolGeo pool_geo(const Frame& F, int it) {
    const int ri = it >> 7, c8 = it & 127, t0 = ri * 32; PoolGeo g;
    g.w = 2 << (c8 >> 5); g.pos0 = t0 & (SEQ - 1); g.up = F.PROJ + (size_t)t0 * INW + UOFF + c8 * 8; g.dp = F.MIXED + (size_t)t0 * DM + 1024 + c8 * 8; return g;
}
__device__ __forceinline__ void pool_begin(Frame& F, int it, PoolSt& ps) {
    const int NITEM = (NTOK / 32) * 128;
    ps.active = it < NITEM; ps.it = ps.active ? it : 0;
    const PoolGeo g = pool_geo(F, ps.it);
#pragma unroll
    for (int j = 0; j < 8; ++j) ps.S[j] = 0.f;
    for (int i0 = 1; i0 < g.w; i0 += 5) { u32x4 pr[5];
#pragma unroll
        for (int q = 0; q < 5; ++q) { const int i = i0 + q; pr[q] = (u32x4){0u, 0u, 0u, 0u}; if (i < g.w && g.pos0 - i >= 0) pr[q] = *(const GAS u32x4*)(g.up - (ptrdiff_t)i * INW); }
#pragma unroll
        for (int q = 0; q < 5; ++q) { const u32x4 raw = pr[q];
            ps.S[0] += bflo(raw.x); ps.S[1] += bfhi(raw.x); ps.S[2] += bflo(raw.y); ps.S[3] += bfhi(raw.y); ps.S[4] += bflo(raw.z); ps.S[5] += bfhi(raw.z); ps.S[6] += bflo(raw.w); ps.S[7] += bfhi(raw.w); } }
}
__device__ __forceinline__ void pool_issue(const Frame& F, const PoolSt& ps, int k, u32x4 (&nw)[4]) {
    const PoolGeo g = pool_geo(F, ps.it);
#pragma unroll
    for (int q = 0; q < 4; ++q) nw[q] = *(const GAS u32x4*)(g.up + (ptrdiff_t)(4 * k + q) * INW);
}
__device__ __forceinline__ void pool_finish(const Frame& F, PoolSt& ps, int k, const u32x4 (&nw)[4]) {
    const PoolGeo g = pool_geo(F, ps.it);
    u32x4 od[4];
#pragma unroll
    for (int q = 0; q < 4; ++q) { const int t = 4 * k + q; const int to = t - g.w + 1, toc = (g.pos0 + to >= 0) ? to : t;
        od[q] = *(const GAS u32x4*)(g.up + (ptrdiff_t)toc * INW); }
#pragma unroll
    for (int q = 0; q < 4; ++q) { const int t = 4 * k + q; const u32x4 raw = nw[q]; const bool has_old = g.pos0 + t - g.w + 1 >= 0;
        const u32x4 old = has_old ? od[q] : (u32x4){0u, 0u, 0u, 0u};
        const float xv[8] = {bflo(raw.x), bfhi(raw.x), bflo(raw.y), bfhi(raw.y), bflo(raw.z), bfhi(raw.z), bflo(raw.w), bfhi(raw.w)};
        const int pos = g.pos0 + t; const float ic = __builtin_amdgcn_rcpf((float)((pos + 1 < g.w) ? (pos + 1) : g.w));
        float d[8];
#pragma unroll
        for (int j = 0; j < 8; ++j) { ps.S[j] += xv[j]; d[j] = ps.S[j] * ic - xv[j]; }
        u32x4 o; o.x = pk2(d[0], d[1]); o.y = pk2(d[2], d[3]); o.z = pk2(d[4], d[5]); o.w = pk2(d[6], d[7]);
        *(GAS u32x4*)(g.dp + (size_t)t * DM) = o;
        ps.S[0] -= bflo(old.x); ps.S[1] -= bfhi(old.x); ps.S[2] -= bflo(old.y); ps.S[3] -= bfhi(old.y); ps.S[4] -= bflo(old.z); ps.S[5] -= bfhi(old.z); ps.S[6] -= bflo(old.w); ps.S[7] -= bfhi(old.w); }
}

constexpr int AT_K = 0, AT_V = 32768, AT_VSTR = 520, AT_UNIT = 32768 + 64 * 520;
static_assert(2 * AT_UNIT <= EXPT_OFF, "attention LDS");
__device__ __forceinline__ void attn_super(Frame& F, int b, int n, int kp, PoolSt& ps, int step0) {
    LAS unsigned char* lds = F.lds;
    const int tid = F.tid, lane = F.lane, wid = F.wave;
    const size_t tok0 = (size_t)b * SEQ;
    const int g = wid & 3, ql = lane & 31, hi = lane >> 5;
    u32x4 qc[4], qn[4];
    { const int head = (2 * kp) * 4 + g, s0 = wid >> 2; const bf16_t* qp = F.PROJ + (tok0 + n * 128 + 32 * s0 + ql) * INW + QOFF + head * HD + hi * 8;
#pragma unroll
      for (int d0 = 0; d0 < 4; ++d0) qc[d0] = *(const GAS u32x4*)(qp + d0 * 16); }
    u32x4 kraw[2][4], vraw[2][2][2];
#pragma unroll
    for (int j = 0; j < 2; ++j) { const int kvh = 2 * kp + j;
#pragma unroll
        for (int i = 0; i < 4; ++i) { const int idx = i * 512 + tid, row = idx >> 3, c = idx & 7, pos = n * 128 - 128 + row, pc = pos < 0 ? 0 : pos;
            kraw[j][i] = *(const GAS u32x4*)(F.PROJ + (tok0 + pc) * INW + KOFF + kvh * HD + c * 8); }
#pragma unroll
        for (int i = 0; i < 2; ++i) { const int idx = i * 512 + tid, kpr = idx >> 3, c = idx & 7, pos = n * 128 - 128 + 2 * kpr, pc = pos < 0 ? 0 : pos;
            const bf16_t* p = F.PROJ + (tok0 + pc) * INW + VOFF + kvh * HD + c * 8; vraw[j][i][0] = *(const GAS u32x4*)p; vraw[j][i][1] = *(const GAS u32x4*)(p + INW); } }
    float kn[8];
#pragma unroll
    for (int q = 0; q < 8; ++q) kn[q] = F.k_norm[(tid & 7) * 8 + q];
#pragma unroll
    for (int j = 0; j < 2; ++j) {
#pragma unroll
        for (int i = 0; i < 4; ++i) {
            const int idx = i * 512 + tid, row = idx >> 3, c = idx & 7, pos = n * 128 - 128 + row;
            const u32x4 raw = kraw[j][i];
            float xv[8] = {bflo(raw.x), bfhi(raw.x), bflo(raw.y), bfhi(raw.y), bflo(raw.z), bfhi(raw.z), bflo(raw.w), bfhi(raw.w)};
            float ss = 0.f;
#pragma unroll
            for (int q = 0; q < 8; ++q) ss += xv[q] * xv[q];
            ss += __shfl_xor(ss, 1); ss += __shfl_xor(ss, 2); ss += __shfl_xor(ss, 4);
            const float rn = __builtin_amdgcn_rsqf(ss * (1.0f / HD) + EPS);
#pragma unroll
            for (int q = 0; q < 8; ++q) xv[q] = xv[q] * rn * kn[q];
            const int pp = pos >= 0 ? pos : 0;
            f32x4 cs4[2] = {(f32x4){1.f, 1.f, 1.f, 1.f}, (f32x4){1.f, 1.f, 1.f, 1.f}}, sn4[2] = {(f32x4){0.f, 0.f, 0.f, 0.f}, (f32x4){0.f, 0.f, 0.f, 0.f}};
            if (c < 2) { const GAS f32x4* rp = (const GAS f32x4*)(F.rope + pp * 16); cs4[0] = rp[0]; cs4[1] = rp[1]; sn4[0] = rp[2]; sn4[1] = rp[3]; }
#pragma unroll
            for (int q = 0; q < 8; ++q) { const float pr = __shfl_xor(xv[q], 1); const float cs = cs4[q >> 2][q & 3], sn = sn4[q >> 2][q & 3];
                const float r0 = xv[q] * cs - pr * sn, r1 = xv[q] * cs + pr * sn; xv[q] = (c == 0) ? r0 : (c == 1) ? r1 : xv[q]; }
            u32x4 w; w.x = pk2(xv[0], xv[1]); w.y = pk2(xv[2], xv[3]); w.z = pk2(xv[4], xv[5]); w.w = pk2(xv[6], xv[7]);
            *(LAS u32x4*)(lds + j * AT_UNIT + AT_K + row * 128 + ((c ^ (row & 7)) * 16)) = w;
        }
#pragma unroll
        for (int i = 0; i < 2; ++i) {
            const int idx = i * 512 + tid, kpr = idx >> 3, c = idx & 7;
            const u32x4 r0 = vraw[j][i][0], r1 = vraw[j][i][1];
            const unsigned a0[4] = {r0.x, r0.y, r0.z, r0.w}, a1[4] = {r1.x, r1.y, r1.z, r1.w};
#pragma unroll
            for (int q = 0; q < 4; ++q) {
                const unsigned lo = (a0[q] & 0xffffu) | (a1[q] << 16), hi2 = (a0[q] >> 16) | (a1[q] & 0xffff0000u);
                *(LAS unsigned*)(lds + j * AT_UNIT + AT_V + (c * 8 + 2 * q) * AT_VSTR + kpr * 4) = lo;
                *(LAS unsigned*)(lds + j * AT_UNIT + AT_V + (c * 8 + 2 * q + 1) * AT_VSTR + kpr * 4) = hi2;
            }
        }
    }
    __syncthreads();
    const float SC = 0.125f * 1.4426950408889634f;
    float cbound;
    { float gq = fabsf(F.q_norm[lane]), gk = fabsf(F.k_norm[lane]);
#pragma unroll
      for (int o = 1; o < 64; o <<= 1) { gq = fmaxf(gq, __shfl_xor(gq, o)); gk = fmaxf(gk, __shfl_xor(gk, o)); }
      cbound = 64.0f * SC * gq * gk * 1.02f; }
    const bf16x8 ones8 = {(short)0x3F80, (short)0x3F80, (short)0x3F80, (short)0x3F80, (short)0x3F80, (short)0x3F80, (short)0x3F80, (short)0x3F80};
#pragma unroll 1
    for (int item = 0; item < 4; ++item) {
        const int j = item >> 1, s = (wid >> 2) + 2 * (item & 1), head = (2 * kp + j) * 4 + g;
        const int qpos = n * 128 + 32 * s + ql;
        const int kbase = j * AT_UNIT + AT_K, vbase = j * AT_UNIT + AT_V;
        if (item < 3) {
            const int jn = (item + 1) >> 1, sn = (wid >> 2) + 2 * ((item + 1) & 1), hn = (2 * kp + jn) * 4 + g;
            const bf16_t* qp = F.PROJ + (tok0 + n * 128 + 32 * sn + ql) * INW + QOFF + hn * HD + hi * 8;
#pragma unroll
            for (int d0 = 0; d0 < 4; ++d0) qn[d0] = *(const GAS u32x4*)(qp + d0 * 16);
        }
        const float sink2 = F.sinks[head] * 1.4426950408889634f;
        float qv[4][8];
        float ss = 0.f;
#pragma unroll
        for (int d0 = 0; d0 < 4; ++d0) { const u32x4 raw = qc[d0];
            qv[d0][0] = bflo(raw.x); qv[d0][1] = bfhi(raw.x); qv[d0][2] = bflo(raw.y); qv[d0][3] = bfhi(raw.y); qv[d0][4] = bflo(raw.z); qv[d0][5] = bfhi(raw.z); qv[d0][6] = bflo(raw.w); qv[d0][7] = bfhi(raw.w);
#pragma unroll
            for (int q = 0; q < 8; ++q) ss += qv[d0][q] * qv[d0][q]; }
        ss += __shfl_xor(ss, 32);
        const float rn = SC * __builtin_amdgcn_rsqf(ss * (1.0f / HD) + EPS);
#pragma unroll
        for (int d0 = 0; d0 < 4; ++d0) { const GAS f32x4* gp = (const GAS f32x4*)(F.q_norm + d0 * 16 + hi * 8); const f32x4 g0 = gp[0], g1 = gp[1];
            const float gq[8] = {g0.x, g0.y, g0.z, g0.w, g1.x, g1.y, g1.z, g1.w};
#pragma unroll
            for (int q = 0; q < 8; ++q) qv[d0][q] = qv[d0][q] * rn * gq[q]; }
        { const GAS f32x4* rp = (const GAS f32x4*)(F.rope + qpos * 16); const f32x4 c0 = rp[0], c1 = rp[1], s0 = rp[2], s1 = rp[3];
          const float cs8[8] = {c0.x, c0.y, c0.z, c0.w, c1.x, c1.y, c1.z, c1.w}, sn8[8] = {s0.x, s0.y, s0.z, s0.w, s1.x, s1.y, s1.z, s1.w};
#pragma unroll
          for (int q = 0; q < 8; ++q) { const float pr = __shfl_xor(qv[0][q], 32);
              qv[0][q] = (hi == 0) ? (qv[0][q] * cs8[q] - pr * sn8[q]) : (qv[0][q] * cs8[q] + pr * sn8[q]); } }
        bf16x8 qr[4];
#pragma unroll
        for (int d0 = 0; d0 < 4; ++d0) { u32x4 w; w.x = pk2(qv[d0][0], qv[d0][1]); w.y = pk2(qv[d0][2], qv[d0][3]); w.z = pk2(qv[d0][4], qv[d0][5]); w.w = pk2(qv[d0][6], qv[d0][7]);
            qr[d0] = __builtin_bit_cast(bf16x8, w); }
        const float mref = fmaxf(cbound, sink2);
        f32x16 p[5];
#pragma unroll
        for (int jt = 0; jt < 5; ++jt) {
            const int krow = 32 * (s + jt) + ql;
            f32x16 a;
#pragma unroll
            for (int r = 0; r < 16; ++r) a[r] = -mref;
#pragma unroll
            for (int d0 = 0; d0 < 4; ++d0) { const int c = 2 * d0 + hi;
                const bf16x8 kf = *(const LAS bf16x8*)(lds + kbase + krow * 128 + ((c ^ (krow & 7)) * 16));
                a = __builtin_amdgcn_mfma_f32_32x32x16_bf16(kf, qr[d0], a, 0, 0, 0); }
            p[jt] = a;
        }
#pragma unroll
        for (int jt = 0; jt < 5; ++jt)
#pragma unroll
            for (int r = 0; r < 16; ++r) p[jt][r] = __builtin_amdgcn_exp2f(p[jt][r]);
#pragma unroll
        for (int r = 0; r < 16; ++r) { const int kl = (r & 3) + 8 * (r >> 2) + 4 * hi;
            p[0][r] = (kl > ql) ? p[0][r] : 0.f; p[4][r] = (kl <= ql) ? p[4][r] : 0.f; }
        if (n == 0) {
#pragma unroll
            for (int jt = 0; jt < 4; ++jt) if (s + jt < 4) {
#pragma unroll
                for (int r = 0; r < 16; ++r) p[jt][r] = 0.f; }
        }
        u32x4 pnw[4]; const int pstep = step0 + item; const bool pdo = ps.active && pstep < 8;
        __builtin_amdgcn_sched_barrier(0); if (pdo) pool_issue(F, ps, pstep, pnw); __builtin_amdgcn_sched_barrier(0);
        f32x16 o[2]; o[0] = f32x16{}; o[1] = f32x16{}; f32x16 sacc = f32x16{};
#pragma unroll
        for (int jt = 0; jt < 5; ++jt)
#pragma unroll
            for (int s2 = 0; s2 < 2; ++s2) {
                u32x4 pw; pw.x = cvt_pk_bf16(p[jt][8 * s2 + 0], p[jt][8 * s2 + 1]); pw.y = cvt_pk_bf16(p[jt][8 * s2 + 2], p[jt][8 * s2 + 3]);
                pw.z = cvt_pk_bf16(p[jt][8 * s2 + 4], p[jt][8 * s2 + 5]); pw.w = cvt_pk_bf16(p[jt][8 * s2 + 6], p[jt][8 * s2 + 7]);
                const bf16x8 pf = __builtin_bit_cast(bf16x8, pw);
                const int kb = 32 * (s + jt) + 16 * s2 + 4 * hi;
#pragma unroll
                for (int dt = 0; dt < 2; ++dt) {
                    const LAS unsigned char* vp = lds + vbase + (dt * 32 + ql) * AT_VSTR + kb * 2;
                    const u32x2 v0 = *(const LAS u32x2*)vp, v1 = *(const LAS u32x2*)(vp + 16);
                    u32x4 vw; vw.x = v0.x; vw.y = v0.y; vw.z = v1.x; vw.w = v1.y;
                    o[dt] = __builtin_amdgcn_mfma_f32_32x32x16_bf16(__builtin_bit_cast(bf16x8, vw), pf, o[dt], 0, 0, 0);
                }
                sacc = __builtin_amdgcn_mfma_f32_32x32x16_bf16(ones8, pf, sacc, 0, 0, 0);
            }
        const float inv = __builtin_amdgcn_rcpf(sacc[0] + __builtin_amdgcn_exp2f(sink2 - mref));
        bf16_t* op = F.MIXED + (tok0 + qpos) * DM + head * HD + (hi ? 8 : 0);
#pragma unroll
        for (int dt = 0; dt < 2; ++dt)
#pragma unroll
            for (int gp = 0; gp < 2; ++gp) {
                const int r0 = 8 * gp;
                unsigned ax = cvt_pk_bf16(o[dt][r0 + 0] * inv, o[dt][r0 + 1] * inv), ay = cvt_pk_bf16(o[dt][r0 + 2] * inv, o[dt][r0 + 3] * inv);
                unsigned bx = cvt_pk_bf16(o[dt][r0 + 4] * inv, o[dt][r0 + 5] * inv), by = cvt_pk_bf16(o[dt][r0 + 6] * inv, o[dt][r0 + 7] * inv);
                { auto rr = __builtin_amdgcn_permlane32_swap(ax, bx, false, false); ax = rr[0]; bx = rr[1]; }
                { auto rr = __builtin_amdgcn_permlane32_swap(ay, by, false, false); ay = rr[0]; by = rr[1]; }
                u32x4 w; w.x = ax; w.y = ay; w.z = bx; w.w = by;
                *(GAS u32x4*)(op + dt * 32 + 16 * gp) = w;
            }
        if (pdo) pool_finish(F, ps, pstep, pnw);
#pragma unroll
        for (int d0 = 0; d0 < 4; ++d0) qc[d0] = qn[d0];
    }
    __syncthreads();
}

__device__ __forceinline__ void pool_diff(Frame& F, int first_it) {
    const int NITEM = (NTOK / 32) * 128;
    for (int it = first_it; it < NITEM; it += F.G * 512) {
        const int ri = it >> 7, c8 = it & 127, w = 2 << (c8 >> 5), t0 = ri * 32, pos0 = t0 & (SEQ - 1);
        const bf16_t* up = F.PROJ + (size_t)t0 * INW + UOFF + c8 * 8;
        float S[8];
#pragma unroll
        for (int j = 0; j < 8; ++j) S[j] = 0.f;
        for (int i0 = 1; i0 < w; i0 += 5) { u32x4 pr[5];
#pragma unroll
            for (int q = 0; q < 5; ++q) { const int i = i0 + q; pr[q] = (u32x4){0u, 0u, 0u, 0u}; if (i < w && pos0 - i >= 0) pr[q] = *(const GAS u32x4*)(up - (ptrdiff_t)i * INW); }
#pragma unroll
            for (int q = 0; q < 5; ++q) { const u32x4 raw = pr[q];
                S[0] += bflo(raw.x); S[1] += bfhi(raw.x); S[2] += bflo(raw.y); S[3] += bfhi(raw.y); S[4] += bflo(raw.z); S[5] += bfhi(raw.z); S[6] += bflo(raw.w); S[7] += bfhi(raw.w); } }
#pragma unroll 1
        for (int tc = 0; tc < 32; tc += 8) {
            u32x4 nw[8], od[8];
#pragma unroll
            for (int q = 0; q < 8; ++q) { const int t = tc + q; nw[q] = *(const GAS u32x4*)(up + (ptrdiff_t)t * INW);
                od[q] = (u32x4){0u, 0u, 0u, 0u}; if (pos0 + t - w + 1 >= 0) od[q] = *(const GAS u32x4*)(up + (ptrdiff_t)(t - w + 1) * INW); }
#pragma unroll
            for (int q = 0; q < 8; ++q) { const int t = tc + q; const u32x4 raw = nw[q], old = od[q];
                const float xv[8] = {bflo(raw.x), bfhi(raw.x), bflo(raw.y), bfhi(raw.y), bflo(raw.z), bfhi(raw.z), bflo(raw.w), bfhi(raw.w)};
                const int pos = pos0 + t; const float ic = 1.0f / (float)((pos + 1 < w) ? (pos + 1) : w);
                float d[8];
#pragma unroll
                for (int j = 0; j < 8; ++j) { S[j] += xv[j]; d[j] = S[j] * ic - xv[j]; }
                u32x4 o; o.x = pk2(d[0], d[1]); o.y = pk2(d[2], d[3]); o.z = pk2(d[4], d[5]); o.w = pk2(d[6], d[7]);
                *(GAS u32x4*)(F.MIXED + (size_t)(t0 + t) * DM + 1024 + c8 * 8) = o;
                S[0] -= bflo(old.x); S[1] -= bfhi(old.x); S[2] -= bflo(old.y); S[3] -= bfhi(old.y); S[4] -= bflo(old.z); S[5] -= bfhi(old.z); S[6] -= bflo(old.w); S[7] -= bfhi(old.w); }
        }
    }
}

constexpr int RT_WSTR = 528, RT_W = 0, RT_WLO = 64 * RT_WSTR, RT_L = 2 * 64 * RT_WSTR, RT_LSTR = 65;
__device__ __forceinline__ void route_phase(Frame& F, bool dry) {
    LAS unsigned char* lds = F.lds;
    const int tid = F.tid, lane = F.lane, wid = F.wave, row = lane & 15, kq = lane >> 4;
    for (int tile = F.bx; tile < NTOK / 128; tile += F.G) {
        const int t0 = tile * 128 + wid * 16;
        const bf16_t* hp = F.XB + (size_t)(t0 + row) * DM + kq * 8;
        unsigned char* h8 = F.H8 + (size_t)(t0 + row) * DM + kq * 8;
        f32x4 acc[4]; acc[0] = acc[1] = acc[2] = acc[3] = (f32x4){0.f, 0.f, 0.f, 0.f};
        float ssq = 0.f;
        u32x4 hv[8]; u32x4 wv[8];
#pragma unroll
        for (int ks = 0; ks < 8; ++ks) hv[ks] = *(const GAS u32x4*)(hp + ks * 32);
#pragma unroll
        for (int i = 0; i < 8; ++i) { const int p = i * 512 + tid, which = p >> 11, col = (p & 2047) >> 5, ch = p & 31;
            wv[i] = *(const GAS u32x4*)(F.Wr + (size_t)which * 64 * DM + (size_t)col * DM + ch * 8); }
#pragma unroll 1
        for (int kc = 0; kc < 8; ++kc) {
            __syncthreads();
#pragma unroll
            for (int i = 0; i < 8; ++i) { const int p = i * 512 + tid, which = p >> 11, col = (p & 2047) >> 5, ch = p & 31;
                *(LAS u32x4*)(lds + which * RT_WLO + col * RT_WSTR + ch * 16) = wv[i]; }
            __syncthreads();
            if (kc < 7) {
#pragma unroll
                for (int i = 0; i < 8; ++i) { const int p = i * 512 + tid, which = p >> 11, col = (p & 2047) >> 5, ch = p & 31;
                    wv[i] = *(const GAS u32x4*)(F.Wr + (size_t)which * 64 * DM + (size_t)col * DM + (kc + 1) * 256 + ch * 8); } }
#pragma unroll
            for (int ks = 0; ks < 8; ++ks) {
                const int k = kc * 256 + ks * 32;
                const u32x4 ah = hv[ks];
                if (kc < 7) hv[ks] = *(const GAS u32x4*)(hp + k + 256);
                { const float a0 = bflo(ah.x), a1 = bfhi(ah.x), a2 = bflo(ah.y), a3 = bfhi(ah.y), a4 = bflo(ah.z), a5 = bfhi(ah.z), a6 = bflo(ah.w), a7 = bfhi(ah.w);
                  ssq += (a0 * a0 + a1 * a1) + (a2 * a2 + a3 * a3) + (a4 * a4 + a5 * a5) + (a6 * a6 + a7 * a7);
                  u32x2 w8; w8.x = pk4_fp8(a0, a1, a2, a3); w8.y = pk4_fp8(a4, a5, a6, a7); *(GAS u32x2*)(h8 + k) = w8; }
                const bf16x8 Ah = __builtin_bit_cast(bf16x8, ah);
#pragma unroll
                for (int tc = 0; tc < 4; ++tc) {
                    const LAS unsigned char* bp = lds + (tc * 16 + row) * RT_WSTR + (ks * 32 + kq * 8) * 2;
                    const bf16x8 Bh = *(const LAS bf16x8*)bp, Bl = *(const LAS bf16x8*)(bp + RT_WLO);
                    acc[tc] = __builtin_amdgcn_mfma_f32_16x16x32_bf16(Ah, Bh, acc[tc], 0, 0, 0);
                    acc[tc] = __builtin_amdgcn_mfma_f32_16x16x32_bf16(Ah, Bl, acc[tc], 0, 0, 0);
                }
            }
        }
        ssq += __shfl_xor(ssq, 16); ssq += __shfl_xor(ssq, 32);
        const float rt = 1.0f / sqrtf(ssq * (1.0f / DM) + EPS);
        LAS float* L = (LAS float*)(lds + RT_L) + wid * 16 * RT_LSTR;
#pragma unroll
        for (int tc = 0; tc < 4; ++tc)
#pragma unroll
            for (int r = 0; r < 4; ++r) L[(kq * 4 + r) * RT_LSTR + tc * 16 + row] = acc[tc][r];
        LAS unsigned* lcnt = (LAS unsigned*)(lds + RT_L + 8 * 16 * RT_LSTR * 4); LAS unsigned* lbase = lcnt + NEXP;
        if (tid < NEXP) lcnt[tid] = 0u;
        __syncthreads();
        int me1 = 0, me2 = 0; unsigned r1 = 0u, r2 = 0u;
        if (lane < 16) {
            const int t = t0 + lane; const LAS float* Lt = L + lane * RT_LSTR;
            float c[4]; int grp = 0; float cm;
#pragma unroll
            for (int j = 0; j < 4; ++j) c[j] = Lt[j] * rt + F.b_coarse[j];
            cm = c[0];
#pragma unroll
            for (int j = 1; j < 4; ++j) if (c[j] > cm) { cm = c[j]; grp = j; }
            float den = 0.f;
#pragma unroll
            for (int j = 0; j < 4; ++j) den += __expf(c[j] - cm);
            const float pg = 1.0f / den;
            float f[8];
#pragma unroll
            for (int j = 0; j < 8; ++j) f[j] = Lt[4 + grp * 8 + j] * rt + F.b_fine[grp * 8 + j];
            int i1 = 0; float l1 = f[0];
#pragma unroll
            for (int j = 1; j < 8; ++j) if (f[j] > l1) { l1 = f[j]; i1 = j; }
            int i2 = -1; float l2 = -3.0e38f;
#pragma unroll
            for (int j = 0; j < 8; ++j) if (j != i1 && f[j] > l2) { l2 = f[j]; i2 = j; }
            const float e2 = __expf(l2 - l1), g1 = pg / (1.0f + e2), g2 = pg * e2 / (1.0f + e2);
            F.rtok[t] = rt; F.gate[2 * t] = g1; F.gate[2 * t + 1] = g2;
            me1 = grp * 8 + i1; me2 = grp * 8 + i2;
            r1 = __hip_atomic_fetch_add(&lcnt[me1], 1u, __ATOMIC_RELAXED, __HIP_MEMORY_SCOPE_WORKGROUP);
            r2 = __hip_atomic_fetch_add(&lcnt[me2], 1u, __ATOMIC_RELAXED, __HIP_MEMORY_SCOPE_WORKGROUP);
        }
        __syncthreads();
        if (tid < NEXP) { const unsigned c = lcnt[tid]; unsigned base = 0u;
            if (c && !dry) base = __hip_atomic_fetch_add((unsigned*)(F.ctl + CW_CNT + 64 * tid), c, RLX_AGENT);
            lbase[tid] = base; }
        __syncthreads();
        if (lane < 16 && !dry) { const int t = t0 + lane;
            F.rowl[(size_t)me1 * RCAP + lbase[me1] + r1] = 2 * t;
            F.rowl[(size_t)me2 * RCAP + lbase[me2] + r2] = 2 * t + 1; }
    }
}

__device__ __forceinline__ void moe_setup(Frame& F, int nN, bool with_rg) {
    LAS int* expt = (LAS int*)(F.lds + EXPT_OFF); LAS int* tab = (LAS int*)(F.lds + TAB_OFF); LAS float* tabr = (LAS float*)(F.lds + TABR_OFF); LAS float* tabg = (LAS float*)(F.lds + TABG_OFF);
    __syncthreads();
    if (F.tid < NEXP) expt[33 + F.tid] = (int)__hip_atomic_load((unsigned*)(F.ctl + CW_CNT + 64 * F.tid), RLX_AGENT);
    __syncthreads();
    if (F.tid == 0) { int acc = 0, maxT = 0;
        for (int e = 0; e < NEXP; ++e) { const int T = (expt[33 + e] + 255) >> 8; expt[e] = acc; acc += T * nN; maxT = T > maxT ? T : maxT; }
        expt[32] = acc; expt[70] = (MOE_OWNER && F.G == 256 && maxT <= 12) ? 1 : 0; expt[71] = maxT; }
    __syncthreads();
    pg8::MoeProb P; P.expt = expt; P.nN = nN; P.G = F.G; P.c = F.bx;
    pg8::Unit u;
    int nu = 0; while (P.next(nu, u)) ++nu;
    constexpr int KMAX = (TAB_UNITS * 256 + 511) / 512;
    int v[KMAX]; bool ok[KMAX];
#pragma unroll
    for (int k = 0; k < KMAX; ++k) { const int idx = F.tid + k * 512, i = idx >> 8, r = idx & 255; v[k] = 0; ok[k] = false;
        if (i < nu) { P.next(i, u); const int j = u.pm * 256 + r, cnt = expt[33 + u.e]; ok[k] = j < cnt; v[k] = F.rowl[(size_t)u.e * RCAP + (ok[k] ? j : 0)]; } }
#pragma unroll
    for (int k = 0; k < KMAX; ++k) { const int idx = F.tid + k * 512, i = idx >> 8; if (i < nu) tab[idx] = ok[k] ? v[k] : (v[k] | (int)0x80000000); }
    if (with_rg) {
        float rr[KMAX], gg[KMAX];
#pragma unroll
        for (int k = 0; k < KMAX; ++k) { const int idx = F.tid + k * 512, i = idx >> 8; rr[k] = 0.f; gg[k] = 0.f; if (i < nu && i < TABRG_UNITS) { rr[k] = F.rtok[v[k] >> 1]; gg[k] = F.gate[v[k]]; } }
#pragma unroll
        for (int k = 0; k < KMAX; ++k) { const int idx = F.tid + k * 512, i = idx >> 8; if (i < nu && i < TABRG_UNITS) { const float r = rr[k] * (1.0f / W8_SCALE); tabr[idx] = r; tabg[idx] = r * gg[k] * ACT8_SCALE; } }
    }
    __syncthreads();
}

__device__ __forceinline__ void combine_phase(Frame& F, float* dst) {
    const size_t NIT = (size_t)NTOK * (DM / 8), stride = (size_t)F.G * 512;
    const unsigned char* Y8 = (const unsigned char*)F.Y;
    constexpr float IS = 1.0f / Y8_SCALE;
    for (size_t it0 = (size_t)F.bx * 512 + F.tid; it0 < NIT; it0 += 4 * stride) {
        u32x4 h[4]; u32x2 y0[4], y1[4];
#pragma unroll
        for (int q = 0; q < 4; ++q) { const size_t it = it0 + q * stride; if (it < NIT) { const size_t t = it >> 8; const int c = (int)(it & 255) * 8;
            h[q] = *(const GAS u32x4*)(F.XB + t * DM + c); y0[q] = *(const GAS u32x2*)(Y8 + (2 * t) * DM + c); y1[q] = *(const GAS u32x2*)(Y8 + (2 * t + 1) * DM + c); } }
#pragma unroll
        for (int q = 0; q < 4; ++q) { const size_t it = it0 + q * stride; if (it < NIT) { const size_t t = it >> 8; const int c = (int)(it & 255) * 8;
            float* wp = dst + t * DM + c; f32x4 o0, o1;
            const f32x2 a0 = __builtin_amdgcn_cvt_pk_f32_fp8((int)y0[q].x, false), a1 = __builtin_amdgcn_cvt_pk_f32_fp8((int)y0[q].x, true), a2 = __builtin_amdgcn_cvt_pk_f32_fp8((int)y0[q].y, false), a3 = __builtin_amdgcn_cvt_pk_f32_fp8((int)y0[q].y, true);
            const f32x2 b0 = __builtin_amdgcn_cvt_pk_f32_fp8((int)y1[q].x, false), b1 = __builtin_amdgcn_cvt_pk_f32_fp8((int)y1[q].x, true), b2 = __builtin_amdgcn_cvt_pk_f32_fp8((int)y1[q].y, false), b3 = __builtin_amdgcn_cvt_pk_f32_fp8((int)y1[q].y, true);
            o0.x = bflo(h[q].x) + (a0.x + b0.x) * IS; o0.y = bfhi(h[q].x) + (a0.y + b0.y) * IS; o0.z = bflo(h[q].y) + (a1.x + b1.x) * IS; o0.w = bfhi(h[q].y) + (a1.y + b1.y) * IS;
            o1.x = bflo(h[q].z) + (a2.x + b2.x) * IS; o1.y = bfhi(h[q].z) + (a2.y + b2.y) * IS; o1.z = bflo(h[q].w) + (a3.x + b3.x) * IS; o1.w = bfhi(h[q].w) + (a3.y + b3.y) * IS;
            *(GAS f32x4*)wp = o0; *(GAS f32x4*)(wp + 4) = o1; } }
    }
}

struct Args { const float* in[17]; float* out; unsigned char* ws; int ph_lo, ph_hi, use_bar, pad; };
__global__ void __launch_bounds__(512, 2) hymba_fwd(Args args) {
    extern __shared__ __attribute__((aligned(16))) unsigned char lds[];
    Frame F;
    F.lds = (LAS unsigned char*)lds;
    F.tid = threadIdx.x; F.lane = F.tid & 63; F.wave = __builtin_amdgcn_readfirstlane(F.tid >> 6);
    F.G = gridDim.x; F.bx = blockIdx.x;
    unsigned char* ws = args.ws;
    F.ctl = (gu32*)(ws + WS_CTL);
    F.x = args.in[0]; F.norm_mix = args.in[1]; F.w_in = args.in[2]; F.q_norm = args.in[3]; F.k_norm = args.in[4]; F.sinks = args.in[5]; F.w_pool = args.in[6]; F.pool_scale = args.in[7];
    F.w_out = args.in[8]; F.norm_ffn = args.in[9]; F.w_coarse = args.in[10]; F.b_coarse = args.in[11]; F.w_fine = args.in[12]; F.b_fine = args.in[13]; F.w_gate = args.in[14]; F.w_up = args.in[15]; F.w_down = args.in[16];
    F.out = args.out;
    F.rope = (float*)(ws + WS_ROPE); F.rinv = (float*)(ws + WS_RINV); F.rtok = (float*)(ws + WS_RTOK); F.gate = (float*)(ws + WS_GATE);
    F.Wr = (bf16_t*)(ws + WS_WR); F.Wpool = (bf16_t*)(ws + WS_WPOOL); F.Win = (bf16_t*)(ws + WS_WIN); F.Wout = (bf16_t*)(ws + WS_WOUT); F.Wgu8 = ws + WS_WGU; F.Wd8 = ws + WS_WD; F.H8 = ws + WS_H8; F.ACT8 = ws + WS_ACT8;
    F.XB = (bf16_t*)(ws + WS_XB); F.PROJ = (bf16_t*)(ws + WS_PROJ); F.MIXED = (bf16_t*)(ws + WS_MIXED); F.DPOOL = (bf16_t*)(ws + WS_DPOOL); F.Y = (bf16_t*)(ws + WS_Y);
    F.rowl = (int*)(ws + WS_ROWL);
    if (F.tid < 4) ((LAS unsigned*)(F.lds + MISC_OFF))[F.tid] = 0u;
    __syncthreads();
    XcdBarrier bar; bar.bar = (unsigned*)(F.ctl + CW_BAR); bar.x = 0; bar.st = nullptr;
    if (args.use_bar) bar = xcd_barrier_post((unsigned*)(F.ctl + CW_BAR), (volatile LAS unsigned*)(F.lds + MISC_OFF));
    const int lo = args.ph_lo, hi = args.ph_hi;
#ifndef PHASE_MASK
#define PHASE_MASK 0x1ff
#endif
#define IN(k) (((PHASE_MASK >> (k)) & 1) && lo <= (k) && (k) < hi)
#define SEAM(k) do { if (IN(k) && IN((k) + 1)) xcd_barrier(bar); } while (0)

#define REPS(k) ((PROBE_DUP == (k)) ? 2 : 1)
    if (IN(0)) { for (int rep = 0; rep < REPS(0); ++rep) { if (rep) xcd_barrier(bar); p0_prologue(F); } SEAM(0); }
    if (IN(1)) {
        for (int rep = 0; rep < REPS(1); ++rep) { if (rep) xcd_barrier(bar);
        pg8::DenseProb P; P.A = (const char*)F.XB; P.Bt = (const char*)F.Win; P.ldaB = DM * 2; P.KB = DM * 2; P.acolB = 0; P.so.init(NTOK, INW, F.G, F.bx);
        pg8::EpiBf16 E{F.PROJ, INW, 0, 1.0f};
        pg8::gemm_phase(F.lds, P, E); }
        SEAM(1);
    }
    if (IN(2)) {
#if PROBE_DUP == 2
        { PoolSt ps; pool_begin(F, F.bx * 512 + F.tid, ps); int pstep = 0;
#pragma unroll 1
          for (int u = F.bx; u < BATCH * (SEQ / 128) * (NKV / 2); u += F.G) { const int kp = u & 1, n = (u >> 1) & 31, b = u >> 6; attn_super(F, b, n, kp, ps, pstep); pstep += 4; }
          if (ps.active) for (; pstep < 8; ++pstep) { u32x4 a4[4]; pool_issue(F, ps, pstep, a4); pool_finish(F, ps, pstep, a4); } }
        xcd_barrier(bar);
#elif PROBE_DUP == 22
        pool_diff(F, F.bx * 512 + F.tid + F.G * 512);
        xcd_barrier(bar);
#endif
        { PoolSt ps; pool_begin(F, F.bx * 512 + F.tid, ps); int pstep = 0;
#pragma unroll 1
          for (int u = F.bx; u < BATCH * (SEQ / 128) * (NKV / 2); u += F.G) { const int kp = u & 1, n = (u >> 1) & 31, b = u >> 6; attn_super(F, b, n, kp, ps, pstep); pstep += 4; }
          if (ps.active) for (; pstep < 8; ++pstep) { u32x4 a4[4]; pool_issue(F, ps, pstep, a4); pool_finish(F, ps, pstep, a4); } }
        pool_diff(F, F.bx * 512 + F.tid + F.G * 512);
        SEAM(2);
    }
    if (IN(4)) {
        for (int rep = 0; rep < REPS(4); ++rep) { if (rep) xcd_barrier(bar);
        pg8::DenseProb P; P.A = (const char*)F.MIXED; P.Bt = (const char*)F.Wout; P.ldaB = DM * 2; P.KB = DM * 2; P.acolB = 0; P.so.init(NTOK, DM, F.G, F.bx);
        pg8::EpiResBf16 E{F.rinv, F.XB, DM, F.H8};
        pg8::gemm_phase(F.lds, P, E); }
        SEAM(4);
    }
    if (IN(5)) { for (int rep = 0; rep < REPS(5); ++rep) { if (rep) xcd_barrier(bar); route_phase(F, rep + 1 < REPS(5)); __syncthreads(); if (rep == 0) gu_convert(F); } SEAM(5); }
    if (IN(6)) {
        for (int rep = 0; rep < REPS(6); ++rep) { if (rep) xcd_barrier(bar);
        moe_setup(F, 4, true);
        pg8::MoeProb P; P.A = (const char*)F.H8; P.Bt = (const char*)F.Wgu8; P.ldaB = DM; P.KB = DM; P.nN = 4; P.shift = 1; P.tab = (LAS const int*)(F.lds + TAB_OFF); P.expt = (LAS const int*)(F.lds + EXPT_OFF); P.G = F.G; P.c = F.bx;
        pg8::EpiSwiGLU E{F.ACT8, (LAS const int*)(F.lds + TAB_OFF), (LAS const float*)(F.lds + TABR_OFF), (LAS const float*)(F.lds + TABG_OFF)};
        pg8::gemm_phase<pg8::EpiSwiGLU, pg8::MoeProb, true>(F.lds, P, E);
        if (rep == 0) {
            LAS int* ex = (LAS int*)(F.lds + EXPT_OFF);
            const int U = ex[32], per = F.G >> 3, q = (F.bx & 7) * per + (F.bx >> 3);
            if (ex[70]) {
                if (F.tid == 0) { const int maxnu = (ex[71] + 1) >> 1; int idx = -1, nidle = 0;
                    for (int c2 = 0; c2 < 256; ++c2) { const int e2 = (c2 & 7) + 8 * ((c2 >> 3) >> 3), par = ((c2 >> 3) & 7) >> 2, T2 = (ex[33 + e2] + 255) >> 8, nu2 = (T2 - par + 1) >> 1;
                        if (nu2 < maxnu) { if (c2 == F.bx) idx = nidle; ++nidle; } }
                    ex[72] = idx; ex[73] = nidle; }
                __syncthreads();
                const int idx = ex[72], nidle = ex[73];
                if (nidle == 0) wd_convert(F, q, F.G); else if (idx >= 0) wd_convert(F, idx, nidle);
            } else {
                const int rounds = (U + F.G - 1) / F.G, nb = U - (rounds - 1) * F.G;
                if (U <= 0 || nb >= F.G) wd_convert(F, q, F.G); else if (q >= nb) wd_convert(F, q - nb, F.G - nb);
            }
        } }
        SEAM(6);
    }
    if (IN(7)) {
        for (int rep = 0; rep < REPS(7); ++rep) { if (rep) xcd_barrier(bar);
        moe_setup(F, 8, false);
        pg8::MoeProb P; P.A = (const char*)F.ACT8; P.Bt = (const char*)F.Wd8; P.ldaB = DEXP; P.KB = DEXP; P.nN = 8; P.shift = 0; P.tab = (LAS const int*)(F.lds + TAB_OFF); P.expt = (LAS const int*)(F.lds + EXPT_OFF); P.G = F.G; P.c = F.bx;
        pg8::EpiScatterF8 E{(unsigned char*)F.Y, DM, (LAS const int*)(F.lds + TAB_OFF), Y8_SCALE / (W8_SCALE * ACT8_SCALE)};
        pg8::gemm_phase<pg8::EpiScatterF8, pg8::MoeProb, true, 1, PROBE_EPI2 ? 2 : 1>(F.lds, P, E); }
        SEAM(7);
    }
    if (IN(8)) { for (int rep = 0; rep < REPS(8); ++rep) { if (rep) xcd_barrier(bar); combine_phase(F, (rep + 1 < REPS(8)) ? (float*)(ws + WS_END) : F.out); } }
#undef REPS
#undef IN
#undef SEAM
}

extern "C" void kernel_launch(void* const* d_in, const int* in_sizes, int n_in, void* d_out, int out_size, void* d_ws, size_t ws_size, hipStream_t stream) {
    static int grid = 0;
    if (grid == 0) {
        if (n_in != 17 || out_size != NTOK * DM || ws_size < WS_END) { fprintf(stderr, "kernel_launch: unexpected problem (n_in %d, out %d, ws %zu)\n", n_in, out_size, ws_size); grid = -1; return; }
        int dev = 0, cus = 0;
        if (hipGetDevice(&dev) != hipSuccess || hipDeviceGetAttribute(&cus, hipDeviceAttributeMultiprocessorCount, dev) != hipSuccess) { grid = -1; return; }
        if (hipFuncSetAttribute((const void*)hymba_fwd, hipFuncAttributeMaxDynamicSharedMemorySize, LDS_BYTES) != hipSuccess) { fprintf(stderr, "kernel_launch: hipFuncSetAttribute failed\n"); grid = -1; return; }
        int per_cu = 0;
        if (hipOccupancyMaxActiveBlocksPerMultiprocessor(&per_cu, (const void*)hymba_fwd, 512, LDS_BYTES) != hipSuccess || per_cu < 1) { fprintf(stderr, "kernel_launch: occupancy query says %d\n", per_cu); }
        (void)hipGetLastError();
        grid = cus - (cus % 8);
        if (grid <= 0) grid = -1;
    }
    if (grid < 0) return;
    if (hipMemsetAsync((char*)d_ws + WS_CTL, 0, CTL_ZERO_BYTES, stream) != hipSuccess) return;
    Args a{};
    for (int i = 0; i < 17; ++i) a.in[i] = (const float*)d_in[i];
    a.out = (float*)d_out; a.ws = (unsigned char*)d_ws;
    if (MK_N_LAUNCHES == 1) { a.ph_lo = 0; a.ph_hi = NPHASE; a.use_bar = 1; hipLaunchKernelGGL(hymba_fwd, dim3(grid), dim3(512), LDS_BYTES, stream, a); }
    else for (int p = 0; p < NPHASE; ++p) { a.ph_lo = p; a.ph_hi = p + 1; a.use_bar = 0; hipLaunchKernelGGL(hymba_fwd, dim3(grid), dim3(512), LDS_BYTES, stream, a); }
}
```

```cpp
#include <hip/hip_runtime.h>
#include <cstdio>
#include <cstdint>

#ifndef MK_N_LAUNCHES
#define MK_N_LAUNCHES 1
#endif
#ifndef DENSE_A_NT
#define DENSE_A_NT false
#endif
#ifndef MOE_OWNER
#define MOE_OWNER 1
#endif
#ifndef STORE_AUX
#define STORE_AUX 0
#endif
#ifndef P0_RH
#define P0_RH 4
#endif
#ifndef STAGGER_TICKS
#define STAGGER_TICKS 0
#endif
#ifndef PROBE_EPI2
#define PROBE_EPI2 0
#endif
#ifndef PROBE_K2
#define PROBE_K2 0
#endif
#ifndef PROBE_DUP
#define PROBE_DUP -1
#endif

#define GAS __attribute__((address_space(1)))
#define LAS __attribute__((address_space(3)))
typedef unsigned short bf16_t;
typedef short bf16x8 __attribute__((ext_vector_type(8)));
typedef short s16x4 __attribute__((ext_vector_type(4)));
typedef float f32x4 __attribute__((ext_vector_type(4)));
typedef float f32x2 __attribute__((ext_vector_type(2)));
typedef float f32x16 __attribute__((ext_vector_type(16)));
typedef unsigned u32x4 __attribute__((ext_vector_type(4)));
typedef unsigned u32x2 __attribute__((ext_vector_type(2)));
typedef GAS unsigned gu32;

constexpr int BATCH = 8, SEQ = 4096, NTOK = BATCH * SEQ, DM = 2048;
constexpr int NH = 16, NKV = 4, HD = 64, INW = 2560, QOFF = 0, KOFF = 1024, VOFF = 1280, UOFF = 1536, PW = 1024;
constexpr int NEXP = 32, DEXP = 512, NASG = NTOK * 2, RCAP = NASG;
constexpr float EPS = 1e-6f;
constexpr int NPHASE = 9;

constexpr size_t MiB = 1u << 20;
constexpr size_t WS_CTL = 0, CTL_ZERO_BYTES = 64 * 1024;
constexpr size_t WS_ROPE = 1 * MiB;
constexpr size_t WS_RINV = WS_ROPE + 256 * 1024;
constexpr size_t WS_RTOK = WS_RINV + 128 * 1024;
constexpr size_t WS_GATE = WS_RTOK + 128 * 1024;
constexpr size_t WS_WR = 2 * MiB;
constexpr size_t WS_WPOOL = WS_WR + 512 * 1024;
constexpr size_t WS_WIN = 3 * MiB;
constexpr size_t WS_WOUT = 13 * MiB;
constexpr size_t WS_ROWL = 21 * MiB;
constexpr size_t WS_WGU = 29 * MiB;
constexpr size_t WS_H8 = 93 * MiB;
constexpr size_t WS_WD = 157 * MiB;
constexpr size_t WS_ACT8 = 189 * MiB;
constexpr size_t WS_XB = 221 * MiB;
constexpr size_t WS_PROJ = 349 * MiB;
constexpr size_t WS_MIXED = 509 * MiB;
constexpr size_t WS_DPOOL = 637 * MiB;
constexpr size_t WS_ACT = WS_DPOOL;
constexpr size_t WS_Y = WS_PROJ;
constexpr size_t WS_END = 701 * MiB;
static_assert(WS_Y + (size_t)NASG * DM * 2 <= WS_DPOOL, "Y overlay");
constexpr int CW_TMO = 0, CW_BAR = 1024, CW_CNT = 8192;

constexpr int RING_BYTES = 131072;
constexpr int TAB_OFF = RING_BYTES;
constexpr int TAB_UNITS = 14, TABRG_UNITS = 6;
constexpr int TABR_OFF = TAB_OFF + TAB_UNITS * 1024;
constexpr int TABG_OFF = TABR_OFF + TABRG_UNITS * 1024;
constexpr int EXPT_OFF = TABG_OFF + TABRG_UNITS * 1024;
constexpr int MISC_OFF = EXPT_OFF + 512;
constexpr int LDS_BYTES = 159744;
static_assert(MISC_OFF + 16 <= LDS_BYTES, "LDS map");

#define RLX_AGENT __ATOMIC_RELAXED, __HIP_MEMORY_SCOPE_AGENT
#define LDS_WAIT() asm volatile("s_waitcnt lgkmcnt(0)" ::: "memory")
#define VM_WAIT() asm volatile("s_waitcnt vmcnt(0)" ::: "memory")

__device__ __forceinline__ unsigned f2bf(float f) { unsigned u = __builtin_bit_cast(unsigned, f); return (u + 0x7fffu + ((u >> 16) & 1u)) >> 16; }

__device__ __forceinline__ float bflo(unsigned w) { return __builtin_bit_cast(float, w << 16); }
__device__ __forceinline__ float bfhi(unsigned w) { return __builtin_bit_cast(float, w & 0xffff0000u); }
typedef __bf16 bf16x2_t __attribute__((ext_vector_type(2)));
__device__ __forceinline__ unsigned cvt_pk_bf16(float lo, float hi) { f32x2 v = {lo, hi}; bf16x2_t b = __builtin_convertvector(v, bf16x2_t); return __builtin_bit_cast(unsigned, b); }
__device__ __forceinline__ unsigned pk2(float lo, float hi) { return cvt_pk_bf16(lo, hi); }
__device__ __forceinline__ unsigned pk4_fp8(float a, float b, float c, float d) { int r = 0; r = __builtin_amdgcn_cvt_pk_fp8_f32(a, b, r, false); r = __builtin_amdgcn_cvt_pk_fp8_f32(c, d, r, true); return (unsigned)r; }
constexpr float W8_SCALE = 256.0f, ACT8_SCALE = 8.0f, Y8_SCALE = 32.0f;
__device__ __forceinline__ float wave_sum(float v) {
#pragma unroll
    for (int o = 1; o < 64; o <<= 1) v += __shfl_xor(v, o);
    return v;
}

#define XB_TMO      128
#define XB_XCNT(j)  (256  + 64 * (j))
#define XB_XSUB(j)  (1280 + 64 * (j))
#define XB_XGEN(j)  (2304 + 64 * (j))
#define XB_TOP      3328
#define XB_TOPGEN   3392
#define XCD_BAR_WORDS 3456
#define XB_SPIN_CAP (1u << 18)
__device__ __forceinline__ unsigned xb_ld(unsigned* p)              { return __hip_atomic_load(p, __ATOMIC_RELAXED, __HIP_MEMORY_SCOPE_AGENT); }
__device__ __forceinline__ unsigned xb_add(unsigned* p, unsigned v) { return __hip_atomic_fetch_add(p, v, __ATOMIC_RELAXED, __HIP_MEMORY_SCOPE_AGENT); }
__device__ __forceinline__ unsigned xb_xcc_id() { return (unsigned)__builtin_amdgcn_s_getreg((3 << 11) | 20) & 0xFu; }
#define XB_SPIN(cond, bar) do { unsigned _sp = 0; while (cond) { __builtin_amdgcn_s_sleep(1); \
    if ((++_sp & 255u) == 0u) { if (xb_ld(&(bar)[XB_TMO])) break; if (_sp > XB_SPIN_CAP) { atomicAdd(&(bar)[XB_TMO], 1u); break; } } } } while (0)
struct XcdBarrier { unsigned* bar; unsigned x; volatile LAS unsigned* st; };
__device__ __forceinline__ XcdBarrier xcd_barrier_post(unsigned* bar, volatile LAS unsigned* st) {
    XcdBarrier b; b.bar = bar; b.x = xb_xcc_id(); b.st = st;
    if (threadIdx.x == 0) (void)xb_add(&bar[XB_XCNT(b.x)], 1u);
    return b;
}
__device__ __forceinline__ void xcd_barrier_complete(unsigned* bar, unsigned x, unsigned& nloc, unsigned& nx) {
    const unsigned G = gridDim.x * gridDim.y * gridDim.z;
    unsigned sum, cnt, mine, sp = 0u;
    for (;;) {
        sum = 0u; cnt = 0u; mine = 0u;
#pragma unroll
        for (unsigned j = 0; j < 16; ++j) { const unsigned c = xb_ld(&bar[XB_XCNT(j)]); sum += c; cnt += (c > 0u) ? 1u : 0u; mine = (j == x) ? c : mine; }
        if (sum == G) break;
        __builtin_amdgcn_s_sleep(1);
        if ((++sp & 255u) == 0u) { if (xb_ld(&bar[XB_TMO])) break; if (sp > XB_SPIN_CAP) { atomicAdd(&bar[XB_TMO], 1u); break; } }
    }
    nloc = mine > 0u ? mine : 1u; nx = cnt > 0u ? cnt : 1u;
}
__device__ __forceinline__ void xcd_barrier(const XcdBarrier& b) {
    asm volatile("s_waitcnt vmcnt(0)" ::: "memory");
    __syncthreads();
    if (threadIdx.x == 0) {
        unsigned* bar = b.bar;
        __builtin_amdgcn_s_waitcnt(0);
        unsigned nloc = b.st[0], nx = b.st[1];
        if (nloc == 0u) { xcd_barrier_complete(bar, b.x, nloc, nx); b.st[0] = nloc; b.st[1] = nx; }
        const unsigned old = xb_add(&bar[XB_XSUB(b.x)], 1u);
        const unsigned gen = old / nloc;
        if (old + 1u == (gen + 1u) * nloc) {
            __builtin_amdgcn_fence(__ATOMIC_RELEASE, "agent");
            asm volatile("s_waitcnt vmcnt(0)" ::: "memory");
            const unsigned og = xb_add(&bar[XB_TOP], 1u);
            const unsigned tg = og / nx;
            if (og + 1u == (tg + 1u) * nx) xb_add(&bar[XB_TOPGEN], 1u);
            else XB_SPIN(xb_ld(&bar[XB_TOPGEN]) == tg, bar);
            __builtin_amdgcn_fence(__ATOMIC_ACQUIRE, "agent");
            xb_add(&bar[XB_XGEN(b.x)], 1u);
            asm volatile("s_waitcnt vmcnt(0)" ::: "memory");
        } else {
            XB_SPIN(xb_ld(&bar[XB_XGEN(b.x)]) == gen, bar);
            __builtin_amdgcn_fence(__ATOMIC_ACQUIRE, "agent");
            asm volatile("s_waitcnt vmcnt(0)" ::: "memory");
        }
    }
    __syncthreads();
}

namespace pg8 {
constexpr int BM = 256, BK = 64, HALF = 128, HTB = HALF * BK * 2, STAGE_BYTES = 8 * HTB, NXCD = 8, WGM = 2;
static_assert(STAGE_BYTES == RING_BYTES, "stage region");
__host__ __device__ __forceinline__ int lds_byte(int r, int c) { const int st = (r >> 4) * 2 + (c >> 5), rr = r & 15, cc = c & 31, ob = rr * 64 + cc * 2; return st * 1024 + (ob ^ (((ob >> 9) & 1) << 5)); }
__host__ __device__ __forceinline__ void stage_rc(int b, int& R, int& C) { const int st = b / 1024, sb = b % 1024, swz = sb ^ (((sb >> 9) & 1) << 5); R = (st >> 1) * 16 + swz / 64; C = (st & 1) * 32 + (swz % 64) / 2; }
__host__ __device__ __forceinline__ int perm32(int rho) { const int n = rho >> 4, i = rho & 15; return 8 * (i >> 2) + 4 * n + (i & 3); }

struct Unit { int pm, pn, ord, e, cnt; };

struct StaticOrder {
    int nM, nN, nwg, G, c;
    __device__ void init(int M, int N, int G_, int c_) { nM = M / BM; nN = N / BM; nwg = nM * nN; G = G_; c = c_; }
    __device__ bool next(int i, int& pm, int& pn) const {
        const long L = (long)i * G + c; if (L >= nwg) return false;
        int wgid = (int)L; { const int q = nwg / NXCD, r = nwg % NXCD, xcd = wgid % NXCD, off = wgid / NXCD; wgid = (xcd < r ? xcd * (q + 1) : r * (q + 1) + (xcd - r) * q) + off; }
        const int nig = WGM * nN, gid = wgid / nig, fm = gid * WGM, gsz = (nM - fm) < WGM ? (nM - fm) : WGM;
        pm = fm + ((wgid % nig) % gsz); pn = (wgid % nig) / gsz; return true;
    }
};

typedef int v8i32 __attribute__((ext_vector_type(8)));
template <class Epi, class Prob, bool F8 = false, int KREP = 1, int EPI_REP = 1>
__device__ __forceinline__ void gemm_phase(LAS unsigned char* lds, const Prob& S, const Epi& E) {
    const int tid = threadIdx.x, wid = __builtin_amdgcn_readfirstlane(tid >> 6), lane = tid & 63, wr = wid >> 2, wc = wid & 3, fr = lane & 15, fq = lane >> 4;
    const int KB = S.KB, ntr = KB / 128, nt = ntr * KREP, kmask = ntr - 1;
    int Rr[2], Cc[2]; unsigned voffB[2][2];
#pragma unroll
    for (int i = 0; i < 2; ++i) { stage_rc(tid * 16 + i * 8192, Rr[i], Cc[i]);
#pragma unroll
        for (int h = 0; h < 2; ++h) { const int R = Rr[i], ii = R & 15, Rb = 64 * (R >> 5) + 16 * (ii >> 2) + 8 * h + 4 * ((R >> 4) & 1) + (ii & 3); voffB[h][i] = (unsigned)(Rb * KB + Cc[i] * 2); } }
    const size_t kstep = (size_t)(BK * 2);
    const size_t hstep = (size_t)HALF * KB;
    const unsigned ldsw = (unsigned)wid * 1024u;
    const int aoff = lds_byte(wr * 64 + fr, fq * 8), boff = lds_byte(wc * 32 + fr, fq * 8);
    const int aoff8a = aoff, aoff8b = aoff + 1024, boff8a = boff, boff8b = boff + 1024;
#define PG8_SA(b, h) (((b) * 2 + (h)) * HTB)
#define PG8_SB(b, h) ((4 + (b) * 2 + (h)) * HTB)
#define PG8_STAGE_X(bufoff, gbase, voff, aux) do { _Pragma("unroll") for (int _i = 0; _i < 2; ++_i) \
        __builtin_amdgcn_global_load_lds((const unsigned*)((const char*)(gbase) + (voff)[_i]), (LAS unsigned*)(lds + (bufoff) + ldsw + _i * 8192), 16, 0, aux); } while (0)
#define PG8_STAGE(bufoff, gbase, voff) do { if constexpr (((bufoff) < 4 * HTB) && Prob::A_NT) PG8_STAGE_X(bufoff, gbase, voff, 2); else PG8_STAGE_X(bufoff, gbase, voff, 0); } while (0)
#define PG8_LDA_(dst, b, h) do { _Pragma("unroll") for (int m = 0; m < 4; ++m) _Pragma("unroll") for (int k = 0; k < 2; ++k) dst[m][k] = *(const LAS bf16x8*)(lds + PG8_SA(b, h) + aoff + m * 2048 + k * 1024); } while (0)
#define PG8_LDB_(dst, b, h) do { _Pragma("unroll") for (int n = 0; n < 2; ++n) _Pragma("unroll") for (int k = 0; k < 2; ++k) dst[n][k] = *(const LAS bf16x8*)(lds + PG8_SB(b, h) + boff + n * 2048 + k * 1024); } while (0)
#define PG8_LD8(dst, pa, pb) do { const u32x4 _lo = *(const LAS u32x4*)(pa), _hi = *(const LAS u32x4*)(pb); dst = __builtin_bit_cast(v8i32, __builtin_shufflevector(_lo, _hi, 0, 1, 2, 3, 4, 5, 6, 7)); } while (0)
#define PG8_LDA8(dst, b, h) do { _Pragma("unroll") for (int m = 0; m < 4; ++m) PG8_LD8(dst[m], lds + PG8_SA(b, h) + aoff8a + m * 2048, lds + PG8_SA(b, h) + aoff8b + m * 2048); } while (0)
#define PG8_LDB8(dst, b, h) do { _Pragma("unroll") for (int n = 0; n < 2; ++n) PG8_LD8(dst[n], lds + PG8_SB(b, h) + boff8a + n * 2048, lds + PG8_SB(b, h) + boff8b + n * 2048); } while (0)
#define PG8_LDA(dst, b, h) do { if constexpr (F8) PG8_LDA8(dst##8, b, h); else PG8_LDA_(dst, b, h); } while (0)
#define PG8_LDB(dst, b, h) do { if constexpr (F8) PG8_LDB8(dst##8, b, h); else PG8_LDB_(dst, b, h); } while (0)
#define PG8_MFMA8(c, b8, a8) asm volatile("s_nop 1\n\tv_mfma_f32_16x16x128_f8f6f4 %0, %1, %2, %0" : "+v"(c) : "v"(b8), "v"(a8))
#define PG8_MMA(ai, bj, At, Bt) do { __builtin_amdgcn_s_setprio(1); _Pragma("unroll") for (int m = 0; m < 4; ++m) _Pragma("unroll") for (int n = 0; n < 2; ++n) { \
        if constexpr (F8) PG8_MFMA8(acc[ai][bj][m][n], Bt##8[n], At##8[m]); \
        else { _Pragma("unroll") for (int k = 0; k < 2; ++k) acc[ai][bj][m][n] = __builtin_amdgcn_mfma_f32_16x16x32_bf16(Bt[n][k], At[m][k], acc[ai][bj][m][n], 0, 0, 0); } } __builtin_amdgcn_s_setprio(0); } while (0)
#define PG8_WAIT_V(n) asm volatile("s_waitcnt vmcnt(" #n ")" ::: "memory")
#define PG8_WAIT_L(n) asm volatile("s_waitcnt lgkmcnt(" #n ")" ::: "memory")
#define PG8_BAR __builtin_amdgcn_s_barrier()
#define PG8_SCHED __builtin_amdgcn_sched_barrier(0)
    Unit cur, nxt; int ui = 0;
    if (!S.next(0, cur)) return;
    if (STAGGER_TICKS > 0) {
        const unsigned long long t0 = __builtin_amdgcn_s_memrealtime(), dl = (unsigned long long)(((blockIdx.x >> 3) & 15) * STAGGER_TICKS);
        while (__builtin_amdgcn_s_memrealtime() - t0 < dl) __builtin_amdgcn_s_sleep(4);
    }
    f32x4 acc[2][2][4][2];
    E.init(acc, cur, wr, wc, fr, fq);
    bf16x8 At[4][2], B0[2][2], B1[2][2];
    v8i32 At8[4], B08[2], B18[2];
    unsigned vc[2][2], vn[2][2];
    S.a_voff(cur, Rr, Cc, vc);
    const char* cA = S.a_base(cur); const char* cB = S.b_base(cur);
    PG8_STAGE(PG8_SB(0, 0), cB, voffB[0]); PG8_STAGE(PG8_SB(0, 1), cB, voffB[1]); PG8_STAGE(PG8_SA(0, 0), cA, vc[0]); PG8_STAGE(PG8_SA(0, 1), cA, vc[1]);
    if (wr == 1) PG8_BAR;
    PG8_WAIT_V(2); PG8_BAR;
    PG8_STAGE(PG8_SB(1, 0), cB + kstep, voffB[0]); PG8_STAGE(PG8_SA(1, 0), cA + kstep, vc[0]); PG8_STAGE(PG8_SB(1, 1), cB + kstep, voffB[1]);
    PG8_WAIT_V(6); PG8_BAR;
    for (;;) {
        const bool has_next = S.next(ui + 1, nxt);
        const char* nA = has_next ? S.a_base(nxt) : cA; const char* nB = has_next ? S.b_base(nxt) : cB;
        if (has_next) S.a_voff(nxt, Rr, Cc, vn); else { vn[0][0] = vc[0][0]; vn[0][1] = vc[0][1]; vn[1][0] = vc[1][0]; vn[1][1] = vc[1][1]; }
        for (int t = 0; t < nt; t += 2) {
            const bool last = (t == nt - 2);
            const int t1 = (KREP == 1) ? t + 1 : ((t + 1) & kmask), t2 = (KREP == 1) ? t + 2 : ((t + 2) & kmask);
            const char* a1 = cA + (size_t)t1 * kstep;
            const char* a2 = last ? nA : cA + (size_t)t2 * kstep; const char* b2 = last ? nB : cB + (size_t)t2 * kstep;
            const char* a3 = a2 + kstep; const char* b3 = b2 + kstep;
            unsigned w0[2], w1[2]; w0[0] = last ? vn[0][0] : vc[0][0]; w0[1] = last ? vn[0][1] : vc[0][1]; w1[0] = last ? vn[1][0] : vc[1][0]; w1[1] = last ? vn[1][1] : vc[1][1];
            PG8_LDB(B0, 0, 0); PG8_LDB(B1, 0, 1); PG8_SCHED; PG8_LDA(At, 0, 0); PG8_STAGE(PG8_SA(1, 1), a1, vc[1]);
            PG8_WAIT_V(8); PG8_WAIT_L(0); PG8_BAR; PG8_MMA(0, 0, At, B0); PG8_MMA(0, 1, At, B1); PG8_BAR; PG8_SCHED;
            PG8_LDA(At, 0, 1); PG8_STAGE(PG8_SB(0, 0), b2, voffB[0]); PG8_STAGE(PG8_SB(0, 1), b2, voffB[1]); PG8_STAGE(PG8_SA(0, 0), a2, w0);
            PG8_WAIT_V(8); PG8_WAIT_L(0); PG8_BAR; PG8_MMA(1, 0, At, B0); PG8_MMA(1, 1, At, B1); PG8_BAR; PG8_SCHED;
            PG8_LDB(B0, 1, 0); PG8_LDB(B1, 1, 1); PG8_SCHED; PG8_LDA(At, 1, 0); PG8_STAGE(PG8_SA(0, 1), a2, w1);
            PG8_WAIT_V(8); PG8_WAIT_L(0); PG8_BAR; PG8_MMA(0, 0, At, B0); PG8_MMA(0, 1, At, B1); PG8_BAR; PG8_SCHED;
            PG8_LDA(At, 1, 1); PG8_STAGE(PG8_SB(1, 0), b3, voffB[0]); PG8_STAGE(PG8_SB(1, 1), b3, voffB[1]); PG8_STAGE(PG8_SA(1, 0), a3, w0);
            PG8_WAIT_V(8); PG8_WAIT_L(0); PG8_BAR; PG8_MMA(1, 0, At, B0); PG8_MMA(1, 1, At, B1); PG8_BAR; PG8_SCHED;
        }
        if (wr == 0) PG8_BAR;
        if constexpr (F8) asm volatile("s_nop 15\n\ts_nop 7" ::: "memory");
#pragma unroll
        for (int er = 0; er < EPI_REP; ++er) E(acc, cur, wr, wc, fr, fq);
        if (!has_next) break;
        E.init(acc, nxt, wr, wc, fr, fq);
        cur = nxt; cA = nA; cB = nB; ++ui;
        vc[0][0] = vn[0][0]; vc[0][1] = vn[0][1]; vc[1][0] = vn[1][0]; vc[1][1] = vn[1][1];
        if (wr == 1) PG8_BAR;
    }
    PG8_WAIT_V(0);
    PG8_BAR;
#undef PG8_SA
#undef PG8_SB
#undef PG8_STAGE
#undef PG8_STAGE_X
#undef PG8_LDA
#undef PG8_LDB
#undef PG8_MMA
#undef PG8_MFMA8
#undef PG8_LDA_
#undef PG8_LDB_
#undef PG8_LD8
#undef PG8_LDA8
#undef PG8_LDB8
#undef PG8_WAIT_V
#undef PG8_WAIT_L
#undef PG8_BAR
#undef PG8_SCHED
}

struct DenseProb {
    static constexpr bool A_NT = DENSE_A_NT;
    const char* A; const char* Bt; int ldaB, KB, acolB;
    StaticOrder so;
    __device__ __forceinline__ bool next(int i, Unit& u) const { u.ord = i; u.e = 0; u.cnt = 256; return so.next(i, u.pm, u.pn); }
    __device__ __forceinline__ const char* a_base(const Unit& u) const { return A + (size_t)u.pm * BM * ldaB + (size_t)u.pn * acolB; }
    __device__ __forceinline__ const char* b_base(const Unit& u) const { return Bt + (size_t)u.pn * BM * KB; }
    __device__ __forceinline__ void a_voff(const Unit&, const int (&R)[2], const int (&C)[2], unsigned (&vo)[2][2]) const {
#pragma unroll
        for (int h = 0; h < 2; ++h)
#pragma unroll
            for (int i = 0; i < 2; ++i) vo[h][i] = (unsigned)((h * HALF + R[i]) * ldaB + C[i] * 2);
    }
};

struct MoeProb {
    static constexpr bool A_NT = false;
    const char* A; const char* Bt; int ldaB, KB, nN, shift;
    LAS const int* tab;
    LAS const int* expt;
    int G, c;
    __device__ __forceinline__ bool next(int i, Unit& u) const {
        const int per = G >> 3, xcd = c & 7, rank = c >> 3;
        if (expt[70]) {
            const int e = xcd + 8 * (rank >> 3), sub = rank & 7, cnt = expt[33 + e], T = (cnt + 255) >> 8;
            const int pn = (nN == 8) ? sub : (sub & 3), pm = (nN == 8) ? i : 2 * i + (sub >> 2);
            if (pm >= T || i >= TAB_UNITS) return false;
            u.e = e; u.pn = pn; u.pm = pm; u.ord = i; u.cnt = cnt - pm * 256; return true;
        }
        const int L = (i * 8 + xcd) * per + rank;
        if (L >= expt[32] || i >= TAB_UNITS) return false;
        int e = 0;
#pragma unroll 1
        while (e < 31 && L >= expt[e + 1]) ++e;
        const int q = L - expt[e], cnt = expt[33 + e], T = (cnt + 255) >> 8;
        u.e = e; u.pn = q / T; u.pm = q % T; u.ord = i; u.cnt = cnt - u.pm * 256; return true;
    }
    __device__ __forceinline__ const char* a_base(const Unit&) const { return A; }
    __device__ __forceinline__ const char* b_base(const Unit& u) const { return Bt + ((size_t)u.e * nN + u.pn) * BM * KB; }
    __device__ __forceinline__ void a_voff(const Unit& u, const int (&R)[2], const int (&C)[2], unsigned (&vo)[2][2]) const {
#pragma unroll
        for (int h = 0; h < 2; ++h)
#pragma unroll
            for (int i = 0; i < 2; ++i) { const unsigned row = ((unsigned)tab[u.ord * 256 + h * HALF + R[i]] & 0x7fffffffu) >> shift; vo[h][i] = row * (unsigned)ldaB + (unsigned)C[i] * 2u; }
    }
};

struct EpiBf16 {
    bf16_t* O; int ldc, cbase; float scale;
    __device__ __forceinline__ void init(f32x4 (&acc)[2][2][4][2], const Unit&, int, int, int, int) const {
#pragma unroll
        for (int a = 0; a < 2; ++a)
#pragma unroll
            for (int b = 0; b < 2; ++b)
#pragma unroll
                for (int m = 0; m < 4; ++m)
#pragma unroll
                    for (int n = 0; n < 2; ++n) acc[a][b][m][n] = (f32x4){0.f, 0.f, 0.f, 0.f};
    }
    __device__ __forceinline__ void operator()(const f32x4 (&acc)[2][2][4][2], const Unit& u, int wr, int wc, int fr, int fq) const {
        const int row0 = u.pm * BM + wr * 64 + fr, col0 = cbase + u.pn * BM + wc * 64 + 16 * fq;
#pragma unroll
        for (int ai = 0; ai < 2; ++ai)
#pragma unroll
            for (int m = 0; m < 4; ++m) { bf16_t* rowp = O + (size_t)(row0 + ai * HALF + m * 16) * ldc + col0;
#pragma unroll
                for (int bj = 0; bj < 2; ++bj) { const f32x4 v0 = acc[ai][bj][m][0] * scale, v1 = acc[ai][bj][m][1] * scale;
                    u32x4 w; w.x = cvt_pk_bf16(v0[0], v0[1]); w.y = cvt_pk_bf16(v0[2], v0[3]); w.z = cvt_pk_bf16(v1[0], v1[1]); w.w = cvt_pk_bf16(v1[2], v1[3]);
                    *(u32x4*)(rowp + bj * 8) = w; } }
    }
};
struct EpiResBf16 {
    const float* rms; bf16_t* O; int ldc; unsigned char* O8;
    __device__ __forceinline__ void init(f32x4 (&acc)[2][2][4][2], const Unit& u, int wr, int wc, int fr, int fq) const {
        const int row0 = u.pm * BM + wr * 64 + fr, col0 = u.pn * BM + wc * 64 + 16 * fq;
        u32x4 raw[2][4][2]; float rs[2][4];
#pragma unroll
        for (int ai = 0; ai < 2; ++ai)
#pragma unroll
            for (int m = 0; m < 4; ++m) { const int row = row0 + ai * HALF + m * 16; rs[ai][m] = rms[row];
#pragma unroll
                for (int bj = 0; bj < 2; ++bj) raw[ai][m][bj] = *(const GAS u32x4*)(O + (size_t)row * ldc + col0 + bj * 8); }
#pragma unroll
        for (int ai = 0; ai < 2; ++ai)
#pragma unroll
            for (int m = 0; m < 4; ++m)
#pragma unroll
                for (int bj = 0; bj < 2; ++bj) { const u32x4 w = raw[ai][m][bj]; const float r = rs[ai][m];
                    acc[ai][bj][m][0] = (f32x4){bflo(w.x) * r, bfhi(w.x) * r, bflo(w.y) * r, bfhi(w.y) * r};
                    acc[ai][bj][m][1] = (f32x4){bflo(w.z) * r, bfhi(w.z) * r, bflo(w.w) * r, bfhi(w.w) * r}; }
    }
    __device__ __forceinline__ void operator()(const f32x4 (&acc)[2][2][4][2], const Unit& u, int wr, int wc, int fr, int fq) const {
        const int row0 = u.pm * BM + wr * 64 + fr, col0 = u.pn * BM + wc * 64 + 16 * fq;
#pragma unroll
        for (int ai = 0; ai < 2; ++ai)
#pragma unroll
            for (int m = 0; m < 4; ++m) { bf16_t* rowp = O + (size_t)(row0 + ai * HALF + m * 16) * ldc + col0;
#pragma unroll
                for (int bj = 0; bj < 2; ++bj) { const f32x4 v0 = acc[ai][bj][m][0], v1 = acc[ai][bj][m][1];
                    u32x4 w; w.x = cvt_pk_bf16(v0[0], v0[1]); w.y = cvt_pk_bf16(v0[2], v0[3]); w.z = cvt_pk_bf16(v1[0], v1[1]); w.w = cvt_pk_bf16(v1[2], v1[3]);
                    *(u32x4*)(rowp + bj * 8) = w; } }
    }
};
struct EpiSwiGLU {
    unsigned char* act; LAS const int* tab; LAS const float* tabr; LAS const float* tabg;
    __device__ __forceinline__ void init(f32x4 (&acc)[2][2][4][2], const Unit&, int, int, int, int) const {
#pragma unroll
        for (int a = 0; a < 2; ++a)
#pragma unroll
            for (int b = 0; b < 2; ++b)
#pragma unroll
                for (int m = 0; m < 4; ++m)
#pragma unroll
                    for (int n = 0; n < 2; ++n) acc[a][b][m][n] = (f32x4){0.f, 0.f, 0.f, 0.f};
    }
    __device__ __forceinline__ void operator()(const f32x4 (&acc)[2][2][4][2], const Unit& u, int wr, int wc, int fr, int fq) const {
        const int col0 = u.pn * HALF + wc * 32 + 8 * fq;
#pragma unroll
        for (int ai = 0; ai < 2; ++ai)
#pragma unroll
            for (int m = 0; m < 4; ++m) { const int rl = ai * HALF + wr * 64 + m * 16 + fr; const int a = tab[u.ord * 256 + rl];
                const float r = tabr[u.ord * 256 + rl], rg = tabg[u.ord * 256 + rl];
                if (a >= 0) { float o[8];
#pragma unroll
                    for (int n = 0; n < 2; ++n)
#pragma unroll
                        for (int j = 0; j < 4; ++j) { const float g = acc[ai][0][m][n][j] * r; o[n * 4 + j] = g * __builtin_amdgcn_rcpf(1.0f + __builtin_amdgcn_exp2f(g * -1.4426950408889634f)) * (acc[ai][1][m][n][j] * rg); }
                    u32x2 w; w.x = pk4_fp8(o[0], o[1], o[2], o[3]); w.y = pk4_fp8(o[4], o[5], o[6], o[7]);
                    *(u32x2*)(act + (size_t)a * DEXP + col0) = w; } }
    }
};
struct EpiScatterF8 {
    unsigned char* Y; int ldc; LAS const int* tab; float scale;
    __device__ __forceinline__ void init(f32x4 (&acc)[2][2][4][2], const Unit&, int, int, int, int) const {
#pragma unroll
        for (int a = 0; a < 2; ++a)
#pragma unroll
            for (int b = 0; b < 2; ++b)
#pragma unroll
                for (int m = 0; m < 4; ++m)
#pragma unroll
                    for (int n = 0; n < 2; ++n) acc[a][b][m][n] = (f32x4){0.f, 0.f, 0.f, 0.f};
    }
    __device__ __forceinline__ void operator()(const f32x4 (&acc)[2][2][4][2], const Unit& u, int wr, int wc, int fr, int fq) const {
        const int col0 = u.pn * BM + wc * 64 + 16 * fq;
#pragma unroll
        for (int ai = 0; ai < 2; ++ai)
#pragma unroll
            for (int m = 0; m < 4; ++m) { const int rl = ai * HALF + wr * 64 + m * 16 + fr; const int a = tab[u.ord * 256 + rl];
                if (a >= 0) { const f32x4 v0 = acc[ai][0][m][0] * scale, v1 = acc[ai][0][m][1] * scale, v2 = acc[ai][1][m][0] * scale, v3 = acc[ai][1][m][1] * scale;
                    u32x4 w; w.x = pk4_fp8(v0[0], v0[1], v0[2], v0[3]); w.y = pk4_fp8(v1[0], v1[1], v1[2], v1[3]); w.z = pk4_fp8(v2[0], v2[1], v2[2], v2[3]); w.w = pk4_fp8(v3[0], v3[1], v3[2], v3[3]);
                    *(u32x4*)(Y + (size_t)a * ldc + col0) = w; } }
    }
};
}

struct Frame {
    LAS unsigned char* lds;
    gu32* ctl;
    int tid, lane, wave, G, bx;
    const float *x, *norm_mix, *w_in, *q_norm, *k_norm, *sinks, *w_pool, *pool_scale, *w_out, *norm_ffn, *w_coarse, *b_coarse, *w_fine, *b_fine, *w_gate, *w_up, *w_down;
    float* out;
    float *rope, *rinv, *rtok, *gate;
    bf16_t *Wr, *Wpool, *Win, *Wout, *XB, *PROJ, *MIXED, *DPOOL, *Y;
    unsigned char *Wgu8, *Wd8, *H8, *ACT8;
    int* rowl;
};

__device__ __forceinline__ void tr_item(const float* W, int N, int k0, int n0, bf16_t* dst0, int Kd, const float* gk, const float* gn, LAS float* scr, int lane) {
    const int kk0 = lane >> 3, n4 = (lane & 7) * 4;
    f32x4 v[8];
#pragma unroll
    for (int i = 0; i < 8; ++i) v[i] = __builtin_nontemporal_load((const GAS f32x4*)(W + (size_t)(k0 + 8 * i + kk0) * N + n0 + n4));
    f32x4 sn = (f32x4){1.f, 1.f, 1.f, 1.f}; if (gn) sn = *(const GAS f32x4*)(gn + n0 + n4);
#pragma unroll
    for (int i = 0; i < 8; ++i) { const float g = gk ? gk[k0 + 8 * i + kk0] : 1.0f; const f32x4 w = v[i] * sn * g; LAS float* d = scr + (8 * i + kk0) * 33 + n4; d[0] = w.x; d[1] = w.y; d[2] = w.z; d[3] = w.w; }
    LDS_WAIT(); asm volatile("" ::: "memory");
    const int c = lane & 7;
#pragma unroll
    for (int j = 0; j < 4; ++j) { const int n = (lane >> 3) + 8 * j; const LAS float* s = scr + (8 * c) * 33 + n;
        u32x4 o; o.x = pk2(s[0 * 33], s[1 * 33]); o.y = pk2(s[2 * 33], s[3 * 33]); o.z = pk2(s[4 * 33], s[5 * 33]); o.w = pk2(s[6 * 33], s[7 * 33]);
        *(GAS u32x4*)(dst0 + (size_t)n * Kd + k0 + 8 * c) = o; }
    LDS_WAIT(); asm volatile("" ::: "memory");
}

__device__ __forceinline__ void tr_item8(const float* W, int N, int k0, int n0, unsigned char* dst0, int Kd, const float* gk, LAS float* scr, int lane, int gu = 0) {
    const int kk0 = lane >> 3, n4 = (lane & 7) * 4;
    f32x4 v[8];
#pragma unroll
    for (int i = 0; i < 8; ++i) v[i] = __builtin_nontemporal_load((const GAS f32x4*)(W + (size_t)(k0 + 8 * i + kk0) * N + n0 + n4));
#pragma unroll
    for (int i = 0; i < 8; ++i) { const float g = (gk ? gk[k0 + 8 * i + kk0] : 1.0f) * W8_SCALE; const f32x4 w = v[i] * g; LAS float* d = scr + (8 * i + kk0) * 33 + n4; d[0] = w.x; d[1] = w.y; d[2] = w.z; d[3] = w.w; }
    LDS_WAIT(); asm volatile("" ::: "memory");
    const int c = lane & 7;
#pragma unroll
    for (int j = 0; j < 4; ++j) { const int n = (lane >> 3) + 8 * j; const LAS float* s = scr + (8 * c) * 33 + n;
        u32x2 o; o.x = pk4_fp8(s[0 * 33], s[1 * 33], s[2 * 33], s[3 * 33]); o.y = pk4_fp8(s[4 * 33], s[5 * 33], s[6 * 33], s[7 * 33]);
        const int x = n0 + n, drow = gu ? (256 * (x >> 7) + 64 * ((x >> 5) & 3) + 16 * ((x >> 3) & 3) + 8 * (gu - 1) + (x & 7)) : n;
        *(GAS u32x2*)(dst0 + (size_t)drow * Kd + k0 + 8 * c) = o; }
    LDS_WAIT(); asm volatile("" ::: "memory");
}

__device__ __forceinline__ void wd_convert(Frame& F, int iw, int nwg) {
    LAS float* scr = (LAS float*)(F.lds + F.wave * 16384);
    constexpr int I_D = NEXP * (DEXP / 64) * (DM / 32);
    for (int r = iw * 8 + F.wave; r < I_D; r += nwg * 8) {
        const int per = (DEXP / 64) * (DM / 32), e = r / per, q = r % per, nb = DM / 32, kb = q / nb, nn = q % nb;
        tr_item8(F.w_down + (size_t)e * DEXP * DM, DM, 64 * kb, 32 * nn, F.Wd8 + ((size_t)e * DM + 32 * nn) * DEXP, DEXP, nullptr, scr, F.lane);
    }
}

__device__ __forceinline__ void gu_convert(Frame& F) {
    LAS float* scr = (LAS float*)(F.lds + F.wave * 16384);
    constexpr int I_G = NEXP * (DM / 64) * (DEXP / 32);
    for (int it = F.bx * 8 + F.wave; it < 2 * I_G; it += F.G * 8) {
        int r = it; const int up = r >= I_G; if (up) r -= I_G;
        const int per = (DM / 64) * (DEXP / 32), e = r / per, q = r % per, nb = DEXP / 32, kb = q / nb, nn = q % nb, n0 = 32 * nn;
        const float* W = (up ? F.w_up : F.w_gate) + (size_t)e * DM * DEXP;
        tr_item8(W, DEXP, 64 * kb, n0, F.Wgu8 + (size_t)e * 1024 * DM, DM, F.norm_ffn, scr, F.lane, up ? 2 : 1);
    }
}

__device__ __forceinline__ void x_row_load(const Frame& F, int m, f32x4 (&v)[8]) {
    const GAS f32x4* xr = (const GAS f32x4*)(F.x + (size_t)m * DM) + F.lane;
#pragma unroll
    for (int j = 0; j < 8; ++j) v[j] = __builtin_nontemporal_load(xr + 64 * j);
}
__device__ __forceinline__ void x_row_finish(const Frame& F, int m, const f32x4 (&v)[8]) {
    float s = 0.f;
#pragma unroll
    for (int j = 0; j < 8; ++j) s += (v[j].x * v[j].x + v[j].y * v[j].y) + (v[j].z * v[j].z + v[j].w * v[j].w);
    s = wave_sum(s);
    const float rms = sqrtf(s * (1.0f / DM) + EPS), rr = 1.0f / rms;
    if (F.lane == 0) F.rinv[m] = rms;
    GAS u32x2* o8 = (GAS u32x2*)(F.XB + (size_t)m * DM) + F.lane;
#pragma unroll
    for (int j = 0; j < 8; ++j) { u32x2 w; w.x = pk2(v[j].x * rr, v[j].y * rr); w.y = pk2(v[j].z * rr, v[j].w * rr); o8[64 * j] = w; }
}
__device__ __forceinline__ void x_rows(const Frame& F, int m0, int step, int end) {
    int m = m0; if (m >= end) return;
    f32x4 a[8], b[8]; x_row_load(F, m, a);
    for (;;) {
        const int m1 = m + step; const bool h1 = m1 < end; if (h1) x_row_load(F, m1, b);
        x_row_finish(F, m, a); if (!h1) break;
        const int m2 = m1 + step; const bool h2 = m2 < end; if (h2) x_row_load(F, m2, a);
        x_row_finish(F, m1, b); if (!h2) break;
        m = m2;
    }
}

__device__ __forceinline__ void p0_prologue(Frame& F) {
    const int groups = F.G >> 3, NHG = groups >> 1, NSG = groups - NHG, NHW = NHG * 8, NSW = NSG * 8;
    const bool helper = ((F.bx >> 3) & 1) && ((F.bx >> 4) < NHG);
    const int cx = ((F.bx >> 4) << 3) | (F.bx & 7);
    const int ROWS_H = NHW * 8 * P0_RH;
    if (!helper) { x_rows(F, ROWS_H + cx * 8 + F.wave, NSW * 8, NTOK); return; }
    const int gw = cx * 8 + F.wave, NGW = NHW * 8, gt = cx * 512 + F.tid, NGT = NHW * 512;
    LAS float* scr = (LAS float*)(F.lds + F.wave * 16384);
    for (int i = gt; i < SEQ * 8; i += NGT) {
        const int pos = i >> 3, j = i & 7;
        const double invf[8] = {1.0, 0.19392274474868576, 0.03760603093086393, 0.007292664737217109, 0.001414213562373095, 0.0002742481756762073, 5.318295896944988e-05, 1.031338537721246e-05};
        double f = invf[0];
#pragma unroll
        for (int q = 1; q < 8; ++q) f = (j == q) ? invf[q] : f;
        double s, c; sincos((double)pos * f, &s, &c);
        F.rope[pos * 16 + j] = (float)c; F.rope[pos * 16 + 8 + j] = (float)s;
    }
    for (int i = gt; i < 64 * DM; i += NGT) {
        const int j = i / DM, k = i % DM; float v = 0.f;
        if (j < 4) v = F.w_coarse[k * 4 + j] * F.norm_ffn[k]; else if (j < 36) v = F.w_fine[k * 32 + (j - 4)] * F.norm_ffn[k];
        const unsigned hi = f2bf(v); const float lo = v - bflo(hi);
        F.Wr[i] = (bf16_t)hi; F.Wr[64 * DM + i] = (bf16_t)f2bf(lo);
    }
    constexpr int I_IN = (DM / 64) * (INW / 32), I_OUT = (1024 / 64) * (DM / 32);
    constexpr int NITEMS = I_IN + I_OUT;
    for (int it = gw; it < NITEMS; it += NGW) {
        int r = it;
        if (r < I_IN) { const int nb = INW / 32, kb = r / nb, nn = r % nb; tr_item(F.w_in, INW, 64 * kb, 32 * nn, F.Win + (size_t)(32 * nn) * DM, DM, F.norm_mix, nullptr, scr, F.lane); continue; } r -= I_IN;
        if (r < I_OUT) { const int nb = DM / 32, kb = r / nb, nn = r % nb; tr_item(F.w_out, DM, 64 * kb, 32 * nn, F.Wout + (size_t)(32 * nn) * DM, DM, nullptr, nullptr, scr, F.lane); continue; } r -= I_OUT;
    }
    for (int wt = cx; wt < 256; wt += NHW) {
        const int pr = wt >> 3, g = pr >> 3, c0 = (pr & 7) * 32, n0 = ((wt & 7) * 8 + F.wave) * 32, i = F.lane & 31, kk = F.lane >> 5;
        LAS float* wp = (LAS float*)F.lds;
        __syncthreads();
        for (int e = F.tid; e < 32 * 256; e += 512) { const int c = e >> 8, j = e & 255; wp[c * 257 + j] = F.w_pool[(size_t)g * 65536 + (size_t)(c0 + c) * 256 + j] * F.pool_scale[g * 256 + j]; }
        __syncthreads();
        const float* ap = F.w_out + (size_t)(1024 + g * 256 + kk) * DM + n0 + i;
        const LAS float* bp = wp + i * 257 + kk;
        f32x16 acc = {};
#pragma unroll 16
        for (int j0 = 0; j0 < 256; j0 += 2) acc = __builtin_amdgcn_mfma_f32_32x32x2f32(ap[(size_t)j0 * DM], bp[j0], acc, 0, 0, 0);
        bf16_t* op = F.Wout + (size_t)n0 * DM + 1024 + g * 256 + c0 + i;
#pragma unroll
        for (int r = 0; r < 16; ++r) { const int nr = (r & 3) + 8 * (r >> 2) + 4 * kk; op[(size_t)nr * DM] = (bf16_t)f2bf(acc[r]); }
    }
    __syncthreads();
    x_rows(F, gw, NGW, ROWS_H);
}

struct PoolSt { int it; float S[8]; bool active; };
struct PoolGeo { const bf16_t* up; bf16_t* dp; int w, pos0; };
__device__ __forceinline__ PoolGeo pool_geo(const Frame& F, int it) {
    const int ri = it >> 7, c8 = it & 127, t0 = ri * 32; PoolGeo g;
    g.w = 2 << (c8 >> 5); g.pos0 = t0 & (SEQ - 1); g.up = F.PROJ + (size_t)t0 * INW + UOFF + c8 * 8; g.dp = F.MIXED + (size_t)t0 * DM + 1024 + c8 * 8; return g;
}
__device__ __forceinline__ void pool_begin(Frame& F, int it, PoolSt& ps) {
    const int NITEM = (NTOK / 32) * 128;
    ps.active = it < NITEM; ps.it = ps.active ? it : 0;
    const PoolGeo g = pool_geo(F, ps.it);
#pragma unroll
    for (int j = 0; j < 8; ++j) ps.S[j] = 0.f;
    for (int i0 = 1; i0 < g.w; i0 += 5) { u32x4 pr[5];
#pragma unroll
        for (int q = 0; q < 5; ++q) { const int i = i0 + q; pr[q] = (u32x4){0u, 0u, 0u, 0u}; if (i < g.w && g.pos0 - i >= 0) pr[q] = *(const GAS u32x4*)(g.up - (ptrdiff_t)i * INW); }
#pragma unroll
        for (int q = 0; q < 5; ++q) { const u32x4 raw = pr[q];
            ps.S[0] += bflo(raw.x); ps.S[1] += bfhi(raw.x); ps.S[2] += bflo(raw.y); ps.S[3] += bfhi(raw.y); ps.S[4] += bflo(raw.z); ps.S[5] += bfhi(raw.z); ps.S[6] += bflo(raw.w); ps.S[7] += bfhi(raw.w); } }
}
__device__ __forceinline__ void pool_issue(const Frame& F, const PoolSt& ps, int k, u32x4 (&nw)[4]) {
    const PoolGeo g = pool_geo(F, ps.it);
#pragma unroll
    for (int q = 0; q < 4; ++q) nw[q] = *(const GAS u32x4*)(g.up + (ptrdiff_t)(4 * k + q) * INW);
}
__device__ __forceinline__ void pool_finish(const Frame& F, PoolSt& ps, int k, const u32x4 (&nw)[4]) {
    const PoolGeo g = pool_geo(F, ps.it);
    u32x4 od[4];
#pragma unroll
    for (int q = 0; q < 4; ++q) { const int t = 4 * k + q; const int to = t - g.w + 1, toc = (g.pos0 + to >= 0) ? to : t;
        od[q] = *(const GAS u32x4*)(g.up + (ptrdiff_t)toc * INW); }
#pragma unroll
    for (int q = 0; q < 4; ++q) { const int t = 4 * k + q; const u32x4 raw = nw[q]; const bool has_old = g.pos0 + t - g.w + 1 >= 0;
        const u32x4 old = has_old ? od[q] : (u32x4){0u, 0u, 0u, 0u};
        const float xv[8] = {bflo(raw.x), bfhi(raw.x), bflo(raw.y), bfhi(raw.y), bflo(raw.z), bfhi(raw.z), bflo(raw.w), bfhi(raw.w)};
        const int pos = g.pos0 + t; const float ic = __builtin_amdgcn_rcpf((float)((pos + 1 < g.w) ? (pos + 1) : g.w));
        float d[8];
#pragma unroll
        for (int j = 0; j < 8; ++j) { ps.S[j] += xv[j]; d[j] = ps.S[j] * ic - xv[j]; }
        u32x4 o; o.x = pk2(d[0], d[1]); o.y = pk2(d[2], d[3]); o.z = pk2(d[4], d[5]); o.w = pk2(d[6], d[7]);
        *(GAS u32x4*)(g.dp + (size_t)t * DM) = o;
        ps.S[0] -= bflo(old.x); ps.S[1] -= bfhi(old.x); ps.S[2] -= bflo(old.y); ps.S[3] -= bfhi(old.y); ps.S[4] -= bflo(old.z); ps.S[5] -= bfhi(old.z); ps.S[6] -= bflo(old.w); ps.S[7] -= bfhi(old.w); }
}

constexpr int AT_K = 0, AT_V = 32768, AT_VSTR = 520, AT_UNIT = 32768 + 64 * 520;
static_assert(2 * AT_UNIT <= EXPT_OFF, "attention LDS");
__device__ __forceinline__ void attn_super(Frame& F, int b, int n, int kp, PoolSt& ps, int step0) {
    LAS unsigned char* lds = F.lds;
    const int tid = F.tid, lane = F.lane, wid = F.wave;
    const size_t tok0 = (size_t)b * SEQ;
    const int g = wid & 3, ql = lane & 31, hi = lane >> 5;
    u32x4 qc[4], qn[4];
    { const int head = (2 * kp) * 4 + g, s0 = wid >> 2; const bf16_t* qp = F.PROJ + (tok0 + n * 128 + 32 * s0 + ql) * INW + QOFF + head * HD + hi * 8;
#pragma unroll
      for (int d0 = 0; d0 < 4; ++d0) qc[d0] = *(const GAS u32x4*)(qp + d0 * 16); }
    u32x4 kraw[2][4], vraw[2][2][2];
#pragma unroll
    for (int j = 0; j < 2; ++j) { const int kvh = 2 * kp + j;
#pragma unroll
        for (int i = 0; i < 4; ++i) { const int idx = i * 512 + tid, row = idx >> 3, c = idx & 7, pos = n * 128 - 128 + row, pc = pos < 0 ? 0 : pos;
            kraw[j][i] = *(const GAS u32x4*)(F.PROJ + (tok0 + pc) * INW + KOFF + kvh * HD + c * 8); }
#pragma unroll
        for (int i = 0; i < 2; ++i) { const int idx = i * 512 + tid, kpr = idx >> 3, c = idx & 7, pos = n * 128 - 128 + 2 * kpr, pc = pos < 0 ? 0 : pos;
            const bf16_t* p = F.PROJ + (tok0 + pc) * INW + VOFF + kvh * HD + c * 8; vraw[j][i][0] = *(const GAS u32x4*)p; vraw[j][i][1] = *(const GAS u32x4*)(p + INW); } }
    float kn[8];
#pragma unroll
    for (int q = 0; q < 8; ++q) kn[q] = F.k_norm[(tid & 7) * 8 + q];
#pragma unroll
    for (int j = 0; j < 2; ++j) {
#pragma unroll
        for (int i = 0; i < 4; ++i) {
            const int idx = i * 512 + tid, row = idx >> 3, c = idx & 7, pos = n * 128 - 128 + row;
            const u32x4 raw = kraw[j][i];
            float xv[8] = {bflo(raw.x), bfhi(raw.x), bflo(raw.y), bfhi(raw.y), bflo(raw.z), bfhi(raw.z), bflo(raw.w), bfhi(raw.w)};
            float ss = 0.f;
#pragma unroll
            for (int q = 0; q < 8; ++q) ss += xv[q] * xv[q];
            ss += __shfl_xor(ss, 1); ss += __shfl_xor(ss, 2); ss += __shfl_xor(ss, 4);
            const float rn = __builtin_amdgcn_rsqf(ss * (1.0f / HD) + EPS);
#pragma unroll
            for (int q = 0; q < 8; ++q) xv[q] = xv[q] * rn * kn[q];
            const int pp = pos >= 0 ? pos : 0;
            f32x4 cs4[2] = {(f32x4){1.f, 1.f, 1.f, 1.f}, (f32x4){1.f, 1.f, 1.f, 1.f}}, sn4[2] = {(f32x4){0.f, 0.f, 0.f, 0.f}, (f32x4){0.f, 0.f, 0.f, 0.f}};
            if (c < 2) { const GAS f32x4* rp = (const GAS f32x4*)(F.rope + pp * 16); cs4[0] = rp[0]; cs4[1] = rp[1]; sn4[0] = rp[2]; sn4[1] = rp[3]; }
#pragma unroll
            for (int q = 0; q < 8; ++q) { const float pr = __shfl_xor(xv[q], 1); const float cs = cs4[q >> 2][q & 3], sn = sn4[q >> 2][q & 3];
                const float r0 = xv[q] * cs - pr * sn, r1 = xv[q] * cs + pr * sn; xv[q] = (c == 0) ? r0 : (c == 1) ? r1 : xv[q]; }
            u32x4 w; w.x = pk2(xv[0], xv[1]); w.y = pk2(xv[2], xv[3]); w.z = pk2(xv[4], xv[5]); w.w = pk2(xv[6], xv[7]);
            *(LAS u32x4*)(lds + j * AT_UNIT + AT_K + row * 128 + ((c ^ (row & 7)) * 16)) = w;
        }
#pragma unroll
        for (int i = 0; i < 2; ++i) {
            const int idx = i * 512 + tid, kpr = idx >> 3, c = idx & 7;
            const u32x4 r0 = vraw[j][i][0], r1 = vraw[j][i][1];
            const unsigned a0[4] = {r0.x, r0.y, r0.z, r0.w}, a1[4] = {r1.x, r1.y, r1.z, r1.w};
#pragma unroll
            for (int q = 0; q < 4; ++q) {
                const unsigned lo = (a0[q] & 0xffffu) | (a1[q] << 16), hi2 = (a0[q] >> 16) | (a1[q] & 0xffff0000u);
                *(LAS unsigned*)(lds + j * AT_UNIT + AT_V + (c * 8 + 2 * q) * AT_VSTR + kpr * 4) = lo;
                *(LAS unsigned*)(lds + j * AT_UNIT + AT_V + (c * 8 + 2 * q + 1) * AT_VSTR + kpr * 4) = hi2;
            }
        }
    }
    __syncthreads();
    const float SC = 0.125f * 1.4426950408889634f;
    float cbound;
    { float gq = fabsf(F.q_norm[lane]), gk = fabsf(F.k_norm[lane]);
#pragma unroll
      for (int o = 1; o < 64; o <<= 1) { gq = fmaxf(gq, __shfl_xor(gq, o)); gk = fmaxf(gk, __shfl_xor(gk, o)); }
      cbound = 64.0f * SC * gq * gk * 1.02f; }
    const bf16x8 ones8 = {(short)0x3F80, (short)0x3F80, (short)0x3F80, (short)0x3F80, (short)0x3F80, (short)0x3F80, (short)0x3F80, (short)0x3F80};
#pragma unroll 1
    for (int item = 0; item < 4; ++item) {
        const int j = item >> 1, s = (wid >> 2) + 2 * (item & 1), head = (2 * kp + j) * 4 + g;
        const int qpos = n * 128 + 32 * s + ql;
        const int kbase = j * AT_UNIT + AT_K, vbase = j * AT_UNIT + AT_V;
        if (item < 3) {
            const int jn = (item + 1) >> 1, sn = (wid >> 2) + 2 * ((item + 1) & 1), hn = (2 * kp + jn) * 4 + g;
            const bf16_t* qp = F.PROJ + (tok0 + n * 128 + 32 * sn + ql) * INW + QOFF + hn * HD + hi * 8;
#pragma unroll
            for (int d0 = 0; d0 < 4; ++d0) qn[d0] = *(const GAS u32x4*)(qp + d0 * 16);
        }
        const float sink2 = F.sinks[head] * 1.4426950408889634f;
        float qv[4][8];
        float ss = 0.f;
#pragma unroll
        for (int d0 = 0; d0 < 4; ++d0) { const u32x4 raw = qc[d0];
            qv[d0][0] = bflo(raw.x); qv[d0][1] = bfhi(raw.x); qv[d0][2] = bflo(raw.y); qv[d0][3] = bfhi(raw.y); qv[d0][4] = bflo(raw.z); qv[d0][5] = bfhi(raw.z); qv[d0][6] = bflo(raw.w); qv[d0][7] = bfhi(raw.w);
#pragma unroll
            for (int q = 0; q < 8; ++q) ss += qv[d0][q] * qv[d0][q]; }
        ss += __shfl_xor(ss, 32);
        const float rn = SC * __builtin_amdgcn_rsqf(ss * (1.0f / HD) + EPS);
#pragma unroll
        for (int d0 = 0; d0 < 4; ++d0) { const GAS f32x4* gp = (const GAS f32x4*)(F.q_norm + d0 * 16 + hi * 8); const f32x4 g0 = gp[0], g1 = gp[1];
            const float gq[8] = {g0.x, g0.y, g0.z, g0.w, g1.x, g1.y, g1.z, g1.w};
#pragma unroll
            for (int q = 0; q < 8; ++q) qv[d0][q] = qv[d0][q] * rn * gq[q]; }
        { const GAS f32x4* rp = (const GAS f32x4*)(F.rope + qpos * 16); const f32x4 c0 = rp[0], c1 = rp[1], s0 = rp[2], s1 = rp[3];
          const float cs8[8] = {c0.x, c0.y, c0.z, c0.w, c1.x, c1.y, c1.z, c1.w}, sn8[8] = {s0.x, s0.y, s0.z, s0.w, s1.x, s1.y, s1.z, s1.w};
#pragma unroll
          for (int q = 0; q < 8; ++q) { const float pr = __shfl_xor(qv[0][q], 32);
              qv[0][q] = (hi == 0) ? (qv[0][q] * cs8[q] - pr * sn8[q]) : (qv[0][q] * cs8[q] + pr * sn8[q]); } }
        bf16x8 qr[4];
#pragma unroll
        for (int d0 = 0; d0 < 4; ++d0) { u32x4 w; w.x = pk2(qv[d0][0], qv[d0][1]); w.y = pk2(qv[d0][2], qv[d0][3]); w.z = pk2(qv[d0][4], qv[d0][5]); w.w = pk2(qv[d0][6], qv[d0][7]);
            qr[d0] = __builtin_bit_cast(bf16x8, w); }
        const float mref = fmaxf(cbound, sink2);
        f32x16 p[5];
#pragma unroll
        for (int jt = 0; jt < 5; ++jt) {
            const int krow = 32 * (s + jt) + ql;
            f32x16 a;
#pragma unroll
            for (int r = 0; r < 16; ++r) a[r] = -mref;
#pragma unroll
            for (int d0 = 0; d0 < 4; ++d0) { const int c = 2 * d0 + hi;
                const bf16x8 kf = *(const LAS bf16x8*)(lds + kbase + krow * 128 + ((c ^ (krow & 7)) * 16));
                a = __builtin_amdgcn_mfma_f32_32x32x16_bf16(kf, qr[d0], a, 0, 0, 0); }
            p[jt] = a;
        }
#pragma unroll
        for (int jt = 0; jt < 5; ++jt)
#pragma unroll
            for (int r = 0; r < 16; ++r) p[jt][r] = __builtin_amdgcn_exp2f(p[jt][r]);
#pragma unroll
        for (int r = 0; r < 16; ++r) { const int kl = (r & 3) + 8 * (r >> 2) + 4 * hi;
            p[0][r] = (kl > ql) ? p[0][r] : 0.f; p[4][r] = (kl <= ql) ? p[4][r] : 0.f; }
        if (n == 0) {
#pragma unroll
            for (int jt = 0; jt < 4; ++jt) if (s + jt < 4) {
#pragma unroll
                for (int r = 0; r < 16; ++r) p[jt][r] = 0.f; }
        }
        u32x4 pnw[4]; const int pstep = step0 + item; const bool pdo = ps.active && pstep < 8;
        __builtin_amdgcn_sched_barrier(0); if (pdo) pool_issue(F, ps, pstep, pnw); __builtin_amdgcn_sched_barrier(0);
        f32x16 o[2]; o[0] = f32x16{}; o[1] = f32x16{}; f32x16 sacc = f32x16{};
#pragma unroll
        for (int jt = 0; jt < 5; ++jt)
#pragma unroll
            for (int s2 = 0; s2 < 2; ++s2) {
                u32x4 pw; pw.x = cvt_pk_bf16(p[jt][8 * s2 + 0], p[jt][8 * s2 + 1]); pw.y = cvt_pk_bf16(p[jt][8 * s2 + 2], p[jt][8 * s2 + 3]);
                pw.z = cvt_pk_bf16(p[jt][8 * s2 + 4], p[jt][8 * s2 + 5]); pw.w = cvt_pk_bf16(p[jt][8 * s2 + 6], p[jt][8 * s2 + 7]);
                const bf16x8 pf = __builtin_bit_cast(bf16x8, pw);
                const int kb = 32 * (s + jt) + 16 * s2 + 4 * hi;
#pragma unroll
                for (int dt = 0; dt < 2; ++dt) {
                    const LAS unsigned char* vp = lds + vbase + (dt * 32 + ql) * AT_VSTR + kb * 2;
                    const u32x2 v0 = *(const LAS u32x2*)vp, v1 = *(const LAS u32x2*)(vp + 16);
                    u32x4 vw; vw.x = v0.x; vw.y = v0.y; vw.z = v1.x; vw.w = v1.y;
                    o[dt] = __builtin_amdgcn_mfma_f32_32x32x16_bf16(__builtin_bit_cast(bf16x8, vw), pf, o[dt], 0, 0, 0);
                }
                sacc = __builtin_amdgcn_mfma_f32_32x32x16_bf16(ones8, pf, sacc, 0, 0, 0);
            }
        const float inv = __builtin_amdgcn_rcpf(sacc[0] + __builtin_amdgcn_exp2f(sink2 - mref));
        bf16_t* op = F.MIXED + (tok0 + qpos) * DM + head * HD + (hi ? 8 : 0);
#pragma unroll
        for (int dt = 0; dt < 2; ++dt)
#pragma unroll
            for (int gp = 0; gp < 2; ++gp) {
                const int r0 = 8 * gp;
                unsigned ax = cvt_pk_bf16(o[dt][r0 + 0] * inv, o[dt][r0 + 1] * inv), ay = cvt_pk_bf16(o[dt][r0 + 2] * inv, o[dt][r0 + 3] * inv);
                unsigned bx = cvt_pk_bf16(o[dt][r0 + 4] * inv, o[dt][r0 + 5] * inv), by = cvt_pk_bf16(o[dt][r0 + 6] * inv, o[dt][r0 + 7] * inv);
                { auto rr = __builtin_amdgcn_permlane32_swap(ax, bx, false, false); ax = rr[0]; bx = rr[1]; }
                { auto rr = __builtin_amdgcn_permlane32_swap(ay, by, false, false); ay = rr[0]; by = rr[1]; }
                u32x4 w; w.x = ax; w.y = ay; w.z = bx; w.w = by;
                *(GAS u32x4*)(op + dt * 32 + 16 * gp) = w;
            }
        if (pdo) pool_finish(F, ps, pstep, pnw);
#pragma unroll
        for (int d0 = 0; d0 < 4; ++d0) qc[d0] = qn[d0];
    }
    __syncthreads();
}

__device__ __forceinline__ void pool_diff(Frame& F, int first_it) {
    const int NITEM = (NTOK / 32) * 128;
    for (int it = first_it; it < NITEM; it += F.G * 512) {
        const int ri = it >> 7, c8 = it & 127, w = 2 << (c8 >> 5), t0 = ri * 32, pos0 = t0 & (SEQ - 1);
        const bf16_t* up = F.PROJ + (size_t)t0 * INW + UOFF + c8 * 8;
        float S[8];
#pragma unroll
        for (int j = 0; j < 8; ++j) S[j] = 0.f;
        for (int i0 = 1; i0 < w; i0 += 5) { u32x4 pr[5];
#pragma unroll
            for (int q = 0; q < 5; ++q) { const int i = i0 + q; pr[q] = (u32x4){0u, 0u, 0u, 0u}; if (i < w && pos0 - i >= 0) pr[q] = *(const GAS u32x4*)(up - (ptrdiff_t)i * INW); }
#pragma unroll
            for (int q = 0; q < 5; ++q) { const u32x4 raw = pr[q];
                S[0] += bflo(raw.x); S[1] += bfhi(raw.x); S[2] += bflo(raw.y); S[3] += bfhi(raw.y); S[4] += bflo(raw.z); S[5] += bfhi(raw.z); S[6] += bflo(raw.w); S[7] += bfhi(raw.w); } }
#pragma unroll 1
        for (int tc = 0; tc < 32; tc += 8) {
            u32x4 nw[8], od[8];
#pragma unroll
            for (int q = 0; q < 8; ++q) { const int t = tc + q; nw[q] = *(const GAS u32x4*)(up + (ptrdiff_t)t * INW);
                od[q] = (u32x4){0u, 0u, 0u, 0u}; if (pos0 + t - w + 1 >= 0) od[q] = *(const GAS u32x4*)(up + (ptrdiff_t)(t - w + 1) * INW); }
#pragma unroll
            for (int q = 0; q < 8; ++q) { const int t = tc + q; const u32x4 raw = nw[q], old = od[q];
                const float xv[8] = {bflo(raw.x), bfhi(raw.x), bflo(raw.y), bfhi(raw.y), bflo(raw.z), bfhi(raw.z), bflo(raw.w), bfhi(raw.w)};
                const int pos = pos0 + t; const float ic = 1.0f / (float)((pos + 1 < w) ? (pos + 1) : w);
                float d[8];
#pragma unroll
                for (int j = 0; j < 8; ++j) { S[j] += xv[j]; d[j] = S[j] * ic - xv[j]; }
                u32x4 o; o.x = pk2(d[0], d[1]); o.y = pk2(d[2], d[3]); o.z = pk2(d[4], d[5]); o.w = pk2(d[6], d[7]);
                *(GAS u32x4*)(F.MIXED + (size_t)(t0 + t) * DM + 1024 + c8 * 8) = o;
                S[0] -= bflo(old.x); S[1] -= bfhi(old.x); S[2] -= bflo(old.y); S[3] -= bfhi(old.y); S[4] -= bflo(old.z); S[5] -= bfhi(old.z); S[6] -= bflo(old.w); S[7] -= bfhi(old.w); }
        }
    }
}

constexpr int RT_WSTR = 528, RT_W = 0, RT_WLO = 64 * RT_WSTR, RT_L = 2 * 64 * RT_WSTR, RT_LSTR = 65;
__device__ __forceinline__ void route_phase(Frame& F, bool dry) {
    LAS unsigned char* lds = F.lds;
    const int tid = F.tid, lane = F.lane, wid = F.wave, row = lane & 15, kq = lane >> 4;
    for (int tile = F.bx; tile < NTOK / 128; tile += F.G) {
        const int t0 = tile * 128 + wid * 16;
        const bf16_t* hp = F.XB + (size_t)(t0 + row) * DM + kq * 8;
        unsigned char* h8 = F.H8 + (size_t)(t0 + row) * DM + kq * 8;
        f32x4 acc[4]; acc[0] = acc[1] = acc[2] = acc[3] = (f32x4){0.f, 0.f, 0.f, 0.f};
        float ssq = 0.f;
        u32x4 hv[8]; u32x4 wv[8];
#pragma unroll
        for (int ks = 0; ks < 8; ++ks) hv[ks] = *(const GAS u32x4*)(hp + ks * 32);
#pragma unroll
        for (int i = 0; i < 8; ++i) { const int p = i * 512 + tid, which = p >> 11, col = (p & 2047) >> 5, ch = p & 31;
            wv[i] = *(const GAS u32x4*)(F.Wr + (size_t)which * 64 * DM + (size_t)col * DM + ch * 8); }
#pragma unroll 1
        for (int kc = 0; kc < 8; ++kc) {
            __syncthreads();
#pragma unroll
            for (int i = 0; i < 8; ++i) { const int p = i * 512 + tid, which = p >> 11, col = (p & 2047) >> 5, ch = p & 31;
                *(LAS u32x4*)(lds + which * RT_WLO + col * RT_WSTR + ch * 16) = wv[i]; }
            __syncthreads();
            if (kc < 7) {
#pragma unroll
                for (int i = 0; i < 8; ++i) { const int p = i * 512 + tid, which = p >> 11, col = (p & 2047) >> 5, ch = p & 31;
                    wv[i] = *(const GAS u32x4*)(F.Wr + (size_t)which * 64 * DM + (size_t)col * DM + (kc + 1) * 256 + ch * 8); } }
#pragma unroll
            for (int ks = 0; ks < 8; ++ks) {
                const int k = kc * 256 + ks * 32;
                const u32x4 ah = hv[ks];
                if (kc < 7) hv[ks] = *(const GAS u32x4*)(hp + k + 256);
                { const float a0 = bflo(ah.x), a1 = bfhi(ah.x), a2 = bflo(ah.y), a3 = bfhi(ah.y), a4 = bflo(ah.z), a5 = bfhi(ah.z), a6 = bflo(ah.w), a7 = bfhi(ah.w);
                  ssq += (a0 * a0 + a1 * a1) + (a2 * a2 + a3 * a3) + (a4 * a4 + a5 * a5) + (a6 * a6 + a7 * a7);
                  u32x2 w8; w8.x = pk4_fp8(a0, a1, a2, a3); w8.y = pk4_fp8(a4, a5, a6, a7); *(GAS u32x2*)(h8 + k) = w8; }
                const bf16x8 Ah = __builtin_bit_cast(bf16x8, ah);
#pragma unroll
                for (int tc = 0; tc < 4; ++tc) {
                    const LAS unsigned char* bp = lds + (tc * 16 + row) * RT_WSTR + (ks * 32 + kq * 8) * 2;
                    const bf16x8 Bh = *(const LAS bf16x8*)bp, Bl = *(const LAS bf16x8*)(bp + RT_WLO);
                    acc[tc] = __builtin_amdgcn_mfma_f32_16x16x32_bf16(Ah, Bh, acc[tc], 0, 0, 0);
                    acc[tc] = __builtin_amdgcn_mfma_f32_16x16x32_bf16(Ah, Bl, acc[tc], 0, 0, 0);
                }
            }
        }
        ssq += __shfl_xor(ssq, 16); ssq += __shfl_xor(ssq, 32);
        const float rt = 1.0f / sqrtf(ssq * (1.0f / DM) + EPS);
        LAS float* L = (LAS float*)(lds + RT_L) + wid * 16 * RT_LSTR;
#pragma unroll
        for (int tc = 0; tc < 4; ++tc)
#pragma unroll
            for (int r = 0; r < 4; ++r) L[(kq * 4 + r) * RT_LSTR + tc * 16 + row] = acc[tc][r];
        LAS unsigned* lcnt = (LAS unsigned*)(lds + RT_L + 8 * 16 * RT_LSTR * 4); LAS unsigned* lbase = lcnt + NEXP;
        if (tid < NEXP) lcnt[tid] = 0u;
        __syncthreads();
        int me1 = 0, me2 = 0; unsigned r1 = 0u, r2 = 0u;
        if (lane < 16) {
            const int t = t0 + lane; const LAS float* Lt = L + lane * RT_LSTR;
            float c[4]; int grp = 0; float cm;
#pragma unroll
            for (int j = 0; j < 4; ++j) c[j] = Lt[j] * rt + F.b_coarse[j];
            cm = c[0];
#pragma unroll
            for (int j = 1; j < 4; ++j) if (c[j] > cm) { cm = c[j]; grp = j; }
            float den = 0.f;
#pragma unroll
            for (int j = 0; j < 4; ++j) den += __expf(c[j] - cm);
            const float pg = 1.0f / den;
            float f[8];
#pragma unroll
            for (int j = 0; j < 8; ++j) f[j] = Lt[4 + grp * 8 + j] * rt + F.b_fine[grp * 8 + j];
            int i1 = 0; float l1 = f[0];
#pragma unroll
            for (int j = 1; j < 8; ++j) if (f[j] > l1) { l1 = f[j]; i1 = j; }
            int i2 = -1; float l2 = -3.0e38f;
#pragma unroll
            for (int j = 0; j < 8; ++j) if (j != i1 && f[j] > l2) { l2 = f[j]; i2 = j; }
            const float e2 = __expf(l2 - l1), g1 = pg / (1.0f + e2), g2 = pg * e2 / (1.0f + e2);
            F.rtok[t] = rt; F.gate[2 * t] = g1; F.gate[2 * t + 1] = g2;
            me1 = grp * 8 + i1; me2 = grp * 8 + i2;
            r1 = __hip_atomic_fetch_add(&lcnt[me1], 1u, __ATOMIC_RELAXED, __HIP_MEMORY_SCOPE_WORKGROUP);
            r2 = __hip_atomic_fetch_add(&lcnt[me2], 1u, __ATOMIC_RELAXED, __HIP_MEMORY_SCOPE_WORKGROUP);
        }
        __syncthreads();
        if (tid < NEXP) { const unsigned c = lcnt[tid]; unsigned base = 0u;
            if (c && !dry) base = __hip_atomic_fetch_add((unsigned*)(F.ctl + CW_CNT + 64 * tid), c, RLX_AGENT);
            lbase[tid] = base; }
        __syncthreads();
        if (lane < 16 && !dry) { const int t = t0 + lane;
            F.rowl[(size_t)me1 * RCAP + lbase[me1] + r1] = 2 * t;
            F.rowl[(size_t)me2 * RCAP + lbase[me2] + r2] = 2 * t + 1; }
    }
}

__device__ __forceinline__ void moe_setup(Frame& F, int nN, bool with_rg) {
    LAS int* expt = (LAS int*)(F.lds + EXPT_OFF); LAS int* tab = (LAS int*)(F.lds + TAB_OFF); LAS float* tabr = (LAS float*)(F.lds + TABR_OFF); LAS float* tabg = (LAS float*)(F.lds + TABG_OFF);
    __syncthreads();
    if (F.tid < NEXP) expt[33 + F.tid] = (int)__hip_atomic_load((unsigned*)(F.ctl + CW_CNT + 64 * F.tid), RLX_AGENT);
    __syncthreads();
    if (F.tid == 0) { int acc = 0, maxT = 0;
        for (int e = 0; e < NEXP; ++e) { const int T = (expt[33 + e] + 255) >> 8; expt[e] = acc; acc += T * nN; maxT = T > maxT ? T : maxT; }
        expt[32] = acc; expt[70] = (MOE_OWNER && F.G == 256 && maxT <= 12) ? 1 : 0; expt[71] = maxT; }
    __syncthreads();
    pg8::MoeProb P; P.expt = expt; P.nN = nN; P.G = F.G; P.c = F.bx;
    pg8::Unit u;
    int nu = 0; while (P.next(nu, u)) ++nu;
    constexpr int KMAX = (TAB_UNITS * 256 + 511) / 512;
    int v[KMAX]; bool ok[KMAX];
#pragma unroll
    for (int k = 0; k < KMAX; ++k) { const int idx = F.tid + k * 512, i = idx >> 8, r = idx & 255; v[k] = 0; ok[k] = false;
        if (i < nu) { P.next(i, u); const int j = u.pm * 256 + r, cnt = expt[33 + u.e]; ok[k] = j < cnt; v[k] = F.rowl[(size_t)u.e * RCAP + (ok[k] ? j : 0)]; } }
#pragma unroll
    for (int k = 0; k < KMAX; ++k) { const int idx = F.tid + k * 512, i = idx >> 8; if (i < nu) tab[idx] = ok[k] ? v[k] : (v[k] | (int)0x80000000); }
    if (with_rg) {
        float rr[KMAX], gg[KMAX];
#pragma unroll
        for (int k = 0; k < KMAX; ++k) { const int idx = F.tid + k * 512, i = idx >> 8; rr[k] = 0.f; gg[k] = 0.f; if (i < nu && i < TABRG_UNITS) { rr[k] = F.rtok[v[k] >> 1]; gg[k] = F.gate[v[k]]; } }
#pragma unroll
        for (int k = 0; k < KMAX; ++k) { const int idx = F.tid + k * 512, i = idx >> 8; if (i < nu && i < TABRG_UNITS) { const float r = rr[k] * (1.0f / W8_SCALE); tabr[idx] = r; tabg[idx] = r * gg[k] * ACT8_SCALE; } }
    }
    __syncthreads();
}

__device__ __forceinline__ void combine_phase(Frame& F, float* dst) {
    const size_t NIT = (size_t)NTOK * (DM / 8), stride = (size_t)F.G * 512;
    const unsigned char* Y8 = (const unsigned char*)F.Y;
    constexpr float IS = 1.0f / Y8_SCALE;
    for (size_t it0 = (size_t)F.bx * 512 + F.tid; it0 < NIT; it0 += 4 * stride) {
        u32x4 h[4]; u32x2 y0[4], y1[4];
#pragma unroll
        for (int q = 0; q < 4; ++q) { const size_t it = it0 + q * stride; if (it < NIT) { const size_t t = it >> 8; const int c = (int)(it & 255) * 8;
            h[q] = *(const GAS u32x4*)(F.XB + t * DM + c); y0[q] = *(const GAS u32x2*)(Y8 + (2 * t) * DM + c); y1[q] = *(const GAS u32x2*)(Y8 + (2 * t + 1) * DM + c); } }
#pragma unroll
        for (int q = 0; q < 4; ++q) { const size_t it = it0 + q * stride; if (it < NIT) { const size_t t = it >> 8; const int c = (int)(it & 255) * 8;
            float* wp = dst + t * DM + c; f32x4 o0, o1;
            const f32x2 a0 = __builtin_amdgcn_cvt_pk_f32_fp8((int)y0[q].x, false), a1 = __builtin_amdgcn_cvt_pk_f32_fp8((int)y0[q].x, true), a2 = __builtin_amdgcn_cvt_pk_f32_fp8((int)y0[q].y, false), a3 = __builtin_amdgcn_cvt_pk_f32_fp8((int)y0[q].y, true);
            const f32x2 b0 = __builtin_amdgcn_cvt_pk_f32_fp8((int)y1[q].x, false), b1 = __builtin_amdgcn_cvt_pk_f32_fp8((int)y1[q].x, true), b2 = __builtin_amdgcn_cvt_pk_f32_fp8((int)y1[q].y, false), b3 = __builtin_amdgcn_cvt_pk_f32_fp8((int)y1[q].y, true);
            o0.x = bflo(h[q].x) + (a0.x + b0.x) * IS; o0.y = bfhi(h[q].x) + (a0.y + b0.y) * IS; o0.z = bflo(h[q].y) + (a1.x + b1.x) * IS; o0.w = bfhi(h[q].y) + (a1.y + b1.y) * IS;
            o1.x = bflo(h[q].z) + (a2.x + b2.x) * IS; o1.y = bfhi(h[q].z) + (a2.y + b2.y) * IS; o1.z = bflo(h[q].w) + (a3.x + b3.x) * IS; o1.w = bfhi(h[q].w) + (a3.y + b3.y) * IS;
            *(GAS f32x4*)wp = o0; *(GAS f32x4*)(wp + 4) = o1; } }
    }
}

struct Args { const float* in[17]; float* out; unsigned char* ws; int ph_lo, ph_hi, use_bar, pad; };
__global__ void __launch_bounds__(512, 2) hymba_fwd(Args args) {
    extern __shared__ __attribute__((aligned(16))) unsigned char lds[];
    Frame F;
    F.lds = (LAS unsigned char*)lds;
    F.tid = threadIdx.x; F.lane = F.tid & 63; F.wave = __builtin_amdgcn_readfirstlane(F.tid >> 6);
    F.G = gridDim.x; F.bx = blockIdx.x;
    unsigned char* ws = args.ws;
    F.ctl = (gu32*)(ws + WS_CTL);
    F.x = args.in[0]; F.norm_mix = args.in[1]; F.w_in = args.in[2]; F.q_norm = args.in[3]; F.k_norm = args.in[4]; F.sinks = args.in[5]; F.w_pool = args.in[6]; F.pool_scale = args.in[7];
    F.w_out = args.in[8]; F.norm_ffn = args.in[9]; F.w_coarse = args.in[10]; F.b_coarse = args.in[11]; F.w_fine = args.in[12]; F.b_fine = args.in[13]; F.w_gate = args.in[14]; F.w_up = args.in[15]; F.w_down = args.in[16];
    F.out = args.out;
    F.rope = (float*)(ws + WS_ROPE); F.rinv = (float*)(ws + WS_RINV); F.rtok = (float*)(ws + WS_RTOK); F.gate = (float*)(ws + WS_GATE);
    F.Wr = (bf16_t*)(ws + WS_WR); F.Wpool = (bf16_t*)(ws + WS_WPOOL); F.Win = (bf16_t*)(ws + WS_WIN); F.Wout = (bf16_t*)(ws + WS_WOUT); F.Wgu8 = ws + WS_WGU; F.Wd8 = ws + WS_WD; F.H8 = ws + WS_H8; F.ACT8 = ws + WS_ACT8;
    F.XB = (bf16_t*)(ws + WS_XB); F.PROJ = (bf16_t*)(ws + WS_PROJ); F.MIXED = (bf16_t*)(ws + WS_MIXED); F.DPOOL = (bf16_t*)(ws + WS_DPOOL); F.Y = (bf16_t*)(ws + WS_Y);
    F.rowl = (int*)(ws + WS_ROWL);
    if (F.tid < 4) ((LAS unsigned*)(F.lds + MISC_OFF))[F.tid] = 0u;
    __syncthreads();
    XcdBarrier bar; bar.bar = (unsigned*)(F.ctl + CW_BAR); bar.x = 0; bar.st = nullptr;
    if (args.use_bar) bar = xcd_barrier_post((unsigned*)(F.ctl + CW_BAR), (volatile LAS unsigned*)(F.lds + MISC_OFF));
    const int lo = args.ph_lo, hi = args.ph_hi;
#ifndef PHASE_MASK
#define PHASE_MASK 0x1ff
#endif
#define IN(k) (((PHASE_MASK >> (k)) & 1) && lo <= (k) && (k) < hi)
#define SEAM(k) do { if (IN(k) && IN((k) + 1)) xcd_barrier(bar); } while (0)

#define REPS(k) ((PROBE_DUP == (k)) ? 2 : 1)
    if (IN(0)) { for (int rep = 0; rep < REPS(0); ++rep) { if (rep) xcd_barrier(bar); p0_prologue(F); } SEAM(0); }
    if (IN(1)) {
        for (int rep = 0; rep < REPS(1); ++rep) { if (rep) xcd_barrier(bar);
        pg8::DenseProb P; P.A = (const char*)F.XB; P.Bt = (const char*)F.Win; P.ldaB = DM * 2; P.KB = DM * 2; P.acolB = 0; P.so.init(NTOK, INW, F.G, F.bx);
        pg8::EpiBf16 E{F.PROJ, INW, 0, 1.0f};
        pg8::gemm_phase(F.lds, P, E); }
        SEAM(1);
    }
    if (IN(2)) {
#if PROBE_DUP == 2
        { PoolSt ps; pool_begin(F, F.bx * 512 + F.tid, ps); int pstep = 0;
#pragma unroll 1
          for (int u = F.bx; u < BATCH * (SEQ / 128) * (NKV / 2); u += F.G) { const int kp = u & 1, n = (u >> 1) & 31, b = u >> 6; attn_super(F, b, n, kp, ps, pstep); pstep += 4; }
          if (ps.active) for (; pstep < 8; ++pstep) { u32x4 a4[4]; pool_issue(F, ps, pstep, a4); pool_finish(F, ps, pstep, a4); } }
        xcd_barrier(bar);
#elif PROBE_DUP == 22
        pool_diff(F, F.bx * 512 + F.tid + F.G * 512);
        xcd_barrier(bar);
#endif
        { PoolSt ps; pool_begin(F, F.bx * 512 + F.tid, ps); int pstep = 0;
#pragma unroll 1
          for (int u = F.bx; u < BATCH * (SEQ / 128) * (NKV / 2); u += F.G) { const int kp = u & 1, n = (u >> 1) & 31, b = u >> 6; attn_super(F, b, n, kp, ps, pstep); pstep += 4; }
          if (ps.active) for (; pstep < 8; ++pstep) { u32x4 a4[4]; pool_issue(F, ps, pstep, a4); pool_finish(F, ps, pstep, a4); } }
        pool_diff(F, F.bx * 512 + F.tid + F.G * 512);
        SEAM(2);
    }
    if (IN(4)) {
        for (int rep = 0; rep < REPS(4); ++rep) { if (rep) xcd_barrier(bar);
        pg8::DenseProb P; P.A = (const char*)F.MIXED; P.Bt = (const char*)F.Wout; P.ldaB = DM * 2; P.KB = DM * 2; P.acolB = 0; P.so.init(NTOK, DM, F.G, F.bx);
        pg8::EpiResBf16 E{F.rinv, F.XB, DM, F.H8};
        pg8::gemm_phase(F.lds, P, E); }
        SEAM(4);
    }
    if (IN(5)) { for (int rep = 0; rep < REPS(5); ++rep) { if (rep) xcd_barrier(bar); route_phase(F, rep + 1 < REPS(5)); __syncthreads(); if (rep == 0) gu_convert(F); } SEAM(5); }
    if (IN(6)) {
        for (int rep = 0; rep < REPS(6); ++rep) { if (rep) xcd_barrier(bar);
        moe_setup(F, 4, true);
        pg8::MoeProb P; P.A = (const char*)F.H8; P.Bt = (const char*)F.Wgu8; P.ldaB = DM; P.KB = DM; P.nN = 4; P.shift = 1; P.tab = (LAS const int*)(F.lds + TAB_OFF); P.expt = (LAS const int*)(F.lds + EXPT_OFF); P.G = F.G; P.c = F.bx;
        pg8::EpiSwiGLU E{F.ACT8, (LAS const int*)(F.lds + TAB_OFF), (LAS const float*)(F.lds + TABR_OFF), (LAS const float*)(F.lds + TABG_OFF)};
        pg8::gemm_phase<pg8::EpiSwiGLU, pg8::MoeProb, true>(F.lds, P, E);
        if (rep == 0) {
            LAS int* ex = (LAS int*)(F.lds + EXPT_OFF);
            const int U = ex[32], per = F.G >> 3, q = (F.bx & 7) * per + (F.bx >> 3);
            if (ex[70]) {
                if (F.tid == 0) { const int maxnu = (ex[71] + 1) >> 1; int idx = -1, nidle = 0;
                    for (int c2 = 0; c2 < 256; ++c2) { const int e2 = (c2 & 7) + 8 * ((c2 >> 3) >> 3), par = ((c2 >> 3) & 7) >> 2, T2 = (ex[33 + e2] + 255) >> 8, nu2 = (T2 - par + 1) >> 1;
                        if (nu2 < maxnu) { if (c2 == F.bx) idx = nidle; ++nidle; } }
                    ex[72] = idx; ex[73] = nidle; }
                __syncthreads();
                const int idx = ex[72], nidle = ex[73];
                if (nidle == 0) wd_convert(F, q, F.G); else if (idx >= 0) wd_convert(F, idx, nidle);
            } else {
                const int rounds = (U + F.G - 1) / F.G, nb = U - (rounds - 1) * F.G;
                if (U <= 0 || nb >= F.G) wd_convert(F, q, F.G); else if (q >= nb) wd_convert(F, q - nb, F.G - nb);
            }
        } }
        SEAM(6);
    }
    if (IN(7)) {
        for (int rep = 0; rep < REPS(7); ++rep) { if (rep) xcd_barrier(bar);
        moe_setup(F, 8, false);
        pg8::MoeProb P; P.A = (const char*)F.ACT8; P.Bt = (const char*)F.Wd8; P.ldaB = DEXP; P.KB = DEXP; P.nN = 8; P.shift = 0; P.tab = (LAS const int*)(F.lds + TAB_OFF); P.expt = (LAS const int*)(F.lds + EXPT_OFF); P.G = F.G; P.c = F.bx;
        pg8::EpiScatterF8 E{(unsigned char*)F.Y, DM, (LAS const int*)(F.lds + TAB_OFF), Y8_SCALE / (W8_SCALE * ACT8_SCALE)};
        pg8::gemm_phase<pg8::EpiScatterF8, pg8::MoeProb, true, 1, PROBE_EPI2 ? 2 : 1>(F.lds, P, E); }
        SEAM(7);
    }
    if (IN(8)) { for (int rep = 0; rep < REPS(8); ++rep) { if (rep) xcd_barrier(bar); combine_phase(F, (rep + 1 < REPS(8)) ? (float*)(ws + WS_END) : F.out); } }
#undef REPS
#undef IN
#undef SEAM
}

extern "C" void kernel_launch(void* const* d_in, const int* in_sizes, int n_in, void* d_out, int out_size, void* d_ws, size_t ws_size, hipStream_t stream) {
    static int grid = 0;
    if (grid == 0) {
        if (n_in != 17 || out_size != NTOK * DM || ws_size < WS_END) { fprintf(stderr, "kernel_launch: unexpected problem (n_in %d, out %d, ws %zu)\n", n_in, out_size, ws_size); grid = -1; return; }
        int dev = 0, cus = 0;
        if (hipGetDevice(&dev) != hipSuccess || hipDeviceGetAttribute(&cus, hipDeviceAttributeMultiprocessorCount, dev) != hipSuccess) { grid = -1; return; }
        if (hipFuncSetAttribute((const void*)hymba_fwd, hipFuncAttributeMaxDynamicSharedMemorySize, LDS_BYTES) != hipSuccess) { fprintf(stderr, "kernel_launch: hipFuncSetAttribute failed\n"); grid = -1; return; }
        int per_cu = 0;
        if (hipOccupancyMaxActiveBlocksPerMultiprocessor(&per_cu, (const void*)hymba_fwd, 512, LDS_BYTES) != hipSuccess || per_cu < 1) { fprintf(stderr, "kernel_launch: occupancy query says %d\n", per_cu); }
        (void)hipGetLastError();
        grid = cus - (cus % 8);
        if (grid <= 0) grid = -1;
    }
    if (grid < 0) return;
    if (hipMemsetAsync((char*)d_ws + WS_CTL, 0, CTL_ZERO_BYTES, stream) != hipSuccess) return;
    Args a{};
    for (int i = 0; i < 17; ++i) a.in[i] = (const float*)d_in[i];
    a.out = (float*)d_out; a.ws = (unsigned char*)d_ws;
    if (MK_N_LAUNCHES == 1) { a.ph_lo = 0; a.ph_hi = NPHASE; a.use_bar = 1; hipLaunchKernelGGL(hymba_fwd, dim3(grid), dim3(512), LDS_BYTES, stream, a); }
    else for (int p = 0; p < NPHASE; ++p) { a.ph_lo = p; a.ph_hi = p + 1; a.use_bar = 0; hipLaunchKernelGGL(hymba_fwd, dim3(grid), dim3(512), LDS_BYTES, stream, a); }
}
```
